# Optimizing an MI355X kernel written in HIP

```python
import math
import jax
import jax.numpy as jnp
from jax import lax
import numpy as np

D_MODEL = 1024
BATCH = 16
SEQ = 2048
DEPTH = 4
DEC_BATCH = 8
DEC_SEQ = 64
PAST_LEN = 4096

CHUNK = 64
GDN_DK = 128
GDN_DV = 128
GDN_HEADS = D_MODEL // (2 * GDN_DV)
GDN_WIDTH = GDN_HEADS * GDN_DV
GDN_QKV = 2 * GDN_HEADS * GDN_DK + GDN_WIDTH
CONV_W = 4
GDN_PROJ = GDN_QKV + GDN_WIDTH + 2 * GDN_HEADS
RW_HD = 64
RW_HEADS = D_MODEL // (2 * RW_HD)
RW_WIDTH = RW_HEADS * RW_HD
W_LORA = 64
A_LORA = 64
G_LORA = 128
RW_PROJ = 3 * RW_WIDTH + W_LORA + A_LORA + G_LORA
P_TOT = GDN_PROJ + RW_PROJ
MIX_WIDTH = GDN_WIDTH + RW_WIDTH
D_FF = 4 * D_MODEL
DN_ALPHA = (2 * DEPTH) ** 0.25
DN_BETA = (8 * DEPTH) ** -0.25
LN_EPS = 1e-5
GN_EPS = 64e-5
NORM_EPS = 1e-6

kernel_name = 'hymba_gdn_rwkv7_deepnorm_adaln_stream'


def _l2norm(t):
    t = t.astype(jnp.float32)
    return t * lax.rsqrt(jnp.sum(t * t, axis=-1, keepdims=True) + NORM_EPS)


def _layer_norm(t, w, b, eps):
    tf = t.astype(jnp.float32)
    mu = jnp.mean(tf, axis=-1, keepdims=True)
    var = jnp.mean(jnp.square(tf - mu), axis=-1, keepdims=True)
    return ((tf - mu) * lax.rsqrt(var + eps) * w + b).astype(t.dtype)


def _rms_norm(t, w):
    tf = t.astype(jnp.float32)
    return tf * lax.rsqrt(jnp.mean(tf * tf, axis=-1, keepdims=True) + NORM_EPS) * w


def _causal_conv(t, buf, w):
    n = t.shape[1]
    tp = jnp.concatenate([buf.astype(t.dtype), t], axis=1)
    y = tp[:, 0:n] * w[0]
    for j in range(1, CONV_W):
        y = y + tp[:, j:j + n] * w[j]
    return y, tp[:, n:]


def _token_shift(t, prev, mu):
    tp = jnp.concatenate([prev[:, None, :].astype(t.dtype), t[:, :-1]], axis=1)
    return t + (tp - t) * mu, t[:, -1]


def _gated_delta_chunked(q, k, v, log_a, beta, s0, chunk):
    bsz, seq, nh, dk = q.shape
    dv = v.shape[-1]
    nb = seq // chunk

    def blk(t):
        t = t.astype(jnp.float32).reshape((bsz, nb, chunk) + t.shape[2:])
        return jnp.moveaxis(t, 3, 2)

    q, k, v, log_a, beta = blk(q), blk(k), blk(v), blk(log_a), blk(beta)
    g = jnp.cumsum(log_a, axis=-1)
    idx = jnp.arange(chunk)
    causal = idx[:, None] >= idx[None, :]
    strict = idx[:, None] > idx[None, :]
    gam = jnp.exp(jnp.where(causal, g[..., :, None] - g[..., None, :], -jnp.inf))
    a_mat = jnp.where(strict, beta[..., :, None] * jnp.einsum('bnhtd,bnhid->bnhti', k, k) * gam, 0.0)
    eye = jnp.eye(chunk, dtype=jnp.float32)
    rhs = jnp.concatenate([v * beta[..., None], k * (beta * jnp.exp(g))[..., None]], axis=-1)
    sol = lax.linalg.triangular_solve(a_mat + eye, rhs, left_side=True, lower=True, unit_diagonal=True)
    u0, wk = sol[..., :dv], sol[..., dv:]
    qk = jnp.where(causal, jnp.einsum('bnhtd,bnhid->bnhti', q, k) * gam, 0.0)
    g_last = g[..., -1:]
    q_dec = q * jnp.exp(g)[..., None]
    k_dec = k * jnp.exp(g_last - g)[..., None]
    d_last = jnp.exp(g_last[..., 0])

    def step(s, xs):
        u0_c, wk_c, qk_c, qd_c, kd_c, dl_c = xs
        u = u0_c - jnp.einsum('bhtk,bhkv->bhtv', wk_c, s)
        o = jnp.einsum('bhtk,bhkv->bhtv', qd_c, s) + jnp.einsum('bhti,bhiv->bhtv', qk_c, u)
        s = s * dl_c[..., None, None] + jnp.einsum('bhtk,bhtv->bhkv', kd_c, u)
        return s, o

    xs = tuple(jnp.moveaxis(t, 1, 0) for t in (u0, wk, qk, q_dec, k_dec, d_last))
    s_fin, o = lax.scan(step, s0.astype(jnp.float32), xs)
    o = jnp.transpose(o, (1, 0, 3, 2, 4)).reshape(bsz, seq, nh, dv)
    return o, s_fin


def _rwkv7_scan(r, decay, k, v, kk, a, s0):
    def tm(t):
        return jnp.moveaxis(t.astype(jnp.float32), 1, 0)

    def step(s, xs):
        r_t, w_t, k_t, v_t, kk_t, a_t = xs
        sa = jnp.einsum('bhij,bhj->bhi', s, -kk_t)
        s = (s * w_t[:, :, None, :] + sa[..., :, None] * (kk_t * a_t)[:, :, None, :]
             + v_t[..., :, None] * k_t[:, :, None, :])
        return s, jnp.einsum('bhij,bhj->bhi', s, r_t)

    s_fin, o = lax.scan(step, s0.astype(jnp.float32), tuple(tm(t) for t in (r, decay, k, v, kk, a)))
    return jnp.moveaxis(o, 0, 1), s_fin


def _mixer(h, l, p, s_gdn, s_conv, s_rw, s_shift, chunk):
    bsz, seq, _ = h.shape
    proj = jnp.einsum('btd,dp->btp', h, p['w_in'][l])
    o1 = GDN_QKV
    o2 = o1 + GDN_WIDTH
    o3 = o2 + GDN_HEADS
    qkv, z, ga, gb, rw = proj[..., :o1], proj[..., o1:o2], proj[..., o2:o3], proj[..., o3:GDN_PROJ], proj[..., GDN_PROJ:]
    qkv, new_conv = _causal_conv(qkv, s_conv, p['gdn_conv_w'][l])
    qkv = jax.nn.silu(qkv)
    nk = GDN_HEADS * GDN_DK
    q = _l2norm(qkv[..., :nk].reshape(bsz, seq, GDN_HEADS, GDN_DK)) * (GDN_DK ** -0.5)
    k = _l2norm(qkv[..., nk:2 * nk].reshape(bsz, seq, GDN_HEADS, GDN_DK))
    v = qkv[..., 2 * nk:].reshape(bsz, seq, GDN_HEADS, GDN_DV)
    log_a = -jnp.exp(p['gdn_a_log'][l].astype(jnp.float32)) * jax.nn.softplus(ga.astype(jnp.float32) + p['gdn_dt_bias'][l])
    beta = jax.nn.sigmoid(gb.astype(jnp.float32))
    o_g, new_gdn = _gated_delta_chunked(q, k, v, log_a, beta, s_gdn, chunk)
    o_g = _rms_norm(o_g, p['gdn_norm_w'][l]) * jax.nn.silu(z.astype(jnp.float32)).reshape(bsz, seq, GDN_HEADS, GDN_DV)
    o_g = o_g.reshape(bsz, seq, GDN_WIDTH)
    rw, new_shift = _token_shift(rw, s_shift, p['rwkv_mu'][l])
    c1 = RW_WIDTH
    c2 = 2 * RW_WIDTH
    c3 = 3 * RW_WIDTH
    c4 = c3 + W_LORA
    c5 = c4 + A_LORA
    r, kr, vr = rw[..., :c1], rw[..., c1:c2], rw[..., c2:c3]
    xw, xa, xg = rw[..., c3:c4], rw[..., c4:c5], rw[..., c5:]
    w_log = -jax.nn.softplus(-(p['rwkv_w0'][l] + jnp.tanh(xw) @ p['rwkv_w2'][l]).astype(jnp.float32)) - 0.5
    decay = jnp.exp(-jnp.exp(w_log))
    a = jax.nn.sigmoid((p['rwkv_a0'][l] + xa @ p['rwkv_a2'][l]).astype(jnp.float32))
    g = jax.nn.sigmoid(xg) @ p['rwkv_g2'][l]

    def heads(t):
        return t.reshape(bsz, seq, RW_HEADS, RW_HD)

    kk = _l2norm(heads(kr * p['rwkv_kk'][l]))
    kr = kr * (1.0 + (a - 1.0) * p['rwkv_ka'][l])
    o_r, new_rw = _rwkv7_scan(heads(r), heads(decay), heads(kr), heads(vr), kk, heads(a), s_rw)
    o_r = _layer_norm(o_r, p['rwkv_ln_w'][l].reshape(RW_HEADS, RW_HD), p['rwkv_ln_b'][l].reshape(RW_HEADS, RW_HD), GN_EPS)
    bonus = jnp.sum(heads(r * kr * p['rwkv_rk'][l]).astype(jnp.float32), axis=-1, keepdims=True) * heads(vr)
    o_r = (o_r + bonus).reshape(bsz, seq, RW_WIDTH) * g
    y = jnp.concatenate([o_g, o_r], axis=-1).astype(h.dtype) @ p['w_out'][l]
    return y, new_gdn, new_conv, new_rw, new_shift


def _trunk(x, c, st_gdn, st_conv, st_rw, st_shift, p, chunk):
    outs = ([], [], [], [])
    for l in range(DEPTH):
        mod = jnp.einsum('bd,de->be', jax.nn.silu(c), p['w_ada'][l]) + p['b_ada'][l]
        sh1, sc1, g1, sh2, sc2, g2 = jnp.split(mod[:, None, :], 6, axis=-1)
        h = x * (1.0 + sc1) + sh1
        y, n_gdn, n_conv, n_rw, n_shift = _mixer(h, l, p, st_gdn[l], st_conv[l], st_rw[l], st_shift[l], chunk)
        for lst, s in zip(outs, (n_gdn, n_conv, n_rw, n_shift)):
            lst.append(s.astype(x.dtype))
        x = _layer_norm(DN_ALPHA * x + g1 * y, p['ln1_w'][l], p['ln1_b'][l], LN_EPS)
        h = x * (1.0 + sc2) + sh2
        f = jnp.square(jax.nn.relu(h @ p['w_ff1'][l])) @ p['w_ff2'][l]
        x = _layer_norm(DN_ALPHA * x + g2 * f, p['ln2_w'][l], p['ln2_b'][l], LN_EPS)
    return x, jnp.stack(outs[0]), jnp.stack(outs[1]), jnp.stack(outs[2]), jnp.stack(outs[3])


def setup_inputs(seed: int = 0) -> dict:
    key = jax.random.key(seed)
    ks = iter(jax.random.split(key, 48))

    def nrm(shape, s):
        return jax.random.normal(next(ks), shape, jnp.float32) * s

    def uni(shape, lo, hi):
        return jax.random.uniform(next(ks), shape, jnp.float32, lo, hi)

    L = DEPTH
    D = D_MODEL
    x_prompt = nrm((BATCH, SEQ, D), 1.0)
    x_sample = nrm((DEC_BATCH, DEC_SEQ, D), 1.0)
    c_prompt = nrm((BATCH, D), 1.0)
    c_sample = nrm((DEC_BATCH, D), 1.0)
    state_gdn = nrm((L, DEC_BATCH, GDN_HEADS, GDN_DK, GDN_DV), 0.1)
    state_gdn_conv = nrm((L, DEC_BATCH, CONV_W - 1, GDN_QKV), 1.0)
    state_rwkv = nrm((L, DEC_BATCH, RW_HEADS, RW_HD, RW_HD), 1.0)
    state_rwkv_shift = nrm((L, DEC_BATCH, RW_PROJ), 1.0)
    w_ada = nrm((L, D, 6 * D), 0.5 * D ** -0.5)
    b_ada = nrm((L, 6 * D), 0.02)
    w_in = nrm((L, D, P_TOT), D ** -0.5)
    gdn_conv_w = nrm((L, CONV_W, GDN_QKV), CONV_W ** -0.5)
    gdn_a_log = jnp.log(uni((L, GDN_HEADS), 1.0, 16.0))
    dt = jnp.exp(uni((L, GDN_HEADS), math.log(1e-3), math.log(1e-1)))
    gdn_dt_bias = dt + jnp.log(-jnp.expm1(-dt))
    gdn_norm_w = 1.0 + nrm((L, GDN_DV), 0.02)
    rwkv_mu = uni((L, RW_PROJ), 0.0, 1.0)
    rwkv_w0 = uni((L, RW_WIDTH), -6.5, -1.5)
    rwkv_w2 = nrm((L, W_LORA, RW_WIDTH), 0.5 * W_LORA ** -0.5)
    rwkv_a0 = nrm((L, RW_WIDTH), 0.1)
    rwkv_a2 = nrm((L, A_LORA, RW_WIDTH), A_LORA ** -0.5)
    rwkv_g2 = nrm((L, G_LORA, RW_WIDTH), G_LORA ** -0.5)
    rwkv_kk = 0.85 + nrm((L, RW_WIDTH), 0.02)
    rwkv_ka = 1.0 + nrm((L, RW_WIDTH), 0.02)
    rwkv_rk = nrm((L, RW_WIDTH), 0.1)
    rwkv_ln_w = 1.0 + nrm((L, RW_WIDTH), 0.02)
    rwkv_ln_b = nrm((L, RW_WIDTH), 0.02)
    w_out = nrm((L, MIX_WIDTH, D), MIX_WIDTH ** -0.5 * DN_BETA)
    ln1_w = 1.0 + nrm((L, D), 0.02)
    ln1_b = nrm((L, D), 0.02)
    w_ff1 = nrm((L, D, D_FF), D ** -0.5)
    w_ff2 = nrm((L, D_FF, D), D_FF ** -0.5 * DN_BETA)
    ln2_w = 1.0 + nrm((L, D), 0.02)
    ln2_b = nrm((L, D), 0.02)
    return {'x_prompt': x_prompt, 'x_sample': x_sample, 'c_prompt': c_prompt, 'c_sample': c_sample,
            'state_gdn': state_gdn, 'state_gdn_conv': state_gdn_conv, 'state_rwkv': state_rwkv,
            'state_rwkv_shift': state_rwkv_shift, 'w_ada': w_ada, 'b_ada': b_ada, 'w_in': w_in,
            'gdn_conv_w': gdn_conv_w, 'gdn_a_log': gdn_a_log, 'gdn_dt_bias': gdn_dt_bias,
            'gdn_norm_w': gdn_norm_w, 'rwkv_mu': rwkv_mu, 'rwkv_w0': rwkv_w0, 'rwkv_w2': rwkv_w2,
            'rwkv_a0': rwkv_a0, 'rwkv_a2': rwkv_a2, 'rwkv_g2': rwkv_g2, 'rwkv_kk': rwkv_kk,
            'rwkv_ka': rwkv_ka, 'rwkv_rk': rwkv_rk, 'rwkv_ln_w': rwkv_ln_w, 'rwkv_ln_b': rwkv_ln_b,
            'w_out': w_out, 'ln1_w': ln1_w, 'ln1_b': ln1_b, 'w_ff1': w_ff1, 'w_ff2': w_ff2,
            'ln2_w': ln2_w, 'ln2_b': ln2_b}


def reference(x_prompt, x_sample, c_prompt, c_sample, state_gdn, state_gdn_conv, state_rwkv,
              state_rwkv_shift, w_ada, b_ada, w_in, gdn_conv_w, gdn_a_log, gdn_dt_bias, gdn_norm_w,
              rwkv_mu, rwkv_w0, rwkv_w2, rwkv_a0, rwkv_a2, rwkv_g2, rwkv_kk, rwkv_ka, rwkv_rk,
              rwkv_ln_w, rwkv_ln_b, w_out, ln1_w, ln1_b, w_ff1, w_ff2, ln2_w, ln2_b):
    p = dict(w_ada=w_ada, b_ada=b_ada, w_in=w_in, gdn_conv_w=gdn_conv_w, gdn_a_log=gdn_a_log,
             gdn_dt_bias=gdn_dt_bias, gdn_norm_w=gdn_norm_w, rwkv_mu=rwkv_mu, rwkv_w0=rwkv_w0,
             rwkv_w2=rwkv_w2, rwkv_a0=rwkv_a0, rwkv_a2=rwkv_a2, rwkv_g2=rwkv_g2, rwkv_kk=rwkv_kk,
             rwkv_ka=rwkv_ka, rwkv_rk=rwkv_rk, rwkv_ln_w=rwkv_ln_w, rwkv_ln_b=rwkv_ln_b, w_out=w_out,
             ln1_w=ln1_w, ln1_b=ln1_b, w_ff1=w_ff1, w_ff2=w_ff2, ln2_w=ln2_w, ln2_b=ln2_b)
    bp = x_prompt.shape[0]
    dt = x_prompt.dtype
    y_prompt, p_gdn, p_conv, p_rw, p_shift = _trunk(
        x_prompt, c_prompt,
        jnp.zeros((DEPTH, bp, GDN_HEADS, GDN_DK, GDN_DV), dt),
        jnp.zeros((DEPTH, bp, CONV_W - 1, GDN_QKV), dt),
        jnp.zeros((DEPTH, bp, RW_HEADS, RW_HD, RW_HD), dt),
        jnp.zeros((DEPTH, bp, RW_PROJ), dt),
        p, CHUNK)
    y_sample, s_gdn, s_conv, s_rw, s_shift = _trunk(
        x_sample, c_sample, state_gdn, state_gdn_conv, state_rwkv, state_rwkv_shift,
        p, x_sample.shape[1])
    return (y_prompt, y_sample, p_gdn, p_conv, p_rw, p_shift, s_gdn, s_conv, s_rw, s_shift)
```

```cpp
#include <hip/hip_runtime.h>
#include <hip/hip_cooperative_groups.h>
#include <cstdio>
#include <cstdint>
namespace cg = cooperative_groups;

#ifndef MK_ONE_LAUNCH
#define MK_ONE_LAUNCH 1
#define DBL_MASK 0x6
#endif

typedef unsigned short bf16_t;
typedef short bf16x8 __attribute__((ext_vector_type(8)));
typedef float f32x4 __attribute__((ext_vector_type(4)));
typedef float f32x2 __attribute__((ext_vector_type(2)));
typedef unsigned u32x4 __attribute__((ext_vector_type(4)));
typedef unsigned u32x2 __attribute__((ext_vector_type(2)));

constexpr int DM = 1024, NTOK = 33280, NTP = 32768, NSEQ = 24, NLAYER = 4;
constexpr int PJ = 4096;
constexpr int PTOT = 3848;
constexpr int C_Z = 1536, C_RW = 2048, C_GA = 3840, C_GB = 3844;
constexpr int DFF = 4096;
constexpr int RWP = 1792;
constexpr float DN_ALPHA = 1.681792830507429f;
constexpr int LDS_BYTES = 151552;
constexpr int NPHASE = 2 + 9 * NLAYER;

constexpr size_t WS_MOD = 0;
constexpr size_t WS_WIN = 2359296;
constexpr size_t WS_WOUT = WS_WIN + 8388608;
constexpr size_t WS_W1 = WS_WOUT + 2097152;
constexpr size_t WS_W2 = WS_W1 + 8388608;
constexpr size_t WS_LW2 = WS_W2 + 8388608;
constexpr size_t WS_LA2 = WS_LW2 + 65536;
constexpr size_t WS_LG2 = WS_LA2 + 65536;
constexpr size_t WS_DL = WS_LG2 + 131072;
constexpr size_t WS_H = WS_DL + 16384;
constexpr size_t WS_R1 = WS_H + 68157440;
constexpr size_t WS_PREP = WS_R1 + 272629760;
constexpr size_t WS_BAR = WS_PREP + 153354240;
constexpr size_t WS_END = WS_BAR + 16384;
constexpr int PREP_STRIDE = 36864;
constexpr int PO_U0T = 0, PO_WKN = 8192, PO_QD = 16384, PO_KDT = 24576, PO_QK = 32768;

constexpr size_t O_PGDN = 34078720, O_PCONV = 38273024, O_PRW = 38567936, O_PSHIFT = 40665088;
constexpr size_t O_SGDN = 40779776, O_SCONV = 42876928, O_SRW = 43024384, O_SSHIFT = 44072960;

struct Ctx { int tid, bid, nb; };
struct Params {
    const float* in[33];
    float* out;
    unsigned char* ws;
    int ph_lo, ph_hi;
};

extern __shared__ __attribute__((aligned(16))) unsigned char smem[];

typedef __bf16 bf16x2_t __attribute__((ext_vector_type(2)));
__device__ __forceinline__ unsigned cvt_pk_bf16(float lo, float hi) { f32x2 f = {lo, hi}; bf16x2_t v = __builtin_convertvector(f, bf16x2_t); return __builtin_bit_cast(unsigned, v); }
__device__ __forceinline__ bf16_t f2bf(float f) { return (bf16_t)(cvt_pk_bf16(f, 0.f) & 0xffffu); }
__device__ __forceinline__ float bf2f(bf16_t b) { return __uint_as_float(((unsigned)b) << 16); }
__device__ __forceinline__ float bflo(unsigned w) { return __uint_as_float(w << 16); }
__device__ __forceinline__ float bfhi(unsigned w) { return __uint_as_float(w & 0xffff0000u); }
__device__ __forceinline__ void unpack8(u32x4 w, float* f) {
    f[0] = bflo(w.x); f[1] = bfhi(w.x); f[2] = bflo(w.y); f[3] = bfhi(w.y);
    f[4] = bflo(w.z); f[5] = bfhi(w.z); f[6] = bflo(w.w); f[7] = bfhi(w.w);
}
__device__ __forceinline__ u32x4 pack8(const float* f) {
    u32x4 w; w.x = cvt_pk_bf16(f[0], f[1]); w.y = cvt_pk_bf16(f[2], f[3]); w.z = cvt_pk_bf16(f[4], f[5]); w.w = cvt_pk_bf16(f[6], f[7]); return w;
}
__device__ __forceinline__ float silu_f(float x) { return x / (1.f + __expf(-x)); }
__device__ __forceinline__ float sigmoid_f(float x) { return 1.f / (1.f + __expf(-x)); }
__device__ __forceinline__ float softplus_f(float x) { return fmaxf(x, 0.f) + __logf(1.f + __expf(-fabsf(x))); }
__device__ __forceinline__ float tanh_f(float x) { return 1.f - 2.f / (1.f + __expf(2.f * x)); }
__device__ __forceinline__ float dpp_x1(float x) { return __int_as_float(__builtin_amdgcn_mov_dpp(__float_as_int(x), 0xB1, 0xF, 0xF, true)); }
__device__ __forceinline__ float dpp_x2(float x) { return __int_as_float(__builtin_amdgcn_mov_dpp(__float_as_int(x), 0x4E, 0xF, 0xF, true)); }
__device__ __forceinline__ float dpp_hm(float x) { return __int_as_float(__builtin_amdgcn_mov_dpp(__float_as_int(x), 0x141, 0xF, 0xF, true)); }
__device__ __forceinline__ float dpp_rm(float x) { return __int_as_float(__builtin_amdgcn_mov_dpp(__float_as_int(x), 0x140, 0xF, 0xF, true)); }
__device__ __forceinline__ float red8(float x) { x += dpp_x1(x); x += dpp_x2(x); x += dpp_hm(x); return x; }
__device__ __forceinline__ float red16(float x) { x = red8(x); x += dpp_rm(x); return x; }
__device__ __forceinline__ float wave_sum(float v) {
#pragma unroll
    for (int o = 1; o < 64; o <<= 1) v += __shfl_xor(v, o);
    return v;
}
__device__ __forceinline__ int seq_of_row(int row) { return row < NTP ? (row >> 11) : 16 + ((row - NTP) >> 6); }
#define LDS_WAIT() asm volatile("s_waitcnt lgkmcnt(0)" ::: "memory")

__device__ __forceinline__ void phase_mod(const Ctx& cx, const Params& p) {
    float* sc = (float*)smem;
    const int tid = cx.tid;
    const float* c_p = p.in[2]; const float* c_s = p.in[3];
    const float* w_ada = p.in[8]; const float* b_ada = p.in[9];
    float* MOD = (float*)(p.ws + WS_MOD);
    for (int item = cx.bid; item < NLAYER * 96; item += cx.nb) {
        const int l = item / 96, cgp = item % 96;
        for (int idx = tid; idx < 24 * 1024; idx += 512) {
            const int s = idx >> 10, k = idx & 1023;
            const float c = s < 16 ? c_p[s * 1024 + k] : c_s[(s - 16) * 1024 + k];
            sc[k * 24 + s] = silu_f(c);
        }
        __syncthreads();
        const int kg = tid >> 6, col = tid & 63;
        float acc[24];
#pragma unroll
        for (int s = 0; s < 24; ++s) acc[s] = 0.f;
        const float* wp = w_ada + (size_t)l * 1024 * 6144 + (size_t)(kg * 128) * 6144 + cgp * 64 + col;
#pragma unroll 16
        for (int k = 0; k < 128; ++k) {
            const float w = wp[(size_t)k * 6144];
            const f32x4* sp = (const f32x4*)(sc + (kg * 128 + k) * 24);
#pragma unroll
            for (int q = 0; q < 6; ++q) { const f32x4 v = sp[q]; acc[4 * q] += v.x * w; acc[4 * q + 1] += v.y * w; acc[4 * q + 2] += v.z * w; acc[4 * q + 3] += v.w * w; }
        }
        __syncthreads();
#pragma unroll
        for (int s = 0; s < 24; ++s) sc[(kg * 24 + s) * 64 + col] = acc[s];
        __syncthreads();
        for (int o = tid; o < 24 * 64; o += 512) {
            const int s = o >> 6, c = o & 63;
            float sum = b_ada[l * 6144 + cgp * 64 + c];
#pragma unroll
            for (int g = 0; g < 8; ++g) sum += sc[(g * 24 + s) * 64 + c];
            MOD[(size_t)(l * 24 + s) * 6144 + cgp * 64 + c] = sum;
        }
        __syncthreads();
    }
}

__device__ __forceinline__ int win_map(int n) { return n < 2048 ? n : (n < 2056 ? n - 2048 + C_GA : n - 8); }
__device__ __forceinline__ void transpose_w(const Ctx& cx, const float* W, int K, int N, bf16_t* WT, int mode, int gw, int NGW, int rot) {
    const int lane = cx.tid & 63, wave = cx.tid >> 6;
    float* scr = (float*)(smem + wave * 8448);
    const int nblk = (N + 31) / 32, nitems = (K / 64) * nblk;
    int start = gw - rot; while (start < 0) start += NGW;
    for (int it = start; it < nitems; it += NGW) {
        const int kb = it / nblk, nb = it % nblk, k0 = 64 * kb, n0 = 32 * nb;
        const int nn = n0 + (lane & 31);
#pragma unroll
        for (int i = 0; i < 32; ++i) { const int kk = 2 * i + (lane >> 5); scr[kk * 33 + (lane & 31)] = nn < N ? W[(size_t)(k0 + kk) * N + nn] : 0.f; }
        LDS_WAIT();
        const int c = lane & 7;
#pragma unroll
        for (int j = 0; j < 4; ++j) {
            const int nl = (lane >> 3) + 8 * j, n = n0 + nl;
            const float* s = scr + (8 * c) * 33 + nl;
            u32x4 o; o.x = cvt_pk_bf16(s[0], s[33]); o.y = cvt_pk_bf16(s[66], s[99]); o.z = cvt_pk_bf16(s[132], s[165]); o.w = cvt_pk_bf16(s[198], s[231]);
            if (n < N) { const int row = mode ? win_map(n) : n; *(u32x4*)(WT + (size_t)row * K + k0 + 8 * c) = o; }
        }
        LDS_WAIT();
    }
}
__device__ __forceinline__ void phase_weights(const Ctx& cx, const Params& p, int l) {
    const int gw = cx.bid * 8 + (cx.tid >> 6), NGW = cx.nb * 8;
    unsigned char* ws = p.ws;
    transpose_w(cx, p.in[10] + (size_t)l * 1024 * PTOT, 1024, PTOT, (bf16_t*)(ws + WS_WIN), 1, gw, NGW, 0);
    transpose_w(cx, p.in[26] + (size_t)l * 1024 * 1024, 1024, 1024, (bf16_t*)(ws + WS_WOUT), 0, gw, NGW, 1936 % NGW);
    transpose_w(cx, p.in[29] + (size_t)l * 1024 * 4096, 1024, 4096, (bf16_t*)(ws + WS_W1), 0, gw, NGW, (1936 + 512) % NGW);
    transpose_w(cx, p.in[30] + (size_t)l * 4096 * 1024, 4096, 1024, (bf16_t*)(ws + WS_W2), 0, gw, NGW, (1936 + 512 + 2048) % NGW);
    transpose_w(cx, p.in[17] + (size_t)l * 64 * 512, 64, 512, (bf16_t*)(ws + WS_LW2), 0, gw, NGW, (1936 + 512 + 4096) % NGW);
    transpose_w(cx, p.in[19] + (size_t)l * 64 * 512, 64, 512, (bf16_t*)(ws + WS_LA2), 0, gw, NGW, (1936 + 512 + 4096 + 16) % NGW);
    transpose_w(cx, p.in[20] + (size_t)l * 128 * 512, 128, 512, (bf16_t*)(ws + WS_LG2), 0, gw, NGW, (1936 + 512 + 4096 + 32) % NGW);
    u32x4* z = (u32x4*)(ws + WS_WIN + (size_t)PTOT * 1024 * 2);
    const u32x4 zero = {0u, 0u, 0u, 0u};
    for (int i = cx.bid * 512 + cx.tid; i < (PJ - PTOT) * 128; i += cx.nb * 512) z[i] = zero;
}

__device__ __forceinline__ void phase_mod0(const Ctx& cx, const Params& p) {
    const int lane = cx.tid & 63;
    const int gw = cx.bid * 8 + (cx.tid >> 6), NGW = cx.nb * 8;
    const float* MOD = (const float*)(p.ws + WS_MOD);
    bf16_t* H = (bf16_t*)(p.ws + WS_H);
#pragma unroll 2
    for (int row = gw; row < NTOK; row += NGW) {
        const float* xr = row < NTP ? p.in[0] + (size_t)row * 1024 : p.in[1] + (size_t)(row - NTP) * 1024;
        const float* md = MOD + (size_t)seq_of_row(row) * 6144;
#pragma unroll
        for (int j = 0; j < 4; ++j) {
            const int col = lane * 4 + 256 * j;
            const f32x4 x = *(const f32x4*)(xr + col), sh = *(const f32x4*)(md + col), scv = *(const f32x4*)(md + 1024 + col);
            u32x2 o; o.x = cvt_pk_bf16(x.x * (1.f + scv.x) + sh.x, x.y * (1.f + scv.y) + sh.y); o.y = cvt_pk_bf16(x.z * (1.f + scv.z) + sh.z, x.w * (1.f + scv.w) + sh.w);
            *(u32x2*)(H + (size_t)row * 1024 + col) = o;
        }
    }
}

__device__ __forceinline__ void phase_ln(const Ctx& cx, const Params& p, const float* lw, const float* lb, const float* modl  , int sh_off, int sc_off, bool final_out) {
    const int lane = cx.tid & 63;
    const int gw = cx.bid * 8 + (cx.tid >> 6), NGW = cx.nb * 8;
    float* X = p.out;
    bf16_t* H = (bf16_t*)(p.ws + WS_H);
#ifndef REP_LN
#define REP_LN 0
#endif
    for (int rep = 0; rep <= REP_LN; ++rep)
    for (int row = gw; row < NTOK; row += NGW) {
        const bool dry = rep < REP_LN;
        float* xr = X + (size_t)row * 1024;
        const bf16_t* vr = (const bf16_t*)(p.ws + WS_PREP) + (size_t)row * 1024;
        f32x4 v[4]; float s = 0.f;
#pragma unroll
        for (int j = 0; j < 4; ++j) { const u32x2 w = *(const u32x2*)(vr + lane * 4 + 256 * j); v[j] = (f32x4){bflo(w.x), bfhi(w.x), bflo(w.y), bfhi(w.y)}; s += (v[j].x + v[j].y) + (v[j].z + v[j].w); }
        const float mean = wave_sum(s) * (1.f / 1024.f); float s2 = 0.f;
#pragma unroll
        for (int j = 0; j < 4; ++j) { v[j] = v[j] - mean; s2 += (v[j].x * v[j].x + v[j].y * v[j].y) + (v[j].z * v[j].z + v[j].w * v[j].w); }
        const float rstd = rsqrtf(wave_sum(s2) * (1.f / 1024.f) + 1e-5f);
        if (dry && rstd != -1.f) continue;
        const float* md = modl ? modl + (size_t)seq_of_row(row) * 6144 : nullptr;
#pragma unroll
        for (int j = 0; j < 4; ++j) {
            const int col = lane * 4 + 256 * j;
            const f32x4 w = *(const f32x4*)(lw + col), b = *(const f32x4*)(lb + col);
            const f32x4 x = v[j] * rstd * w + b;
            if (final_out) *(f32x4*)(xr + col) = x;
            else { u32x2 ox; ox.x = cvt_pk_bf16(x.x, x.y); ox.y = cvt_pk_bf16(x.z, x.w); *(u32x2*)((bf16_t*)X + (size_t)row * 1024 + col) = ox; }
            if (md) {
                const f32x4 sh = *(const f32x4*)(md + sh_off + col), scv = *(const f32x4*)(md + sc_off + col);
                u32x2 o; o.x = cvt_pk_bf16(x.x * (1.f + scv.x) + sh.x, x.y * (1.f + scv.y) + sh.y); o.y = cvt_pk_bf16(x.z * (1.f + scv.z) + sh.z, x.w * (1.f + scv.w) + sh.w);
                *(u32x2*)(H + (size_t)row * 1024 + col) = o;
            }
        }
    }
}

#define LAS __attribute__((address_space(3)))
namespace gm {
constexpr int BM = 256, BK = 64, HALF = 128, HTB = HALF * BK * 2, NXCD = 8, WGM = 8;
__device__ __forceinline__ int lds_byte(int r, int c) { const int st = (r >> 4) * 2 + (c >> 5), rr = r & 15, cc = c & 31, ob = rr * 64 + cc * 2; return st * 1024 + (ob ^ (((ob >> 9) & 1) << 5)); }
__device__ __forceinline__ void stage_rc(int b, int& R, int& C) { const int st = b / 1024, sb = b % 1024, swz = sb ^ (((sb >> 9) & 1) << 5); R = (st >> 1) * 16 + swz / 64; C = (st & 1) * 32 + (swz % 64) / 2; }
__device__ __forceinline__ int perm32(int rho) { const int n = rho >> 4, i = rho & 15; return 8 * (i >> 2) + 4 * n + (i & 3); }
struct Unit { int pm, pn; };
struct Order {
    int nM, nN, nwg, G, c;
    __device__ __forceinline__ bool next(int i, Unit& u) const {
        const long L = (long)i * G + c; if (L >= nwg) return false;
        int wgid = (int)L; { const int q = nwg / NXCD, r = nwg % NXCD, xcd = wgid % NXCD, off = wgid / NXCD; wgid = (xcd < r ? xcd * (q + 1) : r * (q + 1) + (xcd - r) * q) + off; }
        const int nig = WGM * nN, gid = wgid / nig, fm = gid * WGM, gsz = (nM - fm) < WGM ? (nM - fm) : WGM;
        u.pm = fm + ((wgid % nig) % gsz); u.pn = (wgid % nig) / gsz; return true;
    }
};
struct Epi {
    int kind;
    bf16_t* O; int ldo;
    const float* xp; const float* xs; float* X; const float* gate;
    const bf16_t* xb;
};
__device__ __forceinline__ void epilogue(const Epi& E, const f32x4 (&acc)[2][2][4][2], const Unit& u, int wr, int wc, int fr, int fq) {
    const int brow = u.pm * BM, bcol = u.pn * BM;
    if (E.kind == 0) return;
    if (E.kind == 2) {
#pragma unroll
        for (int ai = 0; ai < 2; ++ai)
#pragma unroll
            for (int m = 0; m < 4; ++m) {
                const int row = brow + ai * HALF + wr * 64 + m * 16 + fr;
                const float* xsrc = (row < NTP ? E.xp : E.xs) + (size_t)row * 1024;
                const bf16_t* xb = E.xb + (size_t)row * 1024;
                const float* gt = E.gate + (size_t)seq_of_row(row) * 6144;
                bf16_t* xo = E.O + (size_t)row * 1024;
#pragma unroll
                for (int bj = 0; bj < 2; ++bj) {
                    const int col = bcol + bj * HALF + wc * 32 + fq * 8;
                    f32x4 x0, x1;
                    if (E.xb) { const u32x4 w = *(const u32x4*)(xb + col); x0 = (f32x4){bflo(w.x), bfhi(w.x), bflo(w.y), bfhi(w.y)}; x1 = (f32x4){bflo(w.z), bfhi(w.z), bflo(w.w), bfhi(w.w)}; }
                    else { x0 = *(const f32x4*)(xsrc + col); x1 = *(const f32x4*)(xsrc + col + 4); }
                    const f32x4 g0 = *(const f32x4*)(gt + col), g1 = *(const f32x4*)(gt + col + 4);
                    const f32x4 v0 = x0 * DN_ALPHA + g0 * acc[ai][bj][m][0], v1 = x1 * DN_ALPHA + g1 * acc[ai][bj][m][1];
                    u32x4 o; o.x = cvt_pk_bf16(v0.x, v0.y); o.y = cvt_pk_bf16(v0.z, v0.w); o.z = cvt_pk_bf16(v1.x, v1.y); o.w = cvt_pk_bf16(v1.z, v1.w);
                    *(u32x4*)(xo + col) = o;
                }
            }
    } else {
        const bool sq = (E.kind == 3);
#pragma unroll
        for (int ai = 0; ai < 2; ++ai)
#pragma unroll
            for (int m = 0; m < 4; ++m) {
                const int row = brow + ai * HALF + wr * 64 + m * 16 + fr;
                bf16_t* orow = E.O + (size_t)row * E.ldo;
#pragma unroll
                for (int bj = 0; bj < 2; ++bj) {
                    const int col = bcol + bj * HALF + wc * 32 + fq * 8;
                    f32x4 v0 = acc[ai][bj][m][0], v1 = acc[ai][bj][m][1];
                    if (sq) {
                        v0.x = fmaxf(v0.x, 0.f); v0.y = fmaxf(v0.y, 0.f); v0.z = fmaxf(v0.z, 0.f); v0.w = fmaxf(v0.w, 0.f); v0 = v0 * v0;
                        v1.x = fmaxf(v1.x, 0.f); v1.y = fmaxf(v1.y, 0.f); v1.z = fmaxf(v1.z, 0.f); v1.w = fmaxf(v1.w, 0.f); v1 = v1 * v1;
                    }
                    u32x4 o; o.x = cvt_pk_bf16(v0.x, v0.y); o.y = cvt_pk_bf16(v0.z, v0.w); o.z = cvt_pk_bf16(v1.x, v1.y); o.w = cvt_pk_bf16(v1.z, v1.w);
                    *(u32x4*)(orow + col) = o;
                }
            }
    }
}
}

__device__ __forceinline__ void gemm_phase(const Ctx& cx, const bf16_t* gA, const bf16_t* gBt, int M, int N, int K, const gm::Epi& E) {
    using namespace gm;
    LAS unsigned char* lds = (LAS unsigned char*)smem;
    Order S; S.nM = M / BM; S.nN = N / BM; S.nwg = S.nM * S.nN; S.G = cx.nb; S.c = cx.bid;
    const int tid = cx.tid, wid = __builtin_amdgcn_readfirstlane(tid >> 6), lane = tid & 63, wr = wid >> 2, wc = wid & 3, fr = lane & 15, fq = lane >> 4;
    const int nt = K / BK;
    unsigned voffA[2], voffB[2];
#pragma unroll
    for (int i = 0; i < 2; ++i) { int R, C; stage_rc(tid * 16 + i * 8192, R, C); const int Rb = (R & ~31) + perm32(R & 31);
        voffA[i] = (unsigned)(R * K + C) * 2u; voffB[i] = (unsigned)(Rb * K + C) * 2u; }
    const size_t kstep = (size_t)(BK * 2);
    const size_t hstep = (size_t)HALF * K * 2;
    const size_t tstep = 2 * hstep;
    const unsigned ldsw = (unsigned)wid * 1024u;
    const int aoff = lds_byte(wr * 64 + fr, fq * 8), boff = lds_byte(wc * 32 + fr, fq * 8);
#define PG8_SA(b, h) (((b) * 2 + (h)) * HTB)
#define PG8_SB(b, h) ((4 + (b) * 2 + (h)) * HTB)
#define PG8_STAGE(bufoff, gbase, voff) do { _Pragma("unroll") for (int _i = 0; _i < 2; ++_i) \
        __builtin_amdgcn_global_load_lds((const unsigned*)((const char*)(gbase) + (voff)[_i]), (LAS unsigned*)(lds + (bufoff) + ldsw + _i * 8192), 16, 0, 0); } while (0)
#define PG8_LDA(dst, b, h) do { _Pragma("unroll") for (int m = 0; m < 4; ++m) _Pragma("unroll") for (int k = 0; k < 2; ++k) dst[m][k] = *(const LAS bf16x8*)(lds + PG8_SA(b, h) + aoff + m * 2048 + k * 1024); } while (0)
#define PG8_LDB(dst, b, h) do { _Pragma("unroll") for (int n = 0; n < 2; ++n) _Pragma("unroll") for (int k = 0; k < 2; ++k) dst[n][k] = *(const LAS bf16x8*)(lds + PG8_SB(b, h) + boff + n * 2048 + k * 1024); } while (0)
#define PG8_MMA(ai, bj, At, Bt) do { __builtin_amdgcn_s_setprio(1); _Pragma("unroll") for (int m = 0; m < 4; ++m) _Pragma("unroll") for (int n = 0; n < 2; ++n) _Pragma("unroll") for (int k = 0; k < 2; ++k) \
        acc[ai][bj][m][n] = __builtin_amdgcn_mfma_f32_16x16x32_bf16(Bt[n][k], At[m][k], acc[ai][bj][m][n], 0, 0, 0); __builtin_amdgcn_s_setprio(0); } while (0)
#define PG8_WAIT_V(n) asm volatile("s_waitcnt vmcnt(" #n ")" ::: "memory")
#define PG8_WAIT_L(n) asm volatile("s_waitcnt lgkmcnt(" #n ")" ::: "memory")
#define PG8_BAR __builtin_amdgcn_s_barrier()
#define PG8_SCHED __builtin_amdgcn_sched_barrier(0)
    Unit cur, nxt; int ui = 0;
    if (S.next(0, cur)) {
    f32x4 acc[2][2][4][2];
#pragma unroll
    for (int a = 0; a < 2; ++a)
#pragma unroll
        for (int b = 0; b < 2; ++b)
#pragma unroll
            for (int m = 0; m < 4; ++m)
#pragma unroll
                for (int n = 0; n < 2; ++n) acc[a][b][m][n] = (f32x4){0.f, 0.f, 0.f, 0.f};
    bf16x8 At[4][2], B0[2][2], B1[2][2];
    const char* cA = (const char*)gA + (size_t)cur.pm * tstep; const char* cB = (const char*)gBt + (size_t)cur.pn * tstep;
    PG8_STAGE(PG8_SB(0, 0), cB, voffB); PG8_STAGE(PG8_SB(0, 1), cB + hstep, voffB); PG8_STAGE(PG8_SA(0, 0), cA, voffA); PG8_STAGE(PG8_SA(0, 1), cA + hstep, voffA);
    if (wr == 1) PG8_BAR;
    PG8_WAIT_V(2); PG8_BAR;
    PG8_STAGE(PG8_SB(1, 0), cB + kstep, voffB); PG8_STAGE(PG8_SA(1, 0), cA + kstep, voffA); PG8_STAGE(PG8_SB(1, 1), cB + hstep + kstep, voffB);
    PG8_WAIT_V(6); PG8_BAR;
    for (;;) {
        const bool has_next = S.next(ui + 1, nxt);
        const char* nA = has_next ? (const char*)gA + (size_t)nxt.pm * tstep : cA; const char* nB = has_next ? (const char*)gBt + (size_t)nxt.pn * tstep : cB;
        for (int t = 0; t < nt; t += 2) {
            const bool last = (t == nt - 2);
            const char* a1 = cA + (size_t)(t + 1) * kstep;
            const char* a2 = last ? nA : cA + (size_t)(t + 2) * kstep; const char* b2 = last ? nB : cB + (size_t)(t + 2) * kstep;
            const char* a3 = a2 + kstep; const char* b3 = b2 + kstep;
            PG8_LDB(B0, 0, 0); PG8_LDB(B1, 0, 1); PG8_SCHED; PG8_LDA(At, 0, 0); PG8_STAGE(PG8_SA(1, 1), a1 + hstep, voffA);
            PG8_WAIT_V(8); PG8_WAIT_L(0); PG8_BAR; PG8_MMA(0, 0, At, B0); PG8_MMA(0, 1, At, B1); PG8_BAR; PG8_SCHED;
            PG8_LDA(At, 0, 1); PG8_STAGE(PG8_SB(0, 0), b2, voffB); PG8_STAGE(PG8_SB(0, 1), b2 + hstep, voffB); PG8_STAGE(PG8_SA(0, 0), a2, voffA);
            PG8_WAIT_V(8); PG8_WAIT_L(0); PG8_BAR; PG8_MMA(1, 0, At, B0); PG8_MMA(1, 1, At, B1); PG8_BAR; PG8_SCHED;
            PG8_LDB(B0, 1, 0); PG8_LDB(B1, 1, 1); PG8_SCHED; PG8_LDA(At, 1, 0); PG8_STAGE(PG8_SA(0, 1), a2 + hstep, voffA);
            PG8_WAIT_V(8); PG8_WAIT_L(0); PG8_BAR; PG8_MMA(0, 0, At, B0); PG8_MMA(0, 1, At, B1); PG8_BAR; PG8_SCHED;
            PG8_LDA(At, 1, 1); PG8_STAGE(PG8_SB(1, 0), b3, voffB); PG8_STAGE(PG8_SB(1, 1), b3 + hstep, voffB); PG8_STAGE(PG8_SA(1, 0), a3, voffA);
            PG8_WAIT_V(8); PG8_WAIT_L(0); PG8_BAR; PG8_MMA(1, 0, At, B0); PG8_MMA(1, 1, At, B1); PG8_BAR; PG8_SCHED;
        }
        if (wr == 0) PG8_BAR;
        epilogue(E, acc, cur, wr, wc, fr, fq);
        if (!has_next) break;
#pragma unroll
        for (int a = 0; a < 2; ++a)
#pragma unroll
            for (int b = 0; b < 2; ++b)
#pragma unroll
                for (int m = 0; m < 4; ++m)
#pragma unroll
                    for (int n = 0; n < 2; ++n) acc[a][b][m][n] = (f32x4){0.f, 0.f, 0.f, 0.f};
        cur = nxt; cA = nA; cB = nB; ++ui;
        if (wr == 1) PG8_BAR;
    }
    PG8_WAIT_V(0);
    PG8_BAR;
    }
#undef PG8_SA
#undef PG8_SB
#undef PG8_STAGE
#undef PG8_LDA
#undef PG8_LDB
#undef PG8_MMA
}

__device__ __forceinline__ void tri_inv64(const float* AM, float* TF, float* WSB, int tid) {
    const int lane = tid & 63, wave = tid >> 6;
    if (wave == 0) {
        const int bb = lane >> 4, cc = lane & 15;
        const float* Ab = AM + (16 * bb) * 68 + 16 * bb;
        float x[16];
#pragma unroll
        for (int i = 0; i < 16; ++i) {
            float a = (i == cc) ? 1.f : 0.f;
#pragma unroll
            for (int j = 0; j < i; ++j) a -= Ab[i * 68 + j] * x[j];
            x[i] = a;
            TF[(16 * bb + i) * 68 + 16 * bb + cc] = a;
        }
    }
    __syncthreads();
    {
        const int g = tid >> 8, i = (tid >> 4) & 15, c = tid & 15, o = 32 * g;
        const float* ar = AM + (o + 16 + i) * 68 + o;
        float acc = 0.f;
#pragma unroll
        for (int k = 0; k < 16; ++k) acc += ar[k] * TF[(o + k) * 68 + o + c];
        WSB[(o + 16 + i) * 68 + o + c] = acc;
        __syncthreads();
        const float* dr = TF + (o + 16 + i) * 68 + o + 16;
        acc = 0.f;
#pragma unroll
        for (int k = 0; k < 16; ++k) acc += dr[k] * WSB[(o + 16 + k) * 68 + o + c];
        TF[(o + 16 + i) * 68 + o + c] = -acc;
    }
    __syncthreads();
    {
        const int i = tid >> 4, c = tid & 15;
        const float* ar = AM + (32 + i) * 68;
        float a0 = 0.f, a1 = 0.f;
#pragma unroll
        for (int k = 0; k < 16; ++k) a0 += ar[k] * TF[k * 68 + c];
#pragma unroll
        for (int k = 16; k < 32; ++k) { const float av = ar[k]; a0 += av * TF[k * 68 + c]; a1 += av * TF[k * 68 + 16 + c]; }
        WSB[(32 + i) * 68 + c] = a0; WSB[(32 + i) * 68 + 16 + c] = a1;
        __syncthreads();
        const float* dr = TF + (32 + i) * 68 + 32;
        a0 = 0.f; a1 = 0.f;
#pragma unroll
        for (int k = 0; k < 16; ++k) { const float dv = dr[k]; a0 += dv * WSB[(32 + k) * 68 + c]; a1 += dv * WSB[(32 + k) * 68 + 16 + c]; }
        if (i >= 16) {
#pragma unroll
            for (int k = 16; k < 32; ++k) { const float dv = dr[k]; a0 += dv * WSB[(32 + k) * 68 + c]; a1 += dv * WSB[(32 + k) * 68 + 16 + c]; }
        }
        TF[(32 + i) * 68 + c] = -a0; TF[(32 + i) * 68 + 16 + c] = -a1;
    }
}
__device__ __forceinline__ int swz_el(int row, int t) { return row * 72 + ((((t >> 3) ^ (row >> 3)) & 7) << 3) + (t & 7); }
__device__ __forceinline__ int swz_ch(int row, int c8) { return row * 72 + (((c8 ^ (row >> 3)) & 7) << 3); }

__device__ __forceinline__ void phase_gdn_prep(const Ctx& cx, const Params& p, int l) {
    const int tid = cx.tid, lane = tid & 63, wave = tid >> 6, fr = lane & 15, fq = lane >> 4;
    bf16_t* QN = (bf16_t*)(smem);
    bf16_t* KN = (bf16_t*)(smem + 17408);
    bf16_t* KBG = (bf16_t*)(smem + 34816);
    bf16_t* VB = (bf16_t*)(smem + 53248);
    float* AM = (float*)(smem + 71680);
    bf16_t* TM = (bf16_t*)(smem + 89088);
    float* GV = (float*)(smem + 98304);
    float* TF = (float*)(smem + 99328);
    float* WSB = (float*)(smem + 116736);
    const bf16_t* PROJ = (const bf16_t*)(p.ws + WS_R1);
    bf16_t* PREP = (bf16_t*)(p.ws + WS_PREP);
    float* DL = (float*)(p.ws + WS_DL);
    const float* convw = p.in[11] + (size_t)l * 4 * 1536;
    const float* conv_state = p.in[5];
#ifndef REP_PREP
#define REP_PREP 1
#endif
    for (int rep = 0; rep < REP_PREP; ++rep)
    for (int u = cx.bid; u < 2080; u += cx.nb) {
        const int c = u >> 2, h = u & 3, t0 = c * 64;
        const bool prompt = c < 512;
        const bool first = prompt ? ((c & 31) == 0) : true;
        const int sb = prompt ? 0 : (c - 512);
        bf16_t* P = PREP + (size_t)u * PREP_STRIDE;
#pragma unroll 1
        for (int pb = 0; pb < 2; ++pb) {
        u32x4 rawc[3][4];
#pragma unroll
        for (int pi = 0; pi < 3; ++pi) {
            const int ps = pb * 3 + pi;
            const int t = (ps & 1) * 32 + wave * 4 + fq, ch0 = (ps >> 1) * 512 + h * 128 + fr * 8;
#pragma unroll
            for (int j = 0; j < 4; ++j) { const int tt = t - 3 + j; rawc[pi][j] = *(const u32x4*)(PROJ + (size_t)(t0 + ((tt >= 0 || !first) ? tt : 0)) * PJ + ch0); }
        }
        if (pb == 0) {
        if (tid < 64) {
                const float ga = bf2f(PROJ[(size_t)(t0 + tid) * PJ + C_GA + h]), gb = bf2f(PROJ[(size_t)(t0 + tid) * PJ + C_GB + h]);
                float g = -__expf(p.in[12][l * 4 + h]) * softplus_f(ga + p.in[13][l * 4 + h]);
                GV[64 + tid] = sigmoid_f(gb);
#pragma unroll
                for (int off = 1; off < 64; off <<= 1) { const float o = __shfl_up(g, off); g += (tid >= off) ? o : 0.f; }
                GV[tid] = g;
            }
            __syncthreads();
        }
#pragma unroll
        for (int pi = 0; pi < 3; ++pi) {
            const int ps = pb * 3 + pi;
            const int kind = ps >> 1, t = (ps & 1) * 32 + wave * 4 + fq, cgp = fr;
            const int ch0 = kind * 512 + h * 128 + cgp * 8;
            float y[8];
#pragma unroll
            for (int e = 0; e < 8; ++e) y[e] = 0.f;
#pragma unroll
            for (int j = 0; j < 4; ++j) {
                const int tt = t - 3 + j;
                float x[8];
                if (tt >= 0 || !first) {
                    unpack8(rawc[pi][j], x);
                } else if (!prompt) {
                    const float* cs = conv_state + ((size_t)(l * 8 + sb) * 3 + (tt + 3)) * 1536 + ch0;
                    const f32x4 a = *(const f32x4*)cs, b = *(const f32x4*)(cs + 4);
                    x[0] = a.x; x[1] = a.y; x[2] = a.z; x[3] = a.w; x[4] = b.x; x[5] = b.y; x[6] = b.z; x[7] = b.w;
                } else {
#pragma unroll
                    for (int e = 0; e < 8; ++e) x[e] = 0.f;
                }
                const f32x4 w0 = *(const f32x4*)(convw + j * 1536 + ch0), w1 = *(const f32x4*)(convw + j * 1536 + ch0 + 4);
                y[0] += x[0] * w0.x; y[1] += x[1] * w0.y; y[2] += x[2] * w0.z; y[3] += x[3] * w0.w;
                y[4] += x[4] * w1.x; y[5] += x[5] * w1.y; y[6] += x[6] * w1.z; y[7] += x[7] * w1.w;
            }
            float ss = 0.f;
#pragma unroll
            for (int e = 0; e < 8; ++e) { y[e] = silu_f(y[e]); ss += y[e] * y[e]; }
            const float gt = GV[t], bt = GV[64 + t];
            if (kind == 0) {
                ss = red16(ss);
                const float rn = rsqrtf(ss + 1e-6f) * 0.08838834764831845f;
                float q[8], qd[8]; const float eg = __expf(gt);
#pragma unroll
                for (int e = 0; e < 8; ++e) { q[e] = y[e] * rn; qd[e] = q[e] * eg; }
                *(u32x4*)(QN + t * 136 + cgp * 8) = pack8(q);
                *(u32x4*)(P + PO_QD + t * 128 + cgp * 8) = pack8(qd);
            } else if (kind == 1) {
                ss = red16(ss);
                const float rn = rsqrtf(ss + 1e-6f);
                float k[8]; const float sc2 = bt * __expf(gt);
#pragma unroll
                for (int e = 0; e < 8; ++e) { k[e] = y[e] * rn; KBG[swz_el(cgp * 8 + e, t)] = f2bf(k[e] * sc2); }
                *(u32x4*)(KN + t * 136 + cgp * 8) = pack8(k);
            } else {
#pragma unroll
                for (int e = 0; e < 8; ++e) VB[swz_el(cgp * 8 + e, t)] = f2bf(y[e] * bt);
            }
        }
        }
        __syncthreads();
        const float g_last = GV[63];
        if (h == 0 && (!prompt || (c & 31) == 31)) {
            float* co = p.out + (prompt ? O_PCONV + (size_t)(l * 16 + (c >> 5)) * 4608 : O_SCONV + (size_t)(l * 8 + sb) * 4608);
            for (int i = tid; i < 4608; i += 512) { const int r = i / 1536, ch = i % 1536; co[i] = bf2f(PROJ[(size_t)(t0 + 61 + r) * PJ + ch]); }
        }
        {
            const int d = tid >> 2, tq = tid & 3;
            float v[16];
#pragma unroll
            for (int i = 0; i < 16; ++i) { const int t = tq * 16 + i; v[i] = bf2f(KN[t * 136 + d]) * __expf(g_last - GV[t]); }
            *(u32x4*)(P + PO_KDT + d * 64 + tq * 16) = pack8(v);
            *(u32x4*)(P + PO_KDT + d * 64 + tq * 16 + 8) = pack8(v + 8);
        }
#pragma unroll
        for (int q = 0; q < 2; ++q) {
            const int tile = wave * 2 + q, tm = tile >> 2, tn = tile & 3;
            f32x4 akk = {0.f, 0.f, 0.f, 0.f}, aqk = {0.f, 0.f, 0.f, 0.f};
#pragma unroll
            for (int kk = 0; kk < 4; ++kk) {
                const bf16x8 ka = *(const bf16x8*)(KN + (tm * 16 + fr) * 136 + kk * 32 + fq * 8);
                const bf16x8 kb = *(const bf16x8*)(KN + (tn * 16 + fr) * 136 + kk * 32 + fq * 8);
                const bf16x8 qb = *(const bf16x8*)(QN + (tn * 16 + fr) * 136 + kk * 32 + fq * 8);
                akk = __builtin_amdgcn_mfma_f32_16x16x32_bf16(ka, kb, akk, 0, 0, 0);
                aqk = __builtin_amdgcn_mfma_f32_16x16x32_bf16(ka, qb, aqk, 0, 0, 0);
            }
            {
                const int i = tn * 16 + fr; const float gi = GV[i];
#pragma unroll
                for (int j = 0; j < 4; ++j) { const int t = tm * 16 + fq * 4 + j; AM[t * 68 + i] = (t > i) ? GV[64 + t] * akk[j] * __expf(GV[t] - gi) : 0.f; }
            }
            {
                const int t = tn * 16 + fr; const float gtt = GV[t]; float o[4];
#pragma unroll
                for (int j = 0; j < 4; ++j) { const int i = tm * 16 + fq * 4 + j; o[j] = (t >= i) ? aqk[j] * __expf(gtt - GV[i]) : 0.f; }
                u32x2 w; w.x = cvt_pk_bf16(o[0], o[1]); w.y = cvt_pk_bf16(o[2], o[3]);
                *(u32x2*)(P + PO_QK + t * 64 + tm * 16 + fq * 4) = w;
            }
        }
        __syncthreads();
        tri_inv64(AM, TF, WSB, tid);
        __syncthreads();
        for (int e = tid; e < 4096; e += 512) {
            const int i = e >> 6, cc = e & 63;
            TM[i * 72 + cc] = ((cc >> 4) <= (i >> 4)) ? f2bf(TF[i * 68 + cc]) : (bf16_t)0;
        }
        if (tid == 64) DL[u] = __expf(g_last);
        __syncthreads();
        {
            const int tm = wave & 3, vh = wave >> 2;
            bf16x8 ta[2];
#pragma unroll
            for (int kk = 0; kk < 2; ++kk) ta[kk] = *(const bf16x8*)(TM + (tm * 16 + fr) * 72 + kk * 32 + fq * 8);
#pragma unroll
            for (int n = 0; n < 4; ++n) {
                const int v = (vh * 4 + n) * 16 + fr;
                f32x4 a = {0.f, 0.f, 0.f, 0.f};
#pragma unroll
                for (int kk = 0; kk < 2; ++kk) a = __builtin_amdgcn_mfma_f32_16x16x32_bf16(ta[kk], *(const bf16x8*)(VB + swz_ch(v, kk * 4 + fq)), a, 0, 0, 0);
                u32x2 w; w.x = cvt_pk_bf16(a[0], a[1]); w.y = cvt_pk_bf16(a[2], a[3]);
                *(u32x2*)(P + PO_U0T + v * 64 + tm * 16 + fq * 4) = w;
            }
            bf16x8 ka[2];
#pragma unroll
            for (int kk = 0; kk < 2; ++kk) ka[kk] = *(const bf16x8*)(KBG + swz_ch(wave * 16 + fr, kk * 4 + fq));
#pragma unroll
            for (int tn = 0; tn < 4; ++tn) {
                f32x4 a = {0.f, 0.f, 0.f, 0.f};
#pragma unroll
                for (int kk = 0; kk < 2; ++kk) a = __builtin_amdgcn_mfma_f32_16x16x32_bf16(ka[kk], *(const bf16x8*)(TM + (tn * 16 + fr) * 72 + kk * 32 + fq * 8), a, 0, 0, 0);
                u32x2 w; w.x = cvt_pk_bf16(-a[0], -a[1]); w.y = cvt_pk_bf16(-a[2], -a[3]);
                *(u32x2*)(P + PO_WKN + (tn * 16 + fr) * 128 + wave * 16 + fq * 4) = w;
            }
        }
        __syncthreads();
    }
}

__device__ __forceinline__ void gdn_scan_unit(const Ctx& cx, const Params& p, int l, int seq, int h) {
    const int tid = cx.tid, lane = tid & 63, wave = tid >> 6, fr = lane & 15, fq = lane >> 4;
    bf16_t* ST = (bf16_t*)(smem);
    bf16_t* UT = (bf16_t*)(smem + 34816);
    float* OB = (float*)(smem + 53248);
    const bf16_t* PROJ = (const bf16_t*)(p.ws + WS_R1);
    const bf16_t* PREP = (const bf16_t*)(p.ws + WS_PREP);
    const float* DL = (const float*)(p.ws + WS_DL);
    bf16_t* YIN = (bf16_t*)(p.ws + WS_H);
    const bool prompt = seq < 16;
    const int b = prompt ? seq : seq - 16;
    const int nch = prompt ? 32 : 1;
    const float* nw = p.in[14] + l * 128;
    f32x4 S[8];
    if (prompt) {
#pragma unroll
        for (int n = 0; n < 8; ++n) S[n] = (f32x4){0.f, 0.f, 0.f, 0.f};
    } else {
        const float* s0 = p.in[4] + ((size_t)(l * 8 + b) * 4 + h) * 16384;
#pragma unroll
        for (int n = 0; n < 8; ++n)
#pragma unroll
            for (int j = 0; j < 4; ++j) S[n][j] = s0[(wave * 16 + fq * 4 + j) * 128 + n * 16 + fr];
    }
#pragma unroll
    for (int n = 0; n < 8; ++n) { u32x2 w; w.x = cvt_pk_bf16(S[n][0], S[n][1]); w.y = cvt_pk_bf16(S[n][2], S[n][3]); *(u32x2*)(ST + (n * 16 + fr) * 136 + wave * 16 + fq * 4) = w; }
    __syncthreads();
    const int tm = wave & 3, vh = wave >> 2;
#pragma unroll 1
    for (int ci = 0; ci < nch; ++ci) {
        const int c = prompt ? seq * 32 + ci : 512 + b;
        const int u = c * 4 + h, t0 = c * 64;
        const bf16_t* P = PREP + (size_t)u * PREP_STRIDE;
        bf16x8 wkn[4], qd[4], qk[2], kdt[2];
#pragma unroll
        for (int kk = 0; kk < 4; ++kk) { wkn[kk] = *(const bf16x8*)(P + PO_WKN + (tm * 16 + fr) * 128 + kk * 32 + fq * 8); qd[kk] = *(const bf16x8*)(P + PO_QD + (tm * 16 + fr) * 128 + kk * 32 + fq * 8); }
#pragma unroll
        for (int kk = 0; kk < 2; ++kk) { qk[kk] = *(const bf16x8*)(P + PO_QK + (tm * 16 + fr) * 64 + kk * 32 + fq * 8); kdt[kk] = *(const bf16x8*)(P + PO_KDT + (wave * 16 + fr) * 64 + kk * 32 + fq * 8); }
        f32x4 U[4], O[4];
#pragma unroll
        for (int n = 0; n < 4; ++n) {
            const u32x2 w = *(const u32x2*)(P + PO_U0T + ((vh * 4 + n) * 16 + fr) * 64 + tm * 16 + fq * 4);
            U[n] = (f32x4){bflo(w.x), bfhi(w.x), bflo(w.y), bfhi(w.y)};
            O[n] = (f32x4){0.f, 0.f, 0.f, 0.f};
        }
        const float dl = DL[u];
#pragma unroll
        for (int kk = 0; kk < 4; ++kk)
#pragma unroll
            for (int n = 0; n < 4; ++n) {
                const bf16x8 sf = *(const bf16x8*)(ST + ((vh * 4 + n) * 16 + fr) * 136 + kk * 32 + fq * 8);
                U[n] = __builtin_amdgcn_mfma_f32_16x16x32_bf16(wkn[kk], sf, U[n], 0, 0, 0);
                O[n] = __builtin_amdgcn_mfma_f32_16x16x32_bf16(qd[kk], sf, O[n], 0, 0, 0);
            }
#pragma unroll
        for (int n = 0; n < 4; ++n) { u32x2 w; w.x = cvt_pk_bf16(U[n][0], U[n][1]); w.y = cvt_pk_bf16(U[n][2], U[n][3]); *(u32x2*)(UT + ((vh * 4 + n) * 16 + fr) * 72 + tm * 16 + fq * 4) = w; }
        __syncthreads();
#pragma unroll
        for (int kk = 0; kk < 2; ++kk)
#pragma unroll
            for (int n = 0; n < 4; ++n) O[n] = __builtin_amdgcn_mfma_f32_16x16x32_bf16(qk[kk], *(const bf16x8*)(UT + ((vh * 4 + n) * 16 + fr) * 72 + kk * 32 + fq * 8), O[n], 0, 0, 0);
#pragma unroll
        for (int n = 0; n < 8; ++n) {
            S[n] = S[n] * dl;
#pragma unroll
            for (int kk = 0; kk < 2; ++kk) S[n] = __builtin_amdgcn_mfma_f32_16x16x32_bf16(kdt[kk], *(const bf16x8*)(UT + (n * 16 + fr) * 72 + kk * 32 + fq * 8), S[n], 0, 0, 0);
        }
        __syncthreads();
#pragma unroll
        for (int n = 0; n < 8; ++n) { u32x2 w; w.x = cvt_pk_bf16(S[n][0], S[n][1]); w.y = cvt_pk_bf16(S[n][2], S[n][3]); *(u32x2*)(ST + (n * 16 + fr) * 136 + wave * 16 + fq * 4) = w; }
#pragma unroll
        for (int n = 0; n < 4; ++n)
#pragma unroll
            for (int j = 0; j < 4; ++j) OB[(tm * 16 + fq * 4 + j) * 132 + (vh * 4 + n) * 16 + fr] = O[n][j];
        __syncthreads();
        {
            const int t = tid >> 3, part = tid & 7;
            float o[16]; float ss = 0.f;
#pragma unroll
            for (int q = 0; q < 4; ++q) { const f32x4 v = *(const f32x4*)(OB + t * 132 + part * 16 + q * 4); o[4 * q] = v.x; o[4 * q + 1] = v.y; o[4 * q + 2] = v.z; o[4 * q + 3] = v.w; ss += v.x * v.x + v.y * v.y + v.z * v.z + v.w * v.w; }
            ss = red8(ss);
            const float rstd = rsqrtf(ss * (1.f / 128.f) + 1e-6f);
            const bf16_t* zp = PROJ + (size_t)(t0 + t) * PJ + C_Z + h * 128 + part * 16;
            float z[16]; unpack8(*(const u32x4*)zp, z); unpack8(*(const u32x4*)(zp + 8), z + 8);
#pragma unroll
            for (int e = 0; e < 16; ++e) o[e] = o[e] * rstd * nw[part * 16 + e] * silu_f(z[e]);
            bf16_t* yp = YIN + (size_t)(t0 + t) * 1024 + h * 128 + part * 16;
            *(u32x4*)yp = pack8(o); *(u32x4*)(yp + 8) = pack8(o + 8);
        }
    }
    {
        float* so = p.out + (prompt ? O_PGDN + ((size_t)(l * 16 + b) * 4 + h) * 16384 : O_SGDN + ((size_t)(l * 8 + b) * 4 + h) * 16384);
#pragma unroll
        for (int n = 0; n < 8; ++n)
#pragma unroll
            for (int j = 0; j < 4; ++j) so[(wave * 16 + fq * 4 + j) * 128 + n * 16 + fr] = S[n][j];
    }
    __syncthreads();
}

__device__ __forceinline__ void phase_rwkv_prep(const Ctx& cx, const Params& p, int l) {
    const int tid = cx.tid, lane = tid & 63, wave = tid >> 6, fr = lane & 15, fq = lane >> 4;
    bf16_t* XW = (bf16_t*)(smem);
    bf16_t* XA = (bf16_t*)(smem + 9216);
    bf16_t* XG = (bf16_t*)(smem + 18432);
    bf16_t* PROJ = (bf16_t*)(p.ws + WS_R1);
    const bf16_t* LW2 = (const bf16_t*)(p.ws + WS_LW2); const bf16_t* LA2 = (const bf16_t*)(p.ws + WS_LA2); const bf16_t* LG2 = (const bf16_t*)(p.ws + WS_LG2);
    const float* mu = p.in[15] + l * RWP;
#ifndef REP_RP
#define REP_RP 1
#endif
    for (int rep = 0; rep < REP_RP; ++rep)
    for (int c = cx.bid; c < 520; c += cx.nb) {
        const int t0 = c * 64;
        const bool prompt = c < 512;
        const bool first = prompt ? ((c & 31) == 0) : true;
        const float* shift_state = p.in[7] + (size_t)(l * 8 + (prompt ? 0 : c - 512)) * RWP;
        {
            const int t = tid >> 3, part = tid & 7;
#pragma unroll
            for (int q = 0; q < 4; ++q) {
                const int cl = part * 32 + q * 8;
                const int idx0 = 1536 + cl;
                float cur[8], prv[8], o[8];
                unpack8(*(const u32x4*)(PROJ + (size_t)(t0 + t) * PJ + C_RW + idx0), cur);
                if (t > 0 || !first) unpack8(*(const u32x4*)(PROJ + (size_t)(t0 + t - 1) * PJ + C_RW + idx0), prv);
                else if (!prompt) {
#pragma unroll
                    for (int e = 0; e < 8; ++e) prv[e] = shift_state[idx0 + e];
                } else {
#pragma unroll
                    for (int e = 0; e < 8; ++e) prv[e] = 0.f;
                }
#pragma unroll
                for (int e = 0; e < 8; ++e) {
                    const float x = cur[e] + (prv[e] - cur[e]) * mu[idx0 + e];
                    o[e] = cl < 64 ? tanh_f(x) : (cl < 128 ? x : sigmoid_f(x));
                }
                bf16_t* dst = cl < 64 ? XW + t * 72 + cl : (cl < 128 ? XA + t * 72 + (cl - 64) : XG + t * 136 + (cl - 128));
                *(u32x4*)dst = pack8(o);
            }
        }
        __syncthreads();
#pragma unroll 1
        for (int cn = 0; cn < 4; ++cn) {
            const int nrow = wave * 64 + cn * 16 + fr;
            bf16x8 bw[2], ba[2], bg[4];
#pragma unroll
            for (int kk = 0; kk < 2; ++kk) { bw[kk] = *(const bf16x8*)(LW2 + nrow * 64 + kk * 32 + fq * 8); ba[kk] = *(const bf16x8*)(LA2 + nrow * 64 + kk * 32 + fq * 8); }
#pragma unroll
            for (int kk = 0; kk < 4; ++kk) bg[kk] = *(const bf16x8*)(LG2 + nrow * 128 + kk * 32 + fq * 8);
            const int ch = wave * 64 + cn * 16 + fq * 4;
            const f32x4 w0 = *(const f32x4*)(p.in[16] + l * 512 + ch), a0 = *(const f32x4*)(p.in[18] + l * 512 + ch);
#pragma unroll 1
            for (int tm = 0; tm < 4; ++tm) {
                f32x4 dw = {0.f, 0.f, 0.f, 0.f}, da = dw, dg = dw;
#pragma unroll
                for (int kk = 0; kk < 2; ++kk) {
                    dw = __builtin_amdgcn_mfma_f32_16x16x32_bf16(bw[kk], *(const bf16x8*)(XW + (tm * 16 + fr) * 72 + kk * 32 + fq * 8), dw, 0, 0, 0);
                    da = __builtin_amdgcn_mfma_f32_16x16x32_bf16(ba[kk], *(const bf16x8*)(XA + (tm * 16 + fr) * 72 + kk * 32 + fq * 8), da, 0, 0, 0);
                }
#pragma unroll
                for (int kk = 0; kk < 4; ++kk)
                    dg = __builtin_amdgcn_mfma_f32_16x16x32_bf16(bg[kk], *(const bf16x8*)(XG + (tm * 16 + fr) * 136 + kk * 32 + fq * 8), dg, 0, 0, 0);
                float dv[4], av[4];
#pragma unroll
                for (int j = 0; j < 4; ++j) {
                    dv[j] = __expf(-softplus_f(-(w0[j] + dw[j])) - 0.5f);
                    av[j] = sigmoid_f(a0[j] + da[j]);
                }
                bf16_t* orow = PROJ + (size_t)(t0 + tm * 16 + fr) * PJ + ch;
                u32x2 o;
                o.x = cvt_pk_bf16(dv[0], dv[1]); o.y = cvt_pk_bf16(dv[2], dv[3]); *(u32x2*)(orow) = o;
                o.x = cvt_pk_bf16(av[0], av[1]); o.y = cvt_pk_bf16(av[2], av[3]); *(u32x2*)(orow + 512) = o;
                o.x = cvt_pk_bf16(dg[0], dg[1]); o.y = cvt_pk_bf16(dg[2], dg[3]); *(u32x2*)(orow + 1024) = o;
            }
        }
        __syncthreads();
    }
}

__device__ __forceinline__ void rwkv_scan_unit(const Ctx& cx, const Params& p, int l, int seq, int h) {
    const int tid = cx.tid, lane = tid & 63, wave = tid >> 6, fr = lane & 15, fq = lane >> 4;
    float* B0 = (float*)(smem);
    float* B1 = (float*)(smem + 16384);
    float* B2 = (float*)(smem + 32768);
    float* B3 = (float*)(smem + 49152);
    float* B4 = (float*)(smem + 65536);
    float* B5 = (float*)(smem + 81920);
    float* B6 = (float*)(smem + 98304);
    float* B7 = (float*)(smem + 114688);
    float* SCL = (float*)(smem + 131072);
    const bf16_t* PROJ = (const bf16_t*)(p.ws + WS_R1);
    bf16_t* YIN = (bf16_t*)(p.ws + WS_H);
    const bool prompt = seq < 16;
    const int b = prompt ? seq : seq - 16;
    const int nch = prompt ? 32 : 1;
    const float* mu = p.in[15] + l * RWP;
    const float* shift_state = p.in[7] + (size_t)(l * 8 + b) * RWP;
    const int row = tid >> 3, sub = tid & 7;
    const int r0 = tid >> 4, l16 = tid & 15;
    f32x2 S0[2], S1[2];
    if (prompt) {
#pragma unroll
        for (int q = 0; q < 2; ++q) { S0[q] = (f32x2){0.f, 0.f}; S1[q] = (f32x2){0.f, 0.f}; }
    } else {
        const float* s0 = p.in[6] + ((size_t)(l * 8 + b) * 8 + h) * 4096 + l16 * 4;
#pragma unroll
        for (int q = 0; q < 2; ++q) { S0[q] = *(const f32x2*)(s0 + r0 * 64 + 2 * q); S1[q] = *(const f32x2*)(s0 + (r0 + 32) * 64 + 2 * q); }
    }
#pragma unroll 1
    for (int ci = 0; ci < nch; ++ci) {
        const int t0 = prompt ? (seq * 32 + ci) * 64 : NTP + b * 64;
        const bool first = (ci == 0);
        {
            const int t = row, c0 = h * 64 + sub * 8, ch0 = l * 512 + c0;
            const bf16_t* prow = PROJ + (size_t)(t0 + t) * PJ;
            float r[8], k[8], v[8], dd[8], a[8], g[8];
            {
                float cur[8], prv[8];
#pragma unroll
                for (int kind = 0; kind < 3; ++kind) {
                    const int idx0 = kind * 512 + c0;
                    unpack8(*(const u32x4*)(prow + C_RW + idx0), cur);
                    if (t > 0 || !first) unpack8(*(const u32x4*)(prow - PJ + C_RW + idx0), prv);
                    else if (!prompt) {
#pragma unroll
                        for (int e = 0; e < 8; ++e) prv[e] = shift_state[idx0 + e];
                    } else {
#pragma unroll
                        for (int e = 0; e < 8; ++e) prv[e] = 0.f;
                    }
                    float* dst = kind == 0 ? r : (kind == 1 ? k : v);
#pragma unroll
                    for (int e = 0; e < 8; ++e) dst[e] = cur[e] + (prv[e] - cur[e]) * mu[idx0 + e];
                }
            }
            unpack8(*(const u32x4*)(prow + c0), dd); unpack8(*(const u32x4*)(prow + 512 + c0), a); unpack8(*(const u32x4*)(prow + 1024 + c0), g);
            float ss = 0.f, c1 = 0.f, c2 = 0.f, bn = 0.f;
            float kkv[8];
#pragma unroll
            for (int e = 0; e < 8; ++e) { kkv[e] = k[e] * p.in[21][ch0 + e]; ss += kkv[e] * kkv[e]; }
            ss = red8(ss);
            const float rn = rsqrtf(ss + 1e-6f);
#pragma unroll
            for (int e = 0; e < 8; ++e) {
                const float w = __expf(-dd[e]);
                const float kkn = kkv[e] * rn, ka = kkn * a[e];
                const float k2 = k[e] * (1.f + (a[e] - 1.f) * p.in[22][ch0 + e]);
                B6[t * 64 + sub * 8 + e] = kkn; B7[t * 64 + sub * 8 + e] = ka; B1[t * 64 + sub * 8 + e] = k2; B0[t * 64 + sub * 8 + e] = w * r[e];
                B3[t * 64 + sub * 8 + e] = w; B2[t * 64 + sub * 8 + e] = v[e]; B5[t * 64 + sub * 8 + e] = g[e];
                c1 += ka * r[e]; c2 += k2 * r[e]; bn += r[e] * k2 * p.in[23][ch0 + e];
            }
            c1 = red8(c1); c2 = red8(c2); bn = red8(bn);
            if (sub == 0) { SCL[t] = c1; SCL[64 + t] = c2; SCL[128 + t] = bn; }
        }
        __syncthreads();
        {
            const f32x4* KKp = (const f32x4*)(B6 + l16 * 4); const f32x4* WRp = (const f32x4*)(B0 + l16 * 4); const f32x4* Wp = (const f32x4*)(B3 + l16 * 4);
            const f32x4* KAp = (const f32x4*)(B7 + l16 * 4); const f32x4* K2p = (const f32x4*)(B1 + l16 * 4);
#pragma unroll 2
            for (int t = 0; t < 64; ++t) {
                const f32x4 kk4 = KKp[t * 16], wr4 = WRp[t * 16], w4 = Wp[t * 16], ka4 = KAp[t * 16], k24 = K2p[t * 16];
                const f32x2 kk[2] = {{kk4.x, kk4.y}, {kk4.z, kk4.w}}, wrr[2] = {{wr4.x, wr4.y}, {wr4.z, wr4.w}}, ww[2] = {{w4.x, w4.y}, {w4.z, w4.w}};
                const f32x2 ka[2] = {{ka4.x, ka4.y}, {ka4.z, ka4.w}}, k2[2] = {{k24.x, k24.y}, {k24.z, k24.w}};
                const float v0 = B2[t * 64 + r0], v1 = B2[t * 64 + r0 + 32], c1 = SCL[t], c2 = SCL[64 + t];
                f32x2 a0 = S0[0] * kk[0], b0 = S0[0] * wrr[0], a1 = S1[0] * kk[0], b1 = S1[0] * wrr[0];
                a0 = __builtin_elementwise_fma(S0[1], kk[1], a0); b0 = __builtin_elementwise_fma(S0[1], wrr[1], b0);
                a1 = __builtin_elementwise_fma(S1[1], kk[1], a1); b1 = __builtin_elementwise_fma(S1[1], wrr[1], b1);
                float d10 = a0.x + a0.y, d20 = b0.x + b0.y, d11 = a1.x + a1.y, d21 = b1.x + b1.y;
                d10 += dpp_x1(d10); d11 += dpp_x1(d11); d20 += dpp_x1(d20); d21 += dpp_x1(d21);
                d10 += dpp_x2(d10); d11 += dpp_x2(d11); d20 += dpp_x2(d20); d21 += dpp_x2(d21);
                d10 += dpp_hm(d10); d11 += dpp_hm(d11); d20 += dpp_hm(d20); d21 += dpp_hm(d21);
                d10 += dpp_rm(d10); d11 += dpp_rm(d11); d20 += dpp_rm(d20); d21 += dpp_rm(d21);
                const float sa0 = -d10, sa1 = -d11;
                const f32x2 sa02 = {sa0, sa0}, sa12 = {sa1, sa1}, v02 = {v0, v0}, v12 = {v1, v1};
#pragma unroll
                for (int q = 0; q < 2; ++q) {
                    S0[q] = __builtin_elementwise_fma(S0[q], ww[q], __builtin_elementwise_fma(sa02, ka[q], v02 * k2[q]));
                    S1[q] = __builtin_elementwise_fma(S1[q], ww[q], __builtin_elementwise_fma(sa12, ka[q], v12 * k2[q]));
                }
                if (l16 == 0) { B4[t * 64 + r0] = d20 + sa0 * c1 + v0 * c2; B4[t * 64 + r0 + 32] = d21 + sa1 * c1 + v1 * c2; }
            }
        }
        __syncthreads();
        {
            const int t = row, ch0 = l * 512 + h * 64 + sub * 8;
            float o[8]; float s = 0.f;
#pragma unroll
            for (int e = 0; e < 8; ++e) { o[e] = B4[t * 64 + sub * 8 + e]; s += o[e]; }
            const float mean = red8(s) * (1.f / 64.f); float s2 = 0.f;
#pragma unroll
            for (int e = 0; e < 8; ++e) { o[e] -= mean; s2 += o[e] * o[e]; }
            const float rstd = rsqrtf(red8(s2) * (1.f / 64.f) + 64e-5f);
            const float bn = SCL[128 + t];
#pragma unroll
            for (int e = 0; e < 8; ++e) o[e] = (o[e] * rstd * p.in[24][ch0 + e] + p.in[25][ch0 + e] + bn * B2[t * 64 + sub * 8 + e]) * B5[t * 64 + sub * 8 + e];
            *(u32x4*)(YIN + (size_t)(t0 + t) * 1024 + 512 + h * 64 + sub * 8) = pack8(o);
        }
        __syncthreads();
    }
    {
        float* so = p.out + (prompt ? O_PRW + ((size_t)(l * 16 + b) * 8 + h) * 4096 : O_SRW + ((size_t)(l * 8 + b) * 8 + h) * 4096) + l16 * 4;
#pragma unroll
        for (int q = 0; q < 2; ++q) { *(f32x2*)(so + r0 * 64 + 2 * q) = S0[q]; *(f32x2*)(so + (r0 + 32) * 64 + 2 * q) = S1[q]; }
        if (h == 0) {
            const int tlast = prompt ? (seq + 1) * 2048 - 1 : NTP + (b + 1) * 64 - 1;
            float* sh = p.out + (prompt ? O_PSHIFT + (size_t)(l * 16 + b) * RWP : O_SSHIFT + (size_t)(l * 8 + b) * RWP);
            for (int i = tid; i < RWP; i += 512) sh[i] = bf2f(PROJ[(size_t)tlast * PJ + C_RW + i]);
        }
    }
    __syncthreads();
}

__device__ __forceinline__ void rwkv_chunk_unit(const Ctx& cx, const Params& p, int l, int seq, int h) {
    const int tid = cx.tid, lane = tid & 63, wave = tid >> 6, fr = lane & 15, fq = lane >> 4;
    constexpr int MS = 72;
    bf16_t* R0 = (bf16_t*)(smem);
    bf16_t* R2 = (bf16_t*)(smem + 9216);
    bf16_t* R3 = (bf16_t*)(smem + 18432);
    bf16_t* R1 = (bf16_t*)(smem + 27648);
    bf16_t* R4 = (bf16_t*)(smem + 36864);
    bf16_t* R5 = (bf16_t*)(smem + 46080);
    bf16_t* R6 = (bf16_t*)(smem + 55296);
    bf16_t* R7 = (bf16_t*)(smem + 64512);
    bf16_t* R8 = (bf16_t*)(smem + 73728);
    bf16_t* R9 = (bf16_t*)(smem + 82944);
    bf16_t* R10 = (bf16_t*)(smem + 92160);
    bf16_t* PT = (bf16_t*)(smem + 101376);
    float* GA = (float*)(smem + 110592);
    float* OW = (float*)(smem + 128000);
    float* GC = (float*)(smem + 145408);
    float* PRM = (float*)(smem + 145664);
    float* TF = (float*)(smem);
    const bf16_t* PROJ = (const bf16_t*)(p.ws + WS_R1);
    bf16_t* YIN = (bf16_t*)(p.ws + WS_H);
    const bool prompt = seq < 16;
    const int b = prompt ? seq : seq - 16;
    const int nch = prompt ? 32 : 1;
    const float* mu = p.in[15] + l * RWP;
    const float* shift_state = p.in[7] + (size_t)(l * 8 + b) * RWP;
    const int row = tid >> 3, sub = tid & 7;
    const int tm = wave & 3, ih = (wave >> 2) * 2;
    f32x4 Pacc[2];
#pragma unroll
    for (int q = 0; q < 2; ++q) Pacc[q] = (f32x4){0.f, 0.f, 0.f, 0.f};
    if (!prompt) {
        const float* s0 = p.in[6] + ((size_t)(l * 8 + b) * 8 + h) * 4096;
#pragma unroll
        for (int q = 0; q < 2; ++q)
#pragma unroll
            for (int jj = 0; jj < 4; ++jj) Pacc[q][jj] = s0[((ih + q) * 16 + fr) * 64 + tm * 16 + fq * 4 + jj];
    }
#pragma unroll
    for (int q = 0; q < 2; ++q) { u32x2 w; w.x = cvt_pk_bf16(Pacc[q][0], Pacc[q][1]); w.y = cvt_pk_bf16(Pacc[q][2], Pacc[q][3]); *(u32x2*)(PT + ((ih + q) * 16 + fr) * MS + tm * 16 + fq * 4) = w; }
    {
        const int pk = tid >> 6, pc = tid & 63;
        const float* s21 = p.in[21]; const float* s22 = p.in[22]; const float* s23 = p.in[23]; const float* s24 = p.in[24]; const float* s25 = p.in[25];
        const float* src = pk < 3 ? mu + pk * 512 + h * 64 : (pk == 3 ? s21 : (pk == 4 ? s22 : (pk == 5 ? s23 : (pk == 6 ? s24 : s25)))) + l * 512 + h * 64;
        PRM[pk * 64 + pc] = src[pc];
    }
    __syncthreads();
    u32x4 nx[9];
    {
        const int t_ = cx.tid >> 3, c_ = (cx.tid & 7) * 8;
        const int t0_ = prompt ? (seq * 32) * 64 : NTP + b * 64;
        const bf16_t* pr = PROJ + (size_t)(t0_ + t_) * PJ + h * 64 + c_;
        const bf16_t* pp = t_ > 0 ? pr - PJ : pr;
#pragma unroll
        for (int q = 0; q < 3; ++q) { nx[q] = *(const u32x4*)(pr + C_RW + q * 512); nx[3 + q] = *(const u32x4*)(pp + C_RW + q * 512); nx[6 + q] = *(const u32x4*)(pr + q * 512); }
    }
#pragma unroll 1
    for (int ci = 0; ci < nch; ++ci) {
        const int t0 = prompt ? (seq * 32 + ci) * 64 : NTP + b * 64;
        const bool first = (ci == 0);
        int tq = cx.tid; asm volatile("" : "+v"(tq));
        const int tid = tq, lane = tid & 63, wave = tid >> 6, fr = lane & 15, fq = lane >> 4, row = tid >> 3, sub = tid & 7, tm = wave & 3, ih = (wave >> 2) * 2;
        const int t = row, c0 = sub * 8, ch0 = l * 512 + h * 64 + c0;
        float v[8], g[8], bn;
        {
            float r[8], k[8], dd[8], a[8], kkn[8], be[8], k2[8];
            u32x4 raw[9];
#pragma unroll
            for (int q = 0; q < 9; ++q) raw[q] = nx[q];
            if (ci + 1 < nch) {
                const bf16_t* pr = PROJ + (size_t)(t0 + 64 + t) * PJ + h * 64 + c0;
#pragma unroll
                for (int q = 0; q < 3; ++q) { nx[q] = *(const u32x4*)(pr + C_RW + q * 512); nx[3 + q] = *(const u32x4*)(pr - PJ + C_RW + q * 512); nx[6 + q] = *(const u32x4*)(pr + q * 512); }
            }
            {
                float cur[8], prv[8];
#pragma unroll
                for (int kind = 0; kind < 3; ++kind) {
                    const int idx0 = kind * 512 + h * 64 + c0;
                    unpack8(raw[kind], cur);
                    if (t > 0 || !first) unpack8(raw[3 + kind], prv);
                    else if (!prompt) {
#pragma unroll
                        for (int e = 0; e < 8; ++e) prv[e] = shift_state[idx0 + e];
                    } else {
#pragma unroll
                        for (int e = 0; e < 8; ++e) prv[e] = 0.f;
                    }
                    float* dst = kind == 0 ? r : (kind == 1 ? k : v);
#pragma unroll
                    for (int e = 0; e < 8; ++e) dst[e] = cur[e] + (prv[e] - cur[e]) * PRM[kind * 64 + c0 + e];
                }
            }
            unpack8(raw[6], dd); unpack8(raw[7], a); unpack8(raw[8], g);
            float ss = 0.f; bn = 0.f;
#pragma unroll
            for (int e = 0; e < 8; ++e) { kkn[e] = k[e] * PRM[192 + c0 + e]; ss += kkn[e] * kkn[e]; }
            ss = red8(ss);
            const float rn = rsqrtf(ss + 1e-6f);
#pragma unroll
            for (int e = 0; e < 8; ++e) {
                kkn[e] *= rn; be[e] = kkn[e] * a[e];
                k2[e] = k[e] * (1.f + (a[e] - 1.f) * PRM[256 + c0 + e]);
                bn += r[e] * k2[e] * PRM[320 + c0 + e];
                GA[t * 64 + c0 + e] = dd[e];
            }
            bn = red8(bn);
            __syncthreads();
            {
                const int j = tid & 63, sg = tid >> 6;
                float sacc = 0.f;
#pragma unroll
                for (int q = 0; q < 8; ++q) { sacc += GA[(sg * 8 + q) * 64 + j]; GA[(sg * 8 + q) * 64 + j] = sacc; }
                OW[sg * 64 + j] = sacc;
                __syncthreads();
                float pre = 0.f;
                for (int q = 0; q < sg; ++q) pre += OW[q * 64 + j];
#pragma unroll
                for (int q = 0; q < 8; ++q) GA[(sg * 8 + q) * 64 + j] += pre;
            }
            __syncthreads();
            {
                float at[8], bt[8], kt[8], rt[8];
#pragma unroll
                for (int e = 0; e < 8; ++e) {
                    const int j = c0 + e;
                    const float Gt = GA[t * 64 + j], Gp = t > 0 ? GA[(t - 1) * 64 + j] : 0.f, Gc = GA[63 * 64 + j];
                    const float em = __expf(-Gp), ep = __expf(Gt), en = __expf(-Gt), ec = __expf(Gt - Gc);
                    at[e] = -kkn[e] * em; bt[e] = be[e] * ep; kt[e] = k2[e] * ep; rt[e] = r[e] * en;
                    const int so = swz_el(j, t);
                    R1[so] = f2bf(at[e]); R5[so] = f2bf(be[e] * ec); R6[so] = f2bf(k2[e] * ec); R7[so] = f2bf(v[e]);
                    if (t == 63) GC[j] = __expf(-Gc);
                }
                *(u32x4*)(R0 + t * MS + c0) = pack8(at); *(u32x4*)(R2 + t * MS + c0) = pack8(bt); *(u32x4*)(R3 + t * MS + c0) = pack8(kt); *(u32x4*)(R4 + t * MS + c0) = pack8(rt);
            }
        }
        __syncthreads();
#pragma unroll
        for (int q = 0; q < 2; ++q) {
            const int tile = wave * 2 + q, sm = tile >> 2, tn = tile & 3;
            f32x4 lb = {0.f, 0.f, 0.f, 0.f}, lk = lb, mb = lb, mk = lb;
#pragma unroll
            for (int kk = 0; kk < 2; ++kk) {
                const bf16x8 yb = *(const bf16x8*)(R2 + (sm * 16 + fr) * MS + kk * 32 + fq * 8), yk = *(const bf16x8*)(R3 + (sm * 16 + fr) * MS + kk * 32 + fq * 8);
                const bf16x8 xa = *(const bf16x8*)(R0 + (tn * 16 + fr) * MS + kk * 32 + fq * 8), xr = *(const bf16x8*)(R4 + (tn * 16 + fr) * MS + kk * 32 + fq * 8);
                lb = __builtin_amdgcn_mfma_f32_16x16x32_bf16(yb, xa, lb, 0, 0, 0); lk = __builtin_amdgcn_mfma_f32_16x16x32_bf16(yk, xa, lk, 0, 0, 0);
                mb = __builtin_amdgcn_mfma_f32_16x16x32_bf16(yb, xr, mb, 0, 0, 0); mk = __builtin_amdgcn_mfma_f32_16x16x32_bf16(yk, xr, mk, 0, 0, 0);
            }
            const int tt = tn * 16 + fr, s0i = sm * 16 + fq * 4;
            float olk[4], omb[4], omk[4];
#pragma unroll
            for (int jj = 0; jj < 4; ++jj) {
                const int si = s0i + jj;
                olk[jj] = (si < tt) ? lk[jj] : 0.f; omb[jj] = (si <= tt) ? mb[jj] : 0.f; omk[jj] = (si <= tt) ? mk[jj] : 0.f;
            }
            u32x2 w;
            w.x = cvt_pk_bf16(olk[0], olk[1]); w.y = cvt_pk_bf16(olk[2], olk[3]); *(u32x2*)(R8 + tt * MS + s0i) = w;
            w.x = cvt_pk_bf16(omb[0], omb[1]); w.y = cvt_pk_bf16(omb[2], omb[3]); *(u32x2*)(R9 + tt * MS + s0i) = w;
            w.x = cvt_pk_bf16(omk[0], omk[1]); w.y = cvt_pk_bf16(omk[2], omk[3]); *(u32x2*)(R10 + tt * MS + s0i) = w;
#pragma unroll
            for (int jj = 0; jj < 4; ++jj) { const int si = s0i + jj; GA[tt * 68 + si] = (si < tt) ? -lb[jj] : 0.f; }
        }
        __syncthreads();
        {
            bf16_t* TM = R3;
            tri_inv64(GA, TF, OW, tid);
            __syncthreads();
#pragma unroll
            for (int q = 0; q < 8; ++q) { const int e = tid + q * 512, i = e >> 6, cc = e & 63; TM[i * MS + cc] = ((cc >> 4) <= (i >> 4)) ? f2bf(TF[i * 68 + cc]) : (bf16_t)0; }
        }
        __syncthreads();
#pragma unroll
        for (int q = 0; q < 2; ++q) {
            f32x4 x1 = {0.f, 0.f, 0.f, 0.f}, w1 = x1;
#pragma unroll
            for (int kk = 0; kk < 2; ++kk) {
                x1 = __builtin_amdgcn_mfma_f32_16x16x32_bf16(*(const bf16x8*)(R8 + (tm * 16 + fr) * MS + kk * 32 + fq * 8), *(const bf16x8*)(R7 + swz_ch((ih + q) * 16 + fr, kk * 4 + fq)), x1, 0, 0, 0);
                w1 = __builtin_amdgcn_mfma_f32_16x16x32_bf16(*(const bf16x8*)(R1 + swz_ch(tm * 16 + fr, kk * 4 + fq)), *(const bf16x8*)(R3 + ((ih + q) * 16 + fr) * MS + kk * 32 + fq * 8), w1, 0, 0, 0);
            }
            u32x2 w;
            w.x = cvt_pk_bf16(x1[0], x1[1]); w.y = cvt_pk_bf16(x1[2], x1[3]); *(u32x2*)(R0 + ((ih + q) * 16 + fr) * MS + tm * 16 + fq * 4) = w;
            w.x = cvt_pk_bf16(w1[0], w1[1]); w.y = cvt_pk_bf16(w1[2], w1[3]); *(u32x2*)(R2 + ((ih + q) * 16 + fr) * MS + tm * 16 + fq * 4) = w;
        }
        __syncthreads();
        f32x4 Uacc[2];
#pragma unroll
        for (int q = 0; q < 2; ++q) {
            Uacc[q] = (f32x4){0.f, 0.f, 0.f, 0.f};
#pragma unroll
            for (int kk = 0; kk < 2; ++kk) {
                Uacc[q] = __builtin_amdgcn_mfma_f32_16x16x32_bf16(*(const bf16x8*)(R3 + (tm * 16 + fr) * MS + kk * 32 + fq * 8), *(const bf16x8*)(R0 + ((ih + q) * 16 + fr) * MS + kk * 32 + fq * 8), Uacc[q], 0, 0, 0);
                Uacc[q] = __builtin_amdgcn_mfma_f32_16x16x32_bf16(*(const bf16x8*)(R2 + (tm * 16 + fr) * MS + kk * 32 + fq * 8), *(const bf16x8*)(PT + ((ih + q) * 16 + fr) * MS + kk * 32 + fq * 8), Uacc[q], 0, 0, 0);
            }
        }
        __syncthreads();
#pragma unroll
        for (int q = 0; q < 2; ++q) { u32x2 w; w.x = cvt_pk_bf16(Uacc[q][0], Uacc[q][1]); w.y = cvt_pk_bf16(Uacc[q][2], Uacc[q][3]); *(u32x2*)(R3 + ((ih + q) * 16 + fr) * MS + tm * 16 + fq * 4) = w; }
        __syncthreads();
#pragma unroll
        for (int q = 0; q < 2; ++q) {
            f32x4 o = {0.f, 0.f, 0.f, 0.f};
            const f32x4 gc = *(const f32x4*)(GC + tm * 16 + fq * 4);
            Pacc[q] = Pacc[q] * gc;
#pragma unroll
            for (int kk = 0; kk < 2; ++kk) {
                const bf16x8 vt = *(const bf16x8*)(R7 + swz_ch((ih + q) * 16 + fr, kk * 4 + fq)), ut = *(const bf16x8*)(R3 + ((ih + q) * 16 + fr) * MS + kk * 32 + fq * 8);
                const bf16x8 pt = *(const bf16x8*)(PT + ((ih + q) * 16 + fr) * MS + kk * 32 + fq * 8);
                o = __builtin_amdgcn_mfma_f32_16x16x32_bf16(*(const bf16x8*)(R10 + (tm * 16 + fr) * MS + kk * 32 + fq * 8), vt, o, 0, 0, 0);
                o = __builtin_amdgcn_mfma_f32_16x16x32_bf16(*(const bf16x8*)(R4 + (tm * 16 + fr) * MS + kk * 32 + fq * 8), pt, o, 0, 0, 0);
                o = __builtin_amdgcn_mfma_f32_16x16x32_bf16(*(const bf16x8*)(R9 + (tm * 16 + fr) * MS + kk * 32 + fq * 8), ut, o, 0, 0, 0);
                Pacc[q] = __builtin_amdgcn_mfma_f32_16x16x32_bf16(*(const bf16x8*)(R5 + swz_ch(tm * 16 + fr, kk * 4 + fq)), ut, Pacc[q], 0, 0, 0);
                Pacc[q] = __builtin_amdgcn_mfma_f32_16x16x32_bf16(*(const bf16x8*)(R6 + swz_ch(tm * 16 + fr, kk * 4 + fq)), vt, Pacc[q], 0, 0, 0);
            }
#pragma unroll
            for (int jj = 0; jj < 4; ++jj) OW[(tm * 16 + fq * 4 + jj) * 68 + (ih + q) * 16 + fr] = o[jj];
        }
        __syncthreads();
#pragma unroll
        for (int q = 0; q < 2; ++q) { u32x2 w; w.x = cvt_pk_bf16(Pacc[q][0], Pacc[q][1]); w.y = cvt_pk_bf16(Pacc[q][2], Pacc[q][3]); *(u32x2*)(PT + ((ih + q) * 16 + fr) * MS + tm * 16 + fq * 4) = w; }
        {
            float o[8]; float sm = 0.f;
#pragma unroll
            for (int e = 0; e < 8; ++e) { o[e] = OW[t * 68 + c0 + e]; sm += o[e]; }
            const float mean = red8(sm) * (1.f / 64.f); float s2 = 0.f;
#pragma unroll
            for (int e = 0; e < 8; ++e) { o[e] -= mean; s2 += o[e] * o[e]; }
            const float rstd = rsqrtf(red8(s2) * (1.f / 64.f) + 64e-5f);
#pragma unroll
            for (int e = 0; e < 8; ++e) o[e] = (o[e] * rstd * PRM[384 + c0 + e] + PRM[448 + c0 + e] + bn * v[e]) * g[e];
            *(u32x4*)(YIN + (size_t)(t0 + t) * 1024 + 512 + h * 64 + c0) = pack8(o);
        }
        __syncthreads();
    }
    {
        float* so = p.out + (prompt ? O_PRW + ((size_t)(l * 16 + b) * 8 + h) * 4096 : O_SRW + ((size_t)(l * 8 + b) * 8 + h) * 4096);
#pragma unroll
        for (int q = 0; q < 2; ++q)
#pragma unroll
            for (int jj = 0; jj < 4; ++jj) so[((ih + q) * 16 + fr) * 64 + tm * 16 + fq * 4 + jj] = Pacc[q][jj];
        if (h == 0) {
            const int tlast = prompt ? (seq + 1) * 2048 - 1 : NTP + (b + 1) * 64 - 1;
            float* sh = p.out + (prompt ? O_PSHIFT + (size_t)(l * 16 + b) * RWP : O_SSHIFT + (size_t)(l * 8 + b) * RWP);
            for (int i = tid; i < RWP; i += 512) sh[i] = bf2f(PROJ[(size_t)tlast * PJ + C_RW + i]);
        }
    }
    __syncthreads();
}

__device__ __forceinline__ void phase_scan(const Ctx& cx, const Params& p, int l) {
#ifndef REP_SCAN
#define REP_SCAN 1
#endif
    for (int rep = 0; rep < REP_SCAN; ++rep)
    for (int w = cx.bid; w < 288; w += cx.nb) {
        bool isr; int seq, h;
        if (w < 128) { isr = true; seq = w >> 3; h = w & 7; }
        else if (w < 192) { isr = false; seq = (w - 128) >> 2; h = (w - 128) & 3; }
        else if (w < 224) { isr = false; seq = 16 + ((w - 192) >> 2); h = (w - 192) & 3; }
        else { isr = true; seq = 16 + ((w - 224) >> 3); h = (w - 224) & 7; }
#ifndef SCANM
#define SCANM 3
#endif
#ifndef REP_R
#define REP_R 1
#endif
#ifndef REP_GD
#define REP_GD 1
#endif
        if (isr) { if (SCANM & 1) for (int rr = 0; rr < REP_R; ++rr) rwkv_chunk_unit(cx, p, l, seq, h); }
        else { if (SCANM & 2) for (int rr = 0; rr < REP_GD; ++rr) gdn_scan_unit(cx, p, l, seq, h); }
    }
}

#define XB_TMO      128
#define XB_XCNT(j)  (256  + 64 * (j))
#define XB_XSUB(j)  (1280 + 64 * (j))
#define XB_XGEN(j)  (2304 + 64 * (j))
#define XB_TOP      3328
#define XB_TOPGEN   3392
#define XCD_BAR_WORDS 3456
#define XB_SPIN_CAP (1u << 18)
#define XLAS __attribute__((address_space(3)))
__device__ __forceinline__ unsigned xb_ld(unsigned* p)              { return __hip_atomic_load(p, __ATOMIC_RELAXED, __HIP_MEMORY_SCOPE_AGENT); }
__device__ __forceinline__ unsigned xb_add(unsigned* p, unsigned v) { return __hip_atomic_fetch_add(p, v, __ATOMIC_RELAXED, __HIP_MEMORY_SCOPE_AGENT); }
__device__ __forceinline__ unsigned xb_xcc_id() { return (unsigned)__builtin_amdgcn_s_getreg((3 << 11) | 20) & 0xFu; }
#define XB_SPIN(cond, bar) do { unsigned _sp = 0; while (cond) { __builtin_amdgcn_s_sleep(1); \
    if ((++_sp & 255u) == 0u) { if (xb_ld(&(bar)[XB_TMO])) break; if (_sp > XB_SPIN_CAP) { atomicAdd(&(bar)[XB_TMO], 1u); break; } } } } while (0)
struct XcdBarrier { unsigned* bar; unsigned x; volatile XLAS unsigned* st; };
__device__ __forceinline__ XcdBarrier xcd_barrier_post(unsigned* bar, volatile XLAS unsigned* st) {
    XcdBarrier b; b.bar = bar; b.x = xb_xcc_id(); b.st = st;
    if (threadIdx.x == 0) (void)xb_add(&bar[XB_XCNT(b.x)], 1u);
    return b;
}
__device__ __forceinline__ void xcd_barrier_complete(unsigned* bar, unsigned x, unsigned& nloc, unsigned& nx) {
    const unsigned G = gridDim.x * gridDim.y * gridDim.z;
    unsigned sum, cnt, mine, sp = 0u;
    for (;;) {
        sum = 0u; cnt = 0u; mine = 0u;
#pragma unroll
        for (unsigned j = 0; j < 16; ++j) { const unsigned c = xb_ld(&bar[XB_XCNT(j)]); sum += c; cnt += (c > 0u) ? 1u : 0u; mine = (j == x) ? c : mine; }
        if (sum == G) break;
        __builtin_amdgcn_s_sleep(1);
        if ((++sp & 255u) == 0u) { if (xb_ld(&bar[XB_TMO])) break; if (sp > XB_SPIN_CAP) { atomicAdd(&bar[XB_TMO], 1u); break; } }
    }
    nloc = mine > 0u ? mine : 1u; nx = cnt > 0u ? cnt : 1u;
}
__device__ __forceinline__ void xcd_barrier(const XcdBarrier& b) {
    asm volatile("s_waitcnt vmcnt(0)" ::: "memory");
    __syncthreads();
    if (threadIdx.x == 0) {
        unsigned* bar = b.bar;
        __builtin_amdgcn_s_waitcnt(0);
        unsigned nloc = b.st[0], nx = b.st[1];
        if (nloc == 0u) { xcd_barrier_complete(bar, b.x, nloc, nx); b.st[0] = nloc; b.st[1] = nx; }
        const unsigned old = xb_add(&bar[XB_XSUB(b.x)], 1u);
        const unsigned gen = old / nloc;
        if (old + 1u == (gen + 1u) * nloc) {
            __builtin_amdgcn_fence(__ATOMIC_RELEASE, "agent");
            asm volatile("s_waitcnt vmcnt(0)" ::: "memory");
            const unsigned og = xb_add(&bar[XB_TOP], 1u);
            const unsigned tg = og / nx;
            if (og + 1u == (tg + 1u) * nx) xb_add(&bar[XB_TOPGEN], 1u);
            else XB_SPIN(xb_ld(&bar[XB_TOPGEN]) == tg, bar);
            __builtin_amdgcn_fence(__ATOMIC_ACQUIRE, "agent");
            xb_add(&bar[XB_XGEN(b.x)], 1u);
            asm volatile("s_waitcnt vmcnt(0)" ::: "memory");
        } else {
            XB_SPIN(xb_ld(&bar[XB_XGEN(b.x)]) == gen, bar);
            __builtin_amdgcn_fence(__ATOMIC_ACQUIRE, "agent");
            asm volatile("s_waitcnt vmcnt(0)" ::: "memory");
        }
    }
    __syncthreads();
}

__device__ __forceinline__ void run_phase(const Ctx& cx, const Params& p, int ph) {
    unsigned char* ws = p.ws;
    const float* MOD = (const float*)(ws + WS_MOD);
#ifndef PHM
#define PHM 0xFFFF
#endif
    if (ph == 0) { if (PHM & 1) phase_mod(cx, p); __syncthreads(); if (PHM & 2) phase_weights(cx, p, 0); return; }
    if (ph == 1) { if (PHM & 4) phase_mod0(cx, p); return; }
    const int l = (ph - 2) / 9, s = (ph - 2) % 9;
    const float* modl = MOD + (size_t)l * 24 * 6144;
    gm::Epi E{};
    const bf16_t* gA = (const bf16_t*)(ws + WS_H); const bf16_t* gB = nullptr; int gN = 0, gK = 1024;
    switch (s) {
    case 0: E.kind = 1; E.O = (bf16_t*)(ws + WS_R1); E.ldo = PJ; gB = (const bf16_t*)(ws + WS_WIN); gN = PJ; break;
    case 1: if (PHM & 16) phase_gdn_prep(cx, p, l); break;
    case 2: if (PHM & 128) phase_rwkv_prep(cx, p, l); break;
    case 3: if (PHM & 32) phase_scan(cx, p, l); break;
    case 4: E.kind = 2; E.X = p.out; E.O = (bf16_t*)(ws + WS_PREP); E.gate = modl + 2048; gB = (const bf16_t*)(ws + WS_WOUT); gN = 1024;
        if (l == 0) { E.xp = p.in[0]; E.xs = p.in[1] - (size_t)NTP * 1024; E.xb = nullptr; } else { E.xp = p.out; E.xs = p.out; E.xb = (const bf16_t*)p.out; }
        break;
    case 5: if (PHM & 64) phase_ln(cx, p, p.in[27] + l * 1024, p.in[28] + l * 1024, modl, 3072, 4096, false); break;
    case 6: E.kind = 3; E.O = (bf16_t*)(ws + WS_R1); E.ldo = DFF; gB = (const bf16_t*)(ws + WS_W1); gN = DFF; break;
    case 7: E.kind = 2; E.X = p.out; E.O = (bf16_t*)(ws + WS_PREP); E.gate = modl + 5120; E.xp = p.out; E.xs = p.out; E.xb = (const bf16_t*)p.out;
        gA = (const bf16_t*)(ws + WS_R1); gB = (const bf16_t*)(ws + WS_W2); gN = 1024; gK = DFF; break;
    default:
        if (PHM & 64) phase_ln(cx, p, p.in[31] + l * 1024, p.in[32] + l * 1024, l < NLAYER - 1 ? modl + 24 * 6144 : nullptr, 0, 1024, l == NLAYER - 1);
        if ((PHM & 2) && l < NLAYER - 1) { __syncthreads(); phase_weights(cx, p, l + 1); }
        break;
    }
#ifndef REP_G
#define REP_G 1
#endif
#ifndef REP_G2
#define REP_G2 0
#endif
    if ((PHM & 8) && gB) {
        const int reps = (E.kind == 2) ? 1 + REP_G2 : REP_G;
        for (int r = 0; r < reps; ++r) { gm::Epi E2 = E; if (E.kind == 2 && r + 1 < reps) E2.kind = 0; gemm_phase(cx, gA, gB, NTOK, gN, gK, E2); }
    }
}

#ifndef DBG_STOP
#define DBG_STOP 0
#endif
#ifndef DBG_OFF
#define DBG_OFF WS_PREP
#endif
#ifndef DBG_MOD
#define DBG_MOD 76677120
#endif
#ifndef DBG_SZ
#define DBG_SZ 20480
#define DBG_POFF 16384
#endif
#ifndef DBG_STRIDE
#define DBG_STRIDE 5
#endif
__global__ void __launch_bounds__(512) mk_fwd(Params p) {
    cg::grid_group grid = cg::this_grid();
    if (p.ph_lo == 1000) {
        const bf16_t* src = (const bf16_t*)(p.ws + DBG_OFF);
        for (size_t i = (size_t)blockIdx.x * 512 + threadIdx.x; i < 44130304; i += (size_t)gridDim.x * 512) p.out[i] = bf2f(src[((i / DBG_SZ) % 2080) * 36864 + DBG_POFF + (i % DBG_SZ)]);
        return;
    }
    volatile XLAS unsigned* xst = (volatile XLAS unsigned*)((XLAS unsigned char*)smem + (LDS_BYTES - 16));
    if (threadIdx.x == 0) { xst[0] = 0u; xst[1] = 0u; xst[2] = 0u; xst[3] = 0u; }
    __syncthreads();
    const XcdBarrier xb = xcd_barrier_post((unsigned*)(p.ws + WS_BAR), xst);
    for (int ph = p.ph_lo; ph < p.ph_hi; ++ph) {
        if (ph > p.ph_lo) { if (p.ph_hi == 0x7fffffff) grid.sync(); else xcd_barrier(xb); }
        Ctx cx; cx.tid = threadIdx.x; cx.bid = blockIdx.x; cx.nb = gridDim.x;
        asm volatile("" : "+v"(cx.tid)); asm volatile("" : "+s"(cx.bid)); asm volatile("" : "+s"(cx.nb));
        run_phase(cx, p, ph);
        __syncthreads();
    }
}

extern "C" void kernel_launch(void* const* d_in, const int* in_sizes, int n_in, void* d_out, int out_size, void* d_ws, size_t ws_size, hipStream_t stream) {
    static int grid = 0;
    if (grid == 0) {
        if (n_in != 33 || ws_size < WS_END) { fprintf(stderr, "kernel_launch: unexpected n_in %d / ws %zu (need %zu)\n", n_in, ws_size, (size_t)WS_END); grid = -1; return; }
        int dev = 0, cus = 0, per_cu = 0;
        hipGetDevice(&dev);
        hipDeviceGetAttribute(&cus, hipDeviceAttributeMultiprocessorCount, dev);
        if (hipFuncSetAttribute((const void*)mk_fwd, hipFuncAttributeMaxDynamicSharedMemorySize, LDS_BYTES) != hipSuccess) { fprintf(stderr, "kernel_launch: hipFuncSetAttribute failed\n"); grid = -1; return; }
        if (hipOccupancyMaxActiveBlocksPerMultiprocessor(&per_cu, (const void*)mk_fwd, 512, LDS_BYTES) != hipSuccess || per_cu < 1) { fprintf(stderr, "kernel_launch: occupancy query says %d\n", per_cu); per_cu = 1; }
        (void)hipGetLastError();
        grid = cus;
    }
    if (grid < 0) return;
    if (hipMemsetAsync((char*)d_ws + WS_BAR, 0, 16384, stream) != hipSuccess) { fprintf(stderr, "kernel_launch: memset of the barrier words failed\n"); return; }
    Params p{};
    for (int i = 0; i < 33; ++i) p.in[i] = (const float*)d_in[i];
    p.out = (float*)d_out; p.ws = (unsigned char*)d_ws;
#if MK_ONE_LAUNCH
    p.ph_lo = 0; p.ph_hi = NPHASE;
    void* args[] = {&p};
    hipError_t e = hipLaunchCooperativeKernel((const void*)mk_fwd, dim3(grid), dim3(512), args, LDS_BYTES, stream);
    if (e != hipSuccess) fprintf(stderr, "cooperative launch failed: %s (grid %d)\n", hipGetErrorString(e), grid);
#else
    for (int ph = 0; ph < (DBG_STOP ? DBG_STOP + 1 : NPHASE); ++ph) {
        p.ph_lo = ph; p.ph_hi = ph + 1;
        if (DBG_STOP && ph == DBG_STOP) { p.ph_lo = 1000; p.ph_hi = 1000; }
        void* args[] = {&p};
        hipError_t e = hipLaunchCooperativeKernel((const void*)mk_fwd, dim3(grid), dim3(512), args, LDS_BYTES, stream);
        if (e != hipSuccess) { fprintf(stderr, "launch %d failed: %s\n", ph, hipGetErrorString(e)); break; }
    }
#endif
}
```

```cpp
#include <hip/hip_runtime.h>
#include <hip/hip_cooperative_groups.h>
#include <cstdio>
#include <cstdint>
namespace cg = cooperative_groups;

#ifndef MK_ONE_LAUNCH
#define MK_ONE_LAUNCH 1
#define DBL_MASK 0x6
#endif

typedef unsigned short bf16_t;
typedef short bf16x8 __attribute__((ext_vector_type(8)));
typedef float f32x4 __attribute__((ext_vector_type(4)));
typedef float f32x2 __attribute__((ext_vector_type(2)));
typedef unsigned u32x4 __attribute__((ext_vector_type(4)));
typedef unsigned u32x2 __attribute__((ext_vector_type(2)));

constexpr int DM = 1024, NTOK = 33280, NTP = 32768, NSEQ = 24, NLAYER = 4;
constexpr int PJ = 4096;
constexpr int PTOT = 3848;
constexpr int C_Z = 1536, C_RW = 2048, C_GA = 3840, C_GB = 3844;
constexpr int DFF = 4096;
constexpr int RWP = 1792;
constexpr float DN_ALPHA = 1.681792830507429f;
constexpr int LDS_BYTES = 151552;
constexpr int NPHASE = 2 + 9 * NLAYER;

constexpr size_t WS_MOD = 0;
constexpr size_t WS_WIN = 2359296;
constexpr size_t WS_WOUT = WS_WIN + 8388608;
constexpr size_t WS_W1 = WS_WOUT + 2097152;
constexpr size_t WS_W2 = WS_W1 + 8388608;
constexpr size_t WS_LW2 = WS_W2 + 8388608;
constexpr size_t WS_LA2 = WS_LW2 + 65536;
constexpr size_t WS_LG2 = WS_LA2 + 65536;
constexpr size_t WS_DL = WS_LG2 + 131072;
constexpr size_t WS_H = WS_DL + 16384;
constexpr size_t WS_R1 = WS_H + 68157440;
constexpr size_t WS_PREP = WS_R1 + 272629760;
constexpr size_t WS_BAR = WS_PREP + 153354240;
constexpr size_t WS_END = WS_BAR + 16384;
constexpr int PREP_STRIDE = 36864;
constexpr int PO_U0T = 0, PO_WKN = 8192, PO_QD = 16384, PO_KDT = 24576, PO_QK = 32768;

constexpr size_t O_PGDN = 34078720, O_PCONV = 38273024, O_PRW = 38567936, O_PSHIFT = 40665088;
constexpr size_t O_SGDN = 40779776, O_SCONV = 42876928, O_SRW = 43024384, O_SSHIFT = 44072960;

struct Ctx { int tid, bid, nb; };
struct Params {
    const float* in[33];
    float* out;
    unsigned char* ws;
    int ph_lo, ph_hi;
};

extern __shared__ __attribute__((aligned(16))) unsigned char smem[];

typedef __bf16 bf16x2_t __attribute__((ext_vector_type(2)));
__device__ __forceinline__ unsigned cvt_pk_bf16(float lo, float hi) { f32x2 f = {lo, hi}; bf16x2_t v = __builtin_convertvector(f, bf16x2_t); return __builtin_bit_cast(unsigned, v); }
__device__ __forceinline__ bf16_t f2bf(float f) { return (bf16_t)(cvt_pk_bf16(f, 0.f) & 0xffffu); }
__device__ __forceinline__ float bf2f(bf16_t b) { return __uint_as_float(((unsigned)b) << 16); }
__device__ __forceinline__ float bflo(unsigned w) { return __uint_as_float(w << 16); }
__device__ __forceinline__ float bfhi(unsigned w) { return __uint_as_float(w & 0xffff0000u); }
__device__ __forceinline__ void unpack8(u32x4 w, float* f) {
    f[0] = bflo(w.x); f[1] = bfhi(w.x); f[2] = bflo(w.y); f[3] = bfhi(w.y);
    f[4] = bflo(w.z); f[5] = bfhi(w.z); f[6] = bflo(w.w); f[7] = bfhi(w.w);
}
__device__ __forceinline__ u32x4 pack8(const float* f) {
    u32x4 w; w.x = cvt_pk_bf16(f[0], f[1]); w.y = cvt_pk_bf16(f[2], f[3]); w.z = cvt_pk_bf16(f[4], f[5]); w.w = cvt_pk_bf16(f[6], f[7]); return w;
}
__device__ __forceinline__ float silu_f(float x) { return x / (1.f + __expf(-x)); }
__device__ __forceinline__ float sigmoid_f(float x) { return 1.f / (1.f + __expf(-x)); }
__device__ __forceinline__ float softplus_f(float x) { return fmaxf(x, 0.f) + __logf(1.f + __expf(-fabsf(x))); }
__device__ __forceinline__ float tanh_f(float x) { return 1.f - 2.f / (1.f + __expf(2.f * x)); }
__device__ __forceinline__ float dpp_x1(float x) { return __int_as_float(__builtin_amdgcn_mov_dpp(__float_as_int(x), 0xB1, 0xF, 0xF, true)); }
__device__ __forceinline__ float dpp_x2(float x) { return __int_as_float(__builtin_amdgcn_mov_dpp(__float_as_int(x), 0x4E, 0xF, 0xF, true)); }
__device__ __forceinline__ float dpp_hm(float x) { return __int_as_float(__builtin_amdgcn_mov_dpp(__float_as_int(x), 0x141, 0xF, 0xF, true)); }
__device__ __forceinline__ float dpp_rm(float x) { return __int_as_float(__builtin_amdgcn_mov_dpp(__float_as_int(x), 0x140, 0xF, 0xF, true)); }
__device__ __forceinline__ float red8(float x) { x += dpp_x1(x); x += dpp_x2(x); x += dpp_hm(x); return x; }
__device__ __forceinline__ float red16(float x) { x = red8(x); x += dpp_rm(x); return x; }
__device__ __forceinline__ float wave_sum(float v) {
#pragma unroll
    for (int o = 1; o < 64; o <<= 1) v += __shfl_xor(v, o);
    return v;
}
__device__ __forceinline__ int seq_of_row(int row) { return row < NTP ? (row >> 11) : 16 + ((row - NTP) >> 6); }
#define LDS_WAIT() asm volatile("s_waitcnt lgkmcnt(0)" ::: "memory")

__device__ __forceinline__ void phase_mod(const Ctx& cx, const Params& p) {
    float* sc = (float*)smem;
    const int tid = cx.tid;
    const float* c_p = p.in[2]; const float* c_s = p.in[3];
    const float* w_ada = p.in[8]; const float* b_ada = p.in[9];
    float* MOD = (float*)(p.ws + WS_MOD);
    for (int item = cx.bid; item < NLAYER * 96; item += cx.nb) {
        const int l = item / 96, cgp = item % 96;
        for (int idx = tid; idx < 24 * 1024; idx += 512) {
            const int s = idx >> 10, k = idx & 1023;
            const float c = s < 16 ? c_p[s * 1024 + k] : c_s[(s - 16) * 1024 + k];
            sc[k * 24 + s] = silu_f(c);
        }
        __syncthreads();
        const int kg = tid >> 6, col = tid & 63;
        float acc[24];
#pragma unroll
        for (int s = 0; s < 24; ++s) acc[s] = 0.f;
        const float* wp = w_ada + (size_t)l * 1024 * 6144 + (size_t)(kg * 128) * 6144 + cgp * 64 + col;
#pragma unroll 16
        for (int k = 0; k < 128; ++k) {
            const float w = wp[(size_t)k * 6144];
            const f32x4* sp = (const f32x4*)(sc + (kg * 128 + k) * 24);
#pragma unroll
            for (int q = 0; q < 6; ++q) { const f32x4 v = sp[q]; acc[4 * q] += v.x * w; acc[4 * q + 1] += v.y * w; acc[4 * q + 2] += v.z * w; acc[4 * q + 3] += v.w * w; }
        }
        __syncthreads();
#pragma unroll
        for (int s = 0; s < 24; ++s) sc[(kg * 24 + s) * 64 + col] = acc[s];
        __syncthreads();
        for (int o = tid; o < 24 * 64; o += 512) {
            const int s = o >> 6, c = o & 63;
            float sum = b_ada[l * 6144 + cgp * 64 + c];
#pragma unroll
            for (int g = 0; g < 8; ++g) sum += sc[(g * 24 + s) * 64 + c];
            MOD[(size_t)(l * 24 + s) * 6144 + cgp * 64 + c] = sum;
        }
        __syncthreads();
    }
}

__device__ __forceinline__ int win_map(int n) { return n < 2048 ? n : (n < 2056 ? n - 2048 + C_GA : n - 8); }
__device__ __forceinline__ void transpose_w(const Ctx& cx, const float* W, int K, int N, bf16_t* WT, int mode, int gw, int NGW, int rot) {
    const int lane = cx.tid & 63, wave = cx.tid >> 6;
    float* scr = (float*)(smem + wave * 8448);
    const int nblk = (N + 31) / 32, nitems = (K / 64) * nblk;
    int start = gw - rot; while (start < 0) start += NGW;
    for (int it = start; it < nitems; it += NGW) {
        const int kb = it / nblk, nb = it % nblk, k0 = 64 * kb, n0 = 32 * nb;
        const int nn = n0 + (lane & 31);
#pragma unroll
        for (int i = 0; i < 32; ++i) { const int kk = 2 * i + (lane >> 5); scr[kk * 33 + (lane & 31)] = nn < N ? W[(size_t)(k0 + kk) * N + nn] : 0.f; }
        LDS_WAIT();
        const int c = lane & 7;
#pragma unroll
        for (int j = 0; j < 4; ++j) {
            const int nl = (lane >> 3) + 8 * j, n = n0 + nl;
            const float* s = scr + (8 * c) * 33 + nl;
            u32x4 o; o.x = cvt_pk_bf16(s[0], s[33]); o.y = cvt_pk_bf16(s[66], s[99]); o.z = cvt_pk_bf16(s[132], s[165]); o.w = cvt_pk_bf16(s[198], s[231]);
            if (n < N) { const int row = mode ? win_map(n) : n; *(u32x4*)(WT + (size_t)row * K + k0 + 8 * c) = o; }
        }
        LDS_WAIT();
    }
}
__device__ __forceinline__ void phase_weights(const Ctx& cx, const Params& p, int l) {
    const int gw = cx.bid * 8 + (cx.tid >> 6), NGW = cx.nb * 8;
    unsigned char* ws = p.ws;
    transpose_w(cx, p.in[10] + (size_t)l * 1024 * PTOT, 1024, PTOT, (bf16_t*)(ws + WS_WIN), 1, gw, NGW, 0);
    transpose_w(cx, p.in[26] + (size_t)l * 1024 * 1024, 1024, 1024, (bf16_t*)(ws + WS_WOUT), 0, gw, NGW, 1936 % NGW);
    transpose_w(cx, p.in[29] + (size_t)l * 1024 * 4096, 1024, 4096, (bf16_t*)(ws + WS_W1), 0, gw, NGW, (1936 + 512) % NGW);
    transpose_w(cx, p.in[30] + (size_t)l * 4096 * 1024, 4096, 1024, (bf16_t*)(ws + WS_W2), 0, gw, NGW, (1936 + 512 + 2048) % NGW);
    transpose_w(cx, p.in[17] + (size_t)l * 64 * 512, 64, 512, (bf16_t*)(ws + WS_LW2), 0, gw, NGW, (1936 + 512 + 4096) % NGW);
    transpose_w(cx, p.in[19] + (size_t)l * 64 * 512, 64, 512, (bf16_t*)(ws + WS_LA2), 0, gw, NGW, (1936 + 512 + 4096 + 16) % NGW);
    transpose_w(cx, p.in[20] + (size_t)l * 128 * 512, 128, 512, (bf16_t*)(ws + WS_LG2), 0, gw, NGW, (1936 + 512 + 4096 + 32) % NGW);
    u32x4* z = (u32x4*)(ws + WS_WIN + (size_t)PTOT * 1024 * 2);
    const u32x4 zero = {0u, 0u, 0u, 0u};
    for (int i = cx.bid * 512 + cx.tid; i < (PJ - PTOT) * 128; i += cx.nb * 512) z[i] = zero;
}

__device__ __forceinline__ void phase_mod0(const Ctx& cx, const Params& p) {
    const int lane = cx.tid & 63;
    const int gw = cx.bid * 8 + (cx.tid >> 6), NGW = cx.nb * 8;
    const float* MOD = (const float*)(p.ws + WS_MOD);
    bf16_t* H = (bf16_t*)(p.ws + WS_H);
#pragma unroll 2
    for (int row = gw; row < NTOK; row += NGW) {
        const float* xr = row < NTP ? p.in[0] + (size_t)row * 1024 : p.in[1] + (size_t)(row - NTP) * 1024;
        const float* md = MOD + (size_t)seq_of_row(row) * 6144;
#pragma unroll
        for (int j = 0; j < 4; ++j) {
            const int col = lane * 4 + 256 * j;
            const f32x4 x = *(const f32x4*)(xr + col), sh = *(const f32x4*)(md + col), scv = *(const f32x4*)(md + 1024 + col);
            u32x2 o; o.x = cvt_pk_bf16(x.x * (1.f + scv.x) + sh.x, x.y * (1.f + scv.y) + sh.y); o.y = cvt_pk_bf16(x.z * (1.f + scv.z) + sh.z, x.w * (1.f + scv.w) + sh.w);
            *(u32x2*)(H + (size_t)row * 1024 + col) = o;
        }
    }
}

__device__ __forceinline__ void phase_ln(const Ctx& cx, const Params& p, const float* lw, const float* lb, const float* modl  , int sh_off, int sc_off, bool final_out) {
    const int lane = cx.tid & 63;
    const int gw = cx.bid * 8 + (cx.tid >> 6), NGW = cx.nb * 8;
    float* X = p.out;
    bf16_t* H = (bf16_t*)(p.ws + WS_H);
#ifndef REP_LN
#define REP_LN 0
#endif
    for (int rep = 0; rep <= REP_LN; ++rep)
    for (int row = gw; row < NTOK; row += NGW) {
        const bool dry = rep < REP_LN;
        float* xr = X + (size_t)row * 1024;
        const bf16_t* vr = (const bf16_t*)(p.ws + WS_PREP) + (size_t)row * 1024;
        f32x4 v[4]; float s = 0.f;
#pragma unroll
        for (int j = 0; j < 4; ++j) { const u32x2 w = *(const u32x2*)(vr + lane * 4 + 256 * j); v[j] = (f32x4){bflo(w.x), bfhi(w.x), bflo(w.y), bfhi(w.y)}; s += (v[j].x + v[j].y) + (v[j].z + v[j].w); }
        const float mean = wave_sum(s) * (1.f / 1024.f); float s2 = 0.f;
#pragma unroll
        for (int j = 0; j < 4; ++j) { v[j] = v[j] - mean; s2 += (v[j].x * v[j].x + v[j].y * v[j].y) + (v[j].z * v[j].z + v[j].w * v[j].w); }
        const float rstd = rsqrtf(wave_sum(s2) * (1.f / 1024.f) + 1e-5f);
        if (dry && rstd != -1.f) continue;
        const float* md = modl ? modl + (size_t)seq_of_row(row) * 6144 : nullptr;
#pragma unroll
        for (int j = 0; j < 4; ++j) {
            const int col = lane * 4 + 256 * j;
            const f32x4 w = *(const f32x4*)(lw + col), b = *(const f32x4*)(lb + col);
            const f32x4 x = v[j] * rstd * w + b;
            if (final_out) *(f32x4*)(xr + col) = x;
            else { u32x2 ox; ox.x = cvt_pk_bf16(x.x, x.y); ox.y = cvt_pk_bf16(x.z, x.w); *(u32x2*)((bf16_t*)X + (size_t)row * 1024 + col) = ox; }
            if (md) {
                const f32x4 sh = *(const f32x4*)(md + sh_off + col), scv = *(const f32x4*)(md + sc_off + col);
                u32x2 o; o.x = cvt_pk_bf16(x.x * (1.f + scv.x) + sh.x, x.y * (1.f + scv.y) + sh.y); o.y = cvt_pk_bf16(x.z * (1.f + scv.z) + sh.z, x.w * (1.f + scv.w) + sh.w);
                *(u32x2*)(H + (size_t)row * 1024 + col) = o;
            }
        }
    }
}

#define LAS __attribute__((address_space(3)))
namespace gm {
constexpr int BM = 256, BK = 64, HALF = 128, HTB = HALF * BK * 2, NXCD = 8, WGM = 8;
__device__ __forceinline__ int lds_byte(int r, int c) { const int st = (r >> 4) * 2 + (c >> 5), rr = r & 15, cc = c & 31, ob = rr * 64 + cc * 2; return st * 1024 + (ob ^ (((ob >> 9) & 1) << 5)); }
__device__ __forceinline__ void stage_rc(int b, int& R, int& C) { const int st = b / 1024, sb = b % 1024, swz = sb ^ (((sb >> 9) & 1) << 5); R = (st >> 1) * 16 + swz / 64; C = (st & 1) * 32 + (swz % 64) / 2; }
__device__ __forceinline__ int perm32(int rho) { const int n = rho >> 4, i = rho & 15; return 8 * (i >> 2) + 4 * n + (i & 3); }
struct Unit { int pm, pn; };
struct Order {
    int nM, nN, nwg, G, c;
    __device__ __forceinline__ bool next(int i, Unit& u) const {
        const long L = (long)i * G + c; if (L >= nwg) return false;
        int wgid = (int)L; { const int q = nwg / NXCD, r = nwg % NXCD, xcd = wgid % NXCD, off = wgid / NXCD; wgid = (xcd < r ? xcd * (q + 1) : r * (q + 1) + (xcd - r) * q) + off; }
        const int nig = WGM * nN, gid = wgid / nig, fm = gid * WGM, gsz = (nM - fm) < WGM ? (nM - fm) : WGM;
        u.pm = fm + ((wgid % nig) % gsz); u.pn = (wgid % nig) / gsz; return true;
    }
};
struct Epi {
    int kind;
    bf16_t* O; int ldo;
    const float* xp; const float* xs; float* X; const float* gate;
    const bf16_t* xb;
};
__device__ __forceinline__ void epilogue(const Epi& E, const f32x4 (&acc)[2][2][4][2], const Unit& u, int wr, int wc, int fr, int fq) {
    const int brow = u.pm * BM, bcol = u.pn * BM;
    if (E.kind == 0) return;
    if (E.kind == 2) {
#pragma unroll
        for (int ai = 0; ai < 2; ++ai)
#pragma unroll
            for (int m = 0; m < 4; ++m) {
                const int row = brow + ai * HALF + wr * 64 + m * 16 + fr;
                const float* xsrc = (row < NTP ? E.xp : E.xs) + (size_t)row * 1024;
                const bf16_t* xb = E.xb + (size_t)row * 1024;
                const float* gt = E.gate + (size_t)seq_of_row(row) * 6144;
                bf16_t* xo = E.O + (size_t)row * 1024;
#pragma unroll
                for (int bj = 0; bj < 2; ++bj) {
                    const int col = bcol + bj * HALF + wc * 32 + fq * 8;
                    f32x4 x0, x1;
                    if (E.xb) { const u32x4 w = *(const u32x4*)(xb + col); x0 = (f32x4){bflo(w.x), bfhi(w.x), bflo(w.y), bfhi(w.y)}; x1 = (f32x4){bflo(w.z), bfhi(w.z), bflo(w.w), bfhi(w.w)}; }
                    else { x0 = *(const f32x4*)(xsrc + col); x1 = *(const f32x4*)(xsrc + col + 4); }
                    const f32x4 g0 = *(const f32x4*)(gt + col), g1 = *(const f32x4*)(gt + col + 4);
                    const f32x4 v0 = x0 * DN_ALPHA + g0 * acc[ai][bj][m][0], v1 = x1 * DN_ALPHA + g1 * acc[ai][bj][m][1];
                    u32x4 o; o.x = cvt_pk_bf16(v0.x, v0.y); o.y = cvt_pk_bf16(v0.z, v0.w); o.z = cvt_pk_bf16(v1.x, v1.y); o.w = cvt_pk_bf16(v1.z, v1.w);
                    *(u32x4*)(xo + col) = o;
                }
            }
    } else {
        const bool sq = (E.kind == 3);
#pragma unroll
        for (int ai = 0; ai < 2; ++ai)
#pragma unroll
            for (int m = 0; m < 4; ++m) {
                const int row = brow + ai * HALF + wr * 64 + m * 16 + fr;
                bf16_t* orow = E.O + (size_t)row * E.ldo;
#pragma unroll
                for (int bj = 0; bj < 2; ++bj) {
                    const int col = bcol + bj * HALF + wc * 32 + fq * 8;
                    f32x4 v0 = acc[ai][bj][m][0], v1 = acc[ai][bj][m][1];
                    if (sq) {
                        v0.x = fmaxf(v0.x, 0.f); v0.y = fmaxf(v0.y, 0.f); v0.z = fmaxf(v0.z, 0.f); v0.w = fmaxf(v0.w, 0.f); v0 = v0 * v0;
                        v1.x = fmaxf(v1.x, 0.f); v1.y = fmaxf(v1.y, 0.f); v1.z = fmaxf(v1.z, 0.f); v1.w = fmaxf(v1.w, 0.f); v1 = v1 * v1;
                    }
                    u32x4 o; o.x = cvt_pk_bf16(v0.x, v0.y); o.y = cvt_pk_bf16(v0.z, v0.w); o.z = cvt_pk_bf16(v1.x, v1.y); o.w = cvt_pk_bf16(v1.z, v1.w);
                    *(u32x4*)(orow + col) = o;
                }
            }
    }
}
}

__device__ __forceinline__ void gemm_phase(const Ctx& cx, const bf16_t* gA, const bf16_t* gBt, int M, int N, int K, const gm::Epi& E) {
    using namespace gm;
    LAS unsigned char* lds = (LAS unsigned char*)smem;
    Order S; S.nM = M / BM; S.nN = N / BM; S.nwg = S.nM * S.nN; S.G = cx.nb; S.c = cx.bid;
    const int tid = cx.tid, wid = __builtin_amdgcn_readfirstlane(tid >> 6), lane = tid & 63, wr = wid >> 2, wc = wid & 3, fr = lane & 15, fq = lane >> 4;
    const int nt = K / BK;
    unsigned voffA[2], voffB[2];
#pragma unroll
    for (int i = 0; i < 2; ++i) { int R, C; stage_rc(tid * 16 + i * 8192, R, C); const int Rb = (R & ~31) + perm32(R & 31);
        voffA[i] = (unsigned)(R * K + C) * 2u; voffB[i] = (unsigned)(Rb * K + C) * 2u; }
    const size_t kstep = (size_t)(BK * 2);
    const size_t hstep = (size_t)HALF * K * 2;
    const size_t tstep = 2 * hstep;
    const unsigned ldsw = (unsigned)wid * 1024u;
    const int aoff = lds_byte(wr * 64 + fr, fq * 8), boff = lds_byte(wc * 32 + fr, fq * 8);
#define PG8_SA(b, h) (((b) * 2 + (h)) * HTB)
#define PG8_SB(b, h) ((4 + (b) * 2 + (h)) * HTB)
#define PG8_STAGE(bufoff, gbase, voff) do { _Pragma("unroll") for (int _i = 0; _i < 2; ++_i) \
        __builtin_amdgcn_global_load_lds((const unsigned*)((const char*)(gbase) + (voff)[_i]), (LAS unsigned*)(lds + (bufoff) + ldsw + _i * 8192), 16, 0, 0); } while (0)
#define PG8_LDA(dst, b, h) do { _Pragma("unroll") for (int m = 0; m < 4; ++m) _Pragma("unroll") for (int k = 0; k < 2; ++k) dst[m][k] = *(const LAS bf16x8*)(lds + PG8_SA(b, h) + aoff + m * 2048 + k * 1024); } while (0)
#define PG8_LDB(dst, b, h) do { _Pragma("unroll") for (int n = 0; n < 2; ++n) _Pragma("unroll") for (int k = 0; k < 2; ++k) dst[n][k] = *(const LAS bf16x8*)(lds + PG8_SB(b, h) + boff + n * 2048 + k * 1024); } while (0)
#define PG8_MMA(ai, bj, At, Bt) do { __builtin_amdgcn_s_setprio(1); _Pragma("unroll") for (int m = 0; m < 4; ++m) _Pragma("unroll") for (int n = 0; n < 2; ++n) _Pragma("unroll") for (int k = 0; k < 2; ++k) \
        acc[ai][bj][m][n] = __builtin_amdgcn_mfma_f32_16x16x32_bf16(Bt[n][k], At[m][k], acc[ai][bj][m][n], 0, 0, 0); __builtin_amdgcn_s_setprio(0); } while (0)
#define PG8_WAIT_V(n) asm volatile("s_waitcnt vmcnt(" #n ")" ::: "memory")
#define PG8_WAIT_L(n) asm volatile("s_waitcnt lgkmcnt(" #n ")" ::: "memory")
#define PG8_BAR __builtin_amdgcn_s_barrier()
#define PG8_SCHED __builtin_amdgcn_sched_barrier(0)
    Unit cur, nxt; int ui = 0;
    if (S.next(0, cur)) {
    f32x4 acc[2][2][4][2];
#pragma unroll
    for (int a = 0; a < 2; ++a)
#pragma unroll
        for (int b = 0; b < 2; ++b)
#pragma unroll
            for (int m = 0; m < 4; ++m)
#pragma unroll
                for (int n = 0; n < 2; ++n) acc[a][b][m][n] = (f32x4){0.f, 0.f, 0.f, 0.f};
    bf16x8 At[4][2], B0[2][2], B1[2][2];
    const char* cA = (const char*)gA + (size_t)cur.pm * tstep; const char* cB = (const char*)gBt + (size_t)cur.pn * tstep;
    PG8_STAGE(PG8_SB(0, 0), cB, voffB); PG8_STAGE(PG8_SB(0, 1), cB + hstep, voffB); PG8_STAGE(PG8_SA(0, 0), cA, voffA); PG8_STAGE(PG8_SA(0, 1), cA + hstep, voffA);
    if (wr == 1) PG8_BAR;
    PG8_WAIT_V(2); PG8_BAR;
    PG8_STAGE(PG8_SB(1, 0), cB + kstep, voffB); PG8_STAGE(PG8_SA(1, 0), cA + kstep, voffA); PG8_STAGE(PG8_SB(1, 1), cB + hstep + kstep, voffB);
    PG8_WAIT_V(6); PG8_BAR;
    for (;;) {
        const bool has_next = S.next(ui + 1, nxt);
        const char* nA = has_next ? (const char*)gA + (size_t)nxt.pm * tstep : cA; const char* nB = has_next ? (const char*)gBt + (size_t)nxt.pn * tstep : cB;
        for (int t = 0; t < nt; t += 2) {
            const bool last = (t == nt - 2);
            const char* a1 = cA + (size_t)(t + 1) * kstep;
            const char* a2 = last ? nA : cA + (size_t)(t + 2) * kstep; const char* b2 = last ? nB : cB + (size_t)(t + 2) * kstep;
            const char* a3 = a2 + kstep; const char* b3 = b2 + kstep;
            PG8_LDB(B0, 0, 0); PG8_LDB(B1, 0, 1); PG8_SCHED; PG8_LDA(At, 0, 0); PG8_STAGE(PG8_SA(1, 1), a1 + hstep, voffA);
            PG8_WAIT_V(8); PG8_WAIT_L(0); PG8_BAR; PG8_MMA(0, 0, At, B0); PG8_MMA(0, 1, At, B1); PG8_BAR; PG8_SCHED;
            PG8_LDA(At, 0, 1); PG8_STAGE(PG8_SB(0, 0), b2, voffB); PG8_STAGE(PG8_SB(0, 1), b2 + hstep, voffB); PG8_STAGE(PG8_SA(0, 0), a2, voffA);
            PG8_WAIT_V(8); PG8_WAIT_L(0); PG8_BAR; PG8_MMA(1, 0, At, B0); PG8_MMA(1, 1, At, B1); PG8_BAR; PG8_SCHED;
            PG8_LDB(B0, 1, 0); PG8_LDB(B1, 1, 1); PG8_SCHED; PG8_LDA(At, 1, 0); PG8_STAGE(PG8_SA(0, 1), a2 + hstep, voffA);
            PG8_WAIT_V(8); PG8_WAIT_L(0); PG8_BAR; PG8_MMA(0, 0, At, B0); PG8_MMA(0, 1, At, B1); PG8_BAR; PG8_SCHED;
            PG8_LDA(At, 1, 1); PG8_STAGE(PG8_SB(1, 0), b3, voffB); PG8_STAGE(PG8_SB(1, 1), b3 + hstep, voffB); PG8_STAGE(PG8_SA(1, 0), a3, voffA);
            PG8_WAIT_V(8); PG8_WAIT_L(0); PG8_BAR; PG8_MMA(1, 0, At, B0); PG8_MMA(1, 1, At, B1); PG8_BAR; PG8_SCHED;
        }
        if (wr == 0) PG8_BAR;
        epilogue(E, acc, cur, wr, wc, fr, fq);
        if (!has_next) break;
#pragma unroll
        for (int a = 0; a < 2; ++a)
#pragma unroll
            for (int b = 0; b < 2; ++b)
#pragma unroll
                for (int m = 0; m < 4; ++m)
#pragma unroll
                    for (int n = 0; n < 2; ++n) acc[a][b][m][n] = (f32x4){0.f, 0.f, 0.f, 0.f};
        cur = nxt; cA = nA; cB = nB; ++ui;
        if (wr == 1) PG8_BAR;
    }
    PG8_WAIT_V(0);
    PG8_BAR;
    }
#undef PG8_SA
#undef PG8_SB
#undef PG8_STAGE
#undef PG8_LDA
#undef PG8_LDB
#undef PG8_MMA
}

__device__ __forceinline__ void tri_inv64(const float* AM, float* TF, float* WSB, int tid) {
    const int lane = tid & 63, wave = tid >> 6;
    if (wave == 0) {
        const int bb = lane >> 4, cc = lane & 15;
        const float* Ab = AM + (16 * bb) * 68 + 16 * bb;
        float x[16];
#pragma unroll
        for (int i = 0; i < 16; ++i) {
            float a = (i == cc) ? 1.f : 0.f;
#pragma unroll
            for (int j = 0; j < i; ++j) a -= Ab[i * 68 + j] * x[j];
            x[i] = a;
            TF[(16 * bb + i) * 68 + 16 * bb + cc] = a;
        }
    }
    __syncthreads();
    {
        const int g = tid >> 8, i = (tid >> 4) & 15, c = tid & 15, o = 32 * g;
        const float* ar = AM + (o + 16 + i) * 68 + o;
        float acc = 0.f;
#pragma unroll
        for (int k = 0; k < 16; ++k) acc += ar[k] * TF[(o + k) * 68 + o + c];
        WSB[(o + 16 + i) * 68 + o + c] = acc;
        __syncthreads();
        const float* dr = TF + (o + 16 + i) * 68 + o + 16;
        acc = 0.f;
#pragma unroll
        for (int k = 0; k < 16; ++k) acc += dr[k] * WSB[(o + 16 + k) * 68 + o + c];
        TF[(o + 16 + i) * 68 + o + c] = -acc;
    }
    __syncthreads();
    {
        const int i = tid >> 4, c = tid & 15;
        const float* ar = AM + (32 + i) * 68;
        float a0 = 0.f, a1 = 0.f;
#pragma unroll
        for (int k = 0; k < 16; ++k) a0 += ar[k] * TF[k * 68 + c];
#pragma unroll
        for (int k = 16; k < 32; ++k) { const float av = ar[k]; a0 += av * TF[k * 68 + c]; a1 += av * TF[k * 68 + 16 + c]; }
        WSB[(32 + i) * 68 + c] = a0; WSB[(32 + i) * 68 + 16 + c] = a1;
        __syncthreads();
        const float* dr = TF + (32 + i) * 68 + 32;
        a0 = 0.f; a1 = 0.f;
#pragma unroll
        for (int k = 0; k < 16; ++k) { const float dv = dr[k]; a0 += dv * WSB[(32 + k) * 68 + c]; a1 += dv * WSB[(32 + k) * 68 + 16 + c]; }
        if (i >= 16) {
#pragma unroll
            for (int k = 16; k < 32; ++k) { const float dv = dr[k]; a0 += dv * WSB[(32 + k) * 68 + c]; a1 += dv * WSB[(32 + k) * 68 + 16 + c]; }
        }
        TF[(32 + i) * 68 + c] = -a0; TF[(32 + i) * 68 + 16 + c] = -a1;
    }
}
__device__ __forceinline__ int swz_el(int row, int t) { return row * 72 + ((((t >> 3) ^ (row >> 3)) & 7) << 3) + (t & 7); }
__device__ __forceinline__ int swz_ch(int row, int c8) { return row * 72 + (((c8 ^ (row >> 3)) & 7) << 3); }

__device__ __forceinline__ void phase_gdn_prep(const Ctx& cx, const Params& p, int l) {
    const int tid = cx.tid, lane = tid & 63, wave = tid >> 6, fr = lane & 15, fq = lane >> 4;
    bf16_t* QN = (bf16_t*)(smem);
    bf16_t* KN = (bf16_t*)(smem + 17408);
    bf16_t* KBG = (bf16_t*)(smem + 34816);
    bf16_t* VB = (bf16_t*)(smem + 53248);
    float* AM = (float*)(smem + 71680);
    bf16_t* TM = (bf16_t*)(smem + 89088);
    float* GV = (float*)(smem + 98304);
    float* TF = (float*)(smem + 99328);
    float* WSB = (float*)(smem + 116736);
    const bf16_t* PROJ = (const bf16_t*)(p.ws + WS_R1);
    bf16_t* PREP = (bf16_t*)(p.ws + WS_PREP);
    float* DL = (float*)(p.ws + WS_DL);
    const float* convw = p.in[11] + (size_t)l * 4 * 1536;
    const float* conv_state = p.in[5];
#ifndef REP_PREP
#define REP_PREP 1
#endif
    for (int rep = 0; rep < REP_PREP; ++rep)
    for (int u = cx.bid; u < 2080; u += cx.nb) {
        const int c = u >> 2, h = u & 3, t0 = c * 64;
        const bool prompt = c < 512;
        const bool first = prompt ? ((c & 31) == 0) : true;
        const int sb = prompt ? 0 : (c - 512);
        bf16_t* P = PREP + (size_t)u * PREP_STRIDE;
#pragma unroll 1
        for (int pb = 0; pb < 2; ++pb) {
        u32x4 rawc[3][4];
#pragma unroll
        for (int pi = 0; pi < 3; ++pi) {
            const int ps = pb * 3 + pi;
            const int t = (ps & 1) * 32 + wave * 4 + fq, ch0 = (ps >> 1) * 512 + h * 128 + fr * 8;
#pragma unroll
            for (int j = 0; j < 4; ++j) { const int tt = t - 3 + j; rawc[pi][j] = *(const u32x4*)(PROJ + (size_t)(t0 + ((tt >= 0 || !first) ? tt : 0)) * PJ + ch0); }
        }
        if (pb == 0) {
        if (tid < 64) {
                const float ga = bf2f(PROJ[(size_t)(t0 + tid) * PJ + C_GA + h]), gb = bf2f(PROJ[(size_t)(t0 + tid) * PJ + C_GB + h]);
                float g = -__expf(p.in[12][l * 4 + h]) * softplus_f(ga + p.in[13][l * 4 + h]);
                GV[64 + tid] = sigmoid_f(gb);
#pragma unroll
                for (int off = 1; off < 64; off <<= 1) { const float o = __shfl_up(g, off); g += (tid >= off) ? o : 0.f; }
                GV[tid] = g;
            }
            __syncthreads();
        }
#pragma unroll
        for (int pi = 0; pi < 3; ++pi) {
            const int ps = pb * 3 + pi;
            const int kind = ps >> 1, t = (ps & 1) * 32 + wave * 4 + fq, cgp = fr;
            const int ch0 = kind * 512 + h * 128 + cgp * 8;
            float y[8];
#pragma unroll
            for (int e = 0; e < 8; ++e) y[e] = 0.f;
#pragma unroll
            for (int j = 0; j < 4; ++j) {
                const int tt = t - 3 + j;
                float x[8];
                if (tt >= 0 || !first) {
                    unpack8(rawc[pi][j], x);
                } else if (!prompt) {
                    const float* cs = conv_state + ((size_t)(l * 8 + sb) * 3 + (tt + 3)) * 1536 + ch0;
                    const f32x4 a = *(const f32x4*)cs, b = *(const f32x4*)(cs + 4);
                    x[0] = a.x; x[1] = a.y; x[2] = a.z; x[3] = a.w; x[4] = b.x; x[5] = b.y; x[6] = b.z; x[7] = b.w;
                } else {
#pragma unroll
                    for (int e = 0; e < 8; ++e) x[e] = 0.f;
                }
                const f32x4 w0 = *(const f32x4*)(convw + j * 1536 + ch0), w1 = *(const f32x4*)(convw + j * 1536 + ch0 + 4);
                y[0] += x[0] * w0.x; y[1] += x[1] * w0.y; y[2] += x[2] * w0.z; y[3] += x[3] * w0.w;
                y[4] += x[4] * w1.x; y[5] += x[5] * w1.y; y[6] += x[6] * w1.z; y[7] += x[7] * w1.w;
            }
            float ss = 0.f;
#pragma unroll
            for (int e = 0; e < 8; ++e) { y[e] = silu_f(y[e]); ss += y[e] * y[e]; }
            const float gt = GV[t], bt = GV[64 + t];
            if (kind == 0) {
                ss = red16(ss);
                const float rn = rsqrtf(ss + 1e-6f) * 0.08838834764831845f;
                float q[8], qd[8]; const float eg = __expf(gt);
#pragma unroll
                for (int e = 0; e < 8; ++e) { q[e] = y[e] * rn; qd[e] = q[e] * eg; }
                *(u32x4*)(QN + t * 136 + cgp * 8) = pack8(q);
                *(u32x4*)(P + PO_QD + t * 128 + cgp * 8) = pack8(qd);
            } else if (kind == 1) {
                ss = red16(ss);
                const float rn = rsqrtf(ss + 1e-6f);
                float k[8]; const float sc2 = bt * __expf(gt);
#pragma unroll
                for (int e = 0; e < 8; ++e) { k[e] = y[e] * rn; KBG[swz_el(cgp * 8 + e, t)] = f2bf(k[e] * sc2); }
                *(u32x4*)(KN + t * 136 + cgp * 8) = pack8(k);
            } else {
#pragma unroll
                for (int e = 0; e < 8; ++e) VB[swz_el(cgp * 8 + e, t)] = f2bf(y[e] * bt);
            }
        }
        }
        __syncthreads();
        const float g_last = GV[63];
        if (h == 0 && (!prompt || (c & 31) == 31)) {
            float* co = p.out + (prompt ? O_PCONV + (size_t)(l * 16 + (c >> 5)) * 4608 : O_SCONV + (size_t)(l * 8 + sb) * 4608);
            for (int i = tid; i < 4608; i += 512) { const int r = i / 1536, ch = i % 1536; co[i] = bf2f(PROJ[(size_t)(t0 + 61 + r) * PJ + ch]); }
        }
        {
            const int d = tid >> 2, tq = tid & 3;
            float v[16];
#pragma unroll
            for (int i = 0; i < 16; ++i) { const int t = tq * 16 + i; v[i] = bf2f(KN[t * 136 + d]) * __expf(g_last - GV[t]); }
            *(u32x4*)(P + PO_KDT + d * 64 + tq * 16) = pack8(v);
            *(u32x4*)(P + PO_KDT + d * 64 + tq * 16 + 8) = pack8(v + 8);
        }
#pragma unroll
        for (int q = 0; q < 2; ++q) {
            const int tile = wave * 2 + q, tm = tile >> 2, tn = tile & 3;
            f32x4 akk = {0.f, 0.f, 0.f, 0.f}, aqk = {0.f, 0.f, 0.f, 0.f};
#pragma unroll
            for (int kk = 0; kk < 4; ++kk) {
                const bf16x8 ka = *(const bf16x8*)(KN + (tm * 16 + fr) * 136 + kk * 32 + fq * 8);
                const bf16x8 kb = *(const bf16x8*)(KN + (tn * 16 + fr) * 136 + kk * 32 + fq * 8);
                const bf16x8 qb = *(const bf16x8*)(QN + (tn * 16 + fr) * 136 + kk * 32 + fq * 8);
                akk = __builtin_amdgcn_mfma_f32_16x16x32_bf16(ka, kb, akk, 0, 0, 0);
                aqk = __builtin_amdgcn_mfma_f32_16x16x32_bf16(ka, qb, aqk, 0, 0, 0);
            }
            {
                const int i = tn * 16 + fr; const float gi = GV[i];
#pragma unroll
                for (int j = 0; j < 4; ++j) { const int t = tm * 16 + fq * 4 + j; AM[t * 68 + i] = (t > i) ? GV[64 + t] * akk[j] * __expf(GV[t] - gi) : 0.f; }
            }
            {
                const int t = tn * 16 + fr; const float gtt = GV[t]; float o[4];
#pragma unroll
                for (int j = 0; j < 4; ++j) { const int i = tm * 16 + fq * 4 + j; o[j] = (t >= i) ? aqk[j] * __expf(gtt - GV[i]) : 0.f; }
                u32x2 w; w.x = cvt_pk_bf16(o[0], o[1]); w.y = cvt_pk_bf16(o[2], o[3]);
                *(u32x2*)(P + PO_QK + t * 64 + tm * 16 + fq * 4) = w;
            }
        }
        __syncthreads();
        tri_inv64(AM, TF, WSB, tid);
        __syncthreads();
        for (int e = tid; e < 4096; e += 512) {
            const int i = e >> 6, cc = e & 63;
            TM[i * 72 + cc] = ((cc >> 4) <= (i >> 4)) ? f2bf(TF[i * 68 + cc]) : (bf16_t)0;
        }
        if (tid == 64) DL[u] = __expf(g_last);
        __syncthreads();
        {
            const int tm = wave & 3, vh = wave >> 2;
            bf16x8 ta[2];
#pragma unroll
            for (int kk = 0; kk < 2; ++kk) ta[kk] = *(const bf16x8*)(TM + (tm * 16 + fr) * 72 + kk * 32 + fq * 8);
#pragma unroll
            for (int n = 0; n < 4; ++n) {
                const int v = (vh * 4 + n) * 16 + fr;
                f32x4 a = {0.f, 0.f, 0.f, 0.f};
#pragma unroll
                for (int kk = 0; kk < 2; ++kk) a = __builtin_amdgcn_mfma_f32_16x16x32_bf16(ta[kk], *(const bf16x8*)(VB + swz_ch(v, kk * 4 + fq)), a, 0, 0, 0);
                u32x2 w; w.x = cvt_pk_bf16(a[0], a[1]); w.y = cvt_pk_bf16(a[2], a[3]);
                *(u32x2*)(P + PO_U0T + v * 64 + tm * 16 + fq * 4) = w;
            }
            bf16x8 ka[2];
#pragma unroll
            for (int kk = 0; kk < 2; ++kk) ka[kk] = *(const bf16x8*)(KBG + swz_ch(wave * 16 + fr, kk * 4 + fq));
#pragma unroll
            for (int tn = 0; tn < 4; ++tn) {
                f32x4 a = {0.f, 0.f, 0.f, 0.f};
#pragma unroll
                for (int kk = 0; kk < 2; ++kk) a = __builtin_amdgcn_mfma_f32_16x16x32_bf16(ka[kk], *(const bf16x8*)(TM + (tn * 16 + fr) * 72 + kk * 32 + fq * 8), a, 0, 0, 0);
                u32x2 w; w.x = cvt_pk_bf16(-a[0], -a[1]); w.y = cvt_pk_bf16(-a[2], -a[3]);
                *(u32x2*)(P + PO_WKN + (tn * 16 + fr) * 128 + wave * 16 + fq * 4) = w;
            }
        }
        __syncthreads();
    }
}

__device__ __forceinline__ void gdn_scan_unit(const Ctx& cx, const Params& p, int l, int seq, int h) {
    const int tid = cx.tid, lane = tid & 63, wave = tid >> 6, fr = lane & 15, fq = lane >> 4;
    bf16_t* ST = (bf16_t*)(smem);
    bf16_t* UT = (bf16_t*)(smem + 34816);
    float* OB = (float*)(smem + 53248);
    const bf16_t* PROJ = (const bf16_t*)(p.ws + WS_R1);
    const bf16_t* PREP = (const bf16_t*)(p.ws + WS_PREP);
    const float* DL = (const float*)(p.ws + WS_DL);
    bf16_t* YIN = (bf16_t*)(p.ws + WS_H);
    const bool prompt = seq < 16;
    const int b = prompt ? seq : seq - 16;
    const int nch = prompt ? 32 : 1;
    const float* nw = p.in[14] + l * 128;
    f32x4 S[8];
    if (prompt) {
#pragma unroll
        for (int n = 0; n < 8; ++n) S[n] = (f32x4){0.f, 0.f, 0.f, 0.f};
    } else {
        const float* s0 = p.in[4] + ((size_t)(l * 8 + b) * 4 + h) * 16384;
#pragma unroll
        for (int n = 0; n < 8; ++n)
#pragma unroll
            for (int j = 0; j < 4; ++j) S[n][j] = s0[(wave * 16 + fq * 4 + j) * 128 + n * 16 + fr];
    }
#pragma unroll
    for (int n = 0; n < 8; ++n) { u32x2 w; w.x = cvt_pk_bf16(S[n][0], S[n][1]); w.y = cvt_pk_bf16(S[n][2], S[n][3]); *(u32x2*)(ST + (n * 16 + fr) * 136 + wave * 16 + fq * 4) = w; }
    __syncthreads();
    const int tm = wave & 3, vh = wave >> 2;
#pragma unroll 1
    for (int ci = 0; ci < nch; ++ci) {
        const int c = prompt ? seq * 32 + ci : 512 + b;
        const int u = c * 4 + h, t0 = c * 64;
        const bf16_t* P = PREP + (size_t)u * PREP_STRIDE;
        bf16x8 wkn[4], qd[4], qk[2], kdt[2];
#pragma unroll
        for (int kk = 0; kk < 4; ++kk) { wkn[kk] = *(const bf16x8*)(P + PO_WKN + (tm * 16 + fr) * 128 + kk * 32 + fq * 8); qd[kk] = *(const bf16x8*)(P + PO_QD + (tm * 16 + fr) * 128 + kk * 32 + fq * 8); }
#pragma unroll
        for (int kk = 0; kk < 2; ++kk) { qk[kk] = *(const bf16x8*)(P + PO_QK + (tm * 16 + fr) * 64 + kk * 32 + fq * 8); kdt[kk] = *(const bf16x8*)(P + PO_KDT + (wave * 16 + fr) * 64 + kk * 32 + fq * 8); }
        f32x4 U[4], O[4];
#pragma unroll
        for (int n = 0; n < 4; ++n) {
            const u32x2 w = *(const u32x2*)(P + PO_U0T + ((vh * 4 + n) * 16 + fr) * 64 + tm * 16 + fq * 4);
            U[n] = (f32x4){bflo(w.x), bfhi(w.x), bflo(w.y), bfhi(w.y)};
            O[n] = (f32x4){0.f, 0.f, 0.f, 0.f};
        }
        const float dl = DL[u];
#pragma unroll
        for (int kk = 0; kk < 4; ++kk)
#pragma unroll
            for (int n = 0; n < 4; ++n) {
                const bf16x8 sf = *(const bf16x8*)(ST + ((vh * 4 + n) * 16 + fr) * 136 + kk * 32 + fq * 8);
                U[n] = __builtin_amdgcn_mfma_f32_16x16x32_bf16(wkn[kk], sf, U[n], 0, 0, 0);
                O[n] = __builtin_amdgcn_mfma_f32_16x16x32_bf16(qd[kk], sf, O[n], 0, 0, 0);
            }
#pragma unroll
        for (int n = 0; n < 4; ++n) { u32x2 w; w.x = cvt_pk_bf16(U[n][0], U[n][1]); w.y = cvt_pk_bf16(U[n][2], U[n][3]); *(u32x2*)(UT + ((vh * 4 + n) * 16 + fr) * 72 + tm * 16 + fq * 4) = w; }
        __syncthreads();
#pragma unroll
        for (int kk = 0; kk < 2; ++kk)
#pragma unroll
            for (int n = 0; n < 4; ++n) O[n] = __builtin_amdgcn_mfma_f32_16x16x32_bf16(qk[kk], *(const bf16x8*)(UT + ((vh * 4 + n) * 16 + fr) * 72 + kk * 32 + fq * 8), O[n], 0, 0, 0);
#pragma unroll
        for (int n = 0; n < 8; ++n) {
            S[n] = S[n] * dl;
#pragma unroll
            for (int kk = 0; kk < 2; ++kk) S[n] = __builtin_amdgcn_mfma_f32_16x16x32_bf16(kdt[kk], *(const bf16x8*)(UT + (n * 16 + fr) * 72 + kk * 32 + fq * 8), S[n], 0, 0, 0);
        }
        __syncthreads();
#pragma unroll
        for (int n = 0; n < 8; ++n) { u32x2 w; w.x = cvt_pk_bf16(S[n][0], S[n][1]); w.y = cvt_pk_bf16(S[n][2], S[n][3]); *(u32x2*)(ST + (n * 16 + fr) * 136 + wave * 16 + fq * 4) = w; }
#pragma unroll
        for (int n = 0; n < 4; ++n)
#pragma unroll
            for (int j = 0; j < 4; ++j) OB[(tm * 16 + fq * 4 + j) * 132 + (vh * 4 + n) * 16 + fr] = O[n][j];
        __syncthreads();
        {
            const int t = tid >> 3, part = tid & 7;
            float o[16]; float ss = 0.f;
#pragma unroll
            for (int q = 0; q < 4; ++q) { const f32x4 v = *(const f32x4*)(OB + t * 132 + part * 16 + q * 4); o[4 * q] = v.x; o[4 * q + 1] = v.y; o[4 * q + 2] = v.z; o[4 * q + 3] = v.w; ss += v.x * v.x + v.y * v.y + v.z * v.z + v.w * v.w; }
            ss = red8(ss);
            const float rstd = rsqrtf(ss * (1.f / 128.f) + 1e-6f);
            const bf16_t* zp = PROJ + (size_t)(t0 + t) * PJ + C_Z + h * 128 + part * 16;
            float z[16]; unpack8(*(const u32x4*)zp, z); unpack8(*(const u32x4*)(zp + 8), z + 8);
#pragma unroll
            for (int e = 0; e < 16; ++e) o[e] = o[e] * rstd * nw[part * 16 + e] * silu_f(z[e]);
            bf16_t* yp = YIN + (size_t)(t0 + t) * 1024 + h * 128 + part * 16;
            *(u32x4*)yp = pack8(o); *(u32x4*)(yp + 8) = pack8(o + 8);
        }
    }
    {
        float* so = p.out + (prompt ? O_PGDN + ((size_t)(l * 16 + b) * 4 + h) * 16384 : O_SGDN + ((size_t)(l * 8 + b) * 4 + h) * 16384);
#pragma unroll
        for (int n = 0; n < 8; ++n)
#pragma unroll
            for (int j = 0; j < 4; ++j) so[(wave * 16 + fq * 4 + j) * 128 + n * 16 + fr] = S[n][j];
    }
    __syncthreads();
}

__device__ __forceinline__ void phase_rwkv_prep(const Ctx& cx, const Params& p, int l) {
    const int tid = cx.tid, lane = tid & 63, wave = tid >> 6, fr = lane & 15, fq = lane >> 4;
    bf16_t* XW = (bf16_t*)(smem);
    bf16_t* XA = (bf16_t*)(smem + 9216);
    bf16_t* XG = (bf16_t*)(smem + 18432);
    bf16_t* PROJ = (bf16_t*)(p.ws + WS_R1);
    const bf16_t* LW2 = (const bf16_t*)(p.ws + WS_LW2); const bf16_t* LA2 = (const bf16_t*)(p.ws + WS_LA2); const bf16_t* LG2 = (const bf16_t*)(p.ws + WS_LG2);
    const float* mu = p.in[15] + l * RWP;
#ifndef REP_RP
#define REP_RP 1
#endif
    for (int rep = 0; rep < REP_RP; ++rep)
    for (int c = cx.bid; c < 520; c += cx.nb) {
        const int t0 = c * 64;
        const bool prompt = c < 512;
        const bool first = prompt ? ((c & 31) == 0) : true;
        const float* shift_state = p.in[7] + (size_t)(l * 8 + (prompt ? 0 : c - 512)) * RWP;
        {
            const int t = tid >> 3, part = tid & 7;
#pragma unroll
            for (int q = 0; q < 4; ++q) {
                const int cl = part * 32 + q * 8;
                const int idx0 = 1536 + cl;
                float cur[8], prv[8], o[8];
                unpack8(*(const u32x4*)(PROJ + (size_t)(t0 + t) * PJ + C_RW + idx0), cur);
                if (t > 0 || !first) unpack8(*(const u32x4*)(PROJ + (size_t)(t0 + t - 1) * PJ + C_RW + idx0), prv);
                else if (!prompt) {
#pragma unroll
                    for (int e = 0; e < 8; ++e) prv[e] = shift_state[idx0 + e];
                } else {
#pragma unroll
                    for (int e = 0; e < 8; ++e) prv[e] = 0.f;
                }
#pragma unroll
                for (int e = 0; e < 8; ++e) {
                    const float x = cur[e] + (prv[e] - cur[e]) * mu[idx0 + e];
                    o[e] = cl < 64 ? tanh_f(x) : (cl < 128 ? x : sigmoid_f(x));
                }
                bf16_t* dst = cl < 64 ? XW + t * 72 + cl : (cl < 128 ? XA + t * 72 + (cl - 64) : XG + t * 136 + (cl - 128));
                *(u32x4*)dst = pack8(o);
            }
        }
        __syncthreads();
#pragma unroll 1
        for (int cp = 0; cp < 2; ++cp) {
            const int cb = wave * 64 + cp * 32;
            bf16x8 bw[2][2], ba[2][2], bg[2][4];
#pragma unroll
            for (int n = 0; n < 2; ++n) {
                const int nrow = cb + 8 * (fr >> 2) + 4 * n + (fr & 3);
#pragma unroll
                for (int kk = 0; kk < 2; ++kk) { bw[n][kk] = *(const bf16x8*)(LW2 + nrow * 64 + kk * 32 + fq * 8); ba[n][kk] = *(const bf16x8*)(LA2 + nrow * 64 + kk * 32 + fq * 8); }
#pragma unroll
                for (int kk = 0; kk < 4; ++kk) bg[n][kk] = *(const bf16x8*)(LG2 + nrow * 128 + kk * 32 + fq * 8);
            }
            const int ch = cb + 8 * fq;
            f32x4 w0[2], a0[2];
#pragma unroll
            for (int n = 0; n < 2; ++n) { w0[n] = *(const f32x4*)(p.in[16] + l * 512 + ch + 4 * n); a0[n] = *(const f32x4*)(p.in[18] + l * 512 + ch + 4 * n); }
#pragma unroll 1
            for (int tm = 0; tm < 4; ++tm) {
                f32x4 dw[2], da[2], dg[2];
#pragma unroll
                for (int n = 0; n < 2; ++n) { dw[n] = (f32x4){0.f, 0.f, 0.f, 0.f}; da[n] = dw[n]; dg[n] = dw[n]; }
#pragma unroll
                for (int kk = 0; kk < 2; ++kk) {
                    const bf16x8 xw = *(const bf16x8*)(XW + (tm * 16 + fr) * 72 + kk * 32 + fq * 8), xa = *(const bf16x8*)(XA + (tm * 16 + fr) * 72 + kk * 32 + fq * 8);
#pragma unroll
                    for (int n = 0; n < 2; ++n) { dw[n] = __builtin_amdgcn_mfma_f32_16x16x32_bf16(bw[n][kk], xw, dw[n], 0, 0, 0); da[n] = __builtin_amdgcn_mfma_f32_16x16x32_bf16(ba[n][kk], xa, da[n], 0, 0, 0); }
                }
#pragma unroll
                for (int kk = 0; kk < 4; ++kk) {
                    const bf16x8 xg = *(const bf16x8*)(XG + (tm * 16 + fr) * 136 + kk * 32 + fq * 8);
#pragma unroll
                    for (int n = 0; n < 2; ++n) dg[n] = __builtin_amdgcn_mfma_f32_16x16x32_bf16(bg[n][kk], xg, dg[n], 0, 0, 0);
                }
                float dv[8], av[8];
#pragma unroll
                for (int n = 0; n < 2; ++n)
#pragma unroll
                    for (int j = 0; j < 4; ++j) {
                        dv[4 * n + j] = __expf(-softplus_f(-(w0[n][j] + dw[n][j])) - 0.5f);
                        av[4 * n + j] = sigmoid_f(a0[n][j] + da[n][j]);
                    }
                bf16_t* orow = PROJ + (size_t)(t0 + tm * 16 + fr) * PJ + ch;
                *(u32x4*)(orow) = pack8(dv);
                *(u32x4*)(orow + 512) = pack8(av);
                u32x4 og; og.x = cvt_pk_bf16(dg[0][0], dg[0][1]); og.y = cvt_pk_bf16(dg[0][2], dg[0][3]); og.z = cvt_pk_bf16(dg[1][0], dg[1][1]); og.w = cvt_pk_bf16(dg[1][2], dg[1][3]);
                *(u32x4*)(orow + 1024) = og;
            }
        }
        __syncthreads();
    }
}

__device__ __forceinline__ void rwkv_scan_unit(const Ctx& cx, const Params& p, int l, int seq, int h) {
    const int tid = cx.tid, lane = tid & 63, wave = tid >> 6, fr = lane & 15, fq = lane >> 4;
    float* B0 = (float*)(smem);
    float* B1 = (float*)(smem + 16384);
    float* B2 = (float*)(smem + 32768);
    float* B3 = (float*)(smem + 49152);
    float* B4 = (float*)(smem + 65536);
    float* B5 = (float*)(smem + 81920);
    float* B6 = (float*)(smem + 98304);
    float* B7 = (float*)(smem + 114688);
    float* SCL = (float*)(smem + 131072);
    const bf16_t* PROJ = (const bf16_t*)(p.ws + WS_R1);
    bf16_t* YIN = (bf16_t*)(p.ws + WS_H);
    const bool prompt = seq < 16;
    const int b = prompt ? seq : seq - 16;
    const int nch = prompt ? 32 : 1;
    const float* mu = p.in[15] + l * RWP;
    const float* shift_state = p.in[7] + (size_t)(l * 8 + b) * RWP;
    const int row = tid >> 3, sub = tid & 7;
    const int r0 = tid >> 4, l16 = tid & 15;
    f32x2 S0[2], S1[2];
    if (prompt) {
#pragma unroll
        for (int q = 0; q < 2; ++q) { S0[q] = (f32x2){0.f, 0.f}; S1[q] = (f32x2){0.f, 0.f}; }
    } else {
        const float* s0 = p.in[6] + ((size_t)(l * 8 + b) * 8 + h) * 4096 + l16 * 4;
#pragma unroll
        for (int q = 0; q < 2; ++q) { S0[q] = *(const f32x2*)(s0 + r0 * 64 + 2 * q); S1[q] = *(const f32x2*)(s0 + (r0 + 32) * 64 + 2 * q); }
    }
#pragma unroll 1
    for (int ci = 0; ci < nch; ++ci) {
        const int t0 = prompt ? (seq * 32 + ci) * 64 : NTP + b * 64;
        const bool first = (ci == 0);
        {
            const int t = row, c0 = h * 64 + sub * 8, ch0 = l * 512 + c0;
            const bf16_t* prow = PROJ + (size_t)(t0 + t) * PJ;
            float r[8], k[8], v[8], dd[8], a[8], g[8];
            {
                float cur[8], prv[8];
#pragma unroll
                for (int kind = 0; kind < 3; ++kind) {
                    const int idx0 = kind * 512 + c0;
                    unpack8(*(const u32x4*)(prow + C_RW + idx0), cur);
                    if (t > 0 || !first) unpack8(*(const u32x4*)(prow - PJ + C_RW + idx0), prv);
                    else if (!prompt) {
#pragma unroll
                        for (int e = 0; e < 8; ++e) prv[e] = shift_state[idx0 + e];
                    } else {
#pragma unroll
                        for (int e = 0; e < 8; ++e) prv[e] = 0.f;
                    }
                    float* dst = kind == 0 ? r : (kind == 1 ? k : v);
#pragma unroll
                    for (int e = 0; e < 8; ++e) dst[e] = cur[e] + (prv[e] - cur[e]) * mu[idx0 + e];
                }
            }
            unpack8(*(const u32x4*)(prow + c0), dd); unpack8(*(const u32x4*)(prow + 512 + c0), a); unpack8(*(const u32x4*)(prow + 1024 + c0), g);
            float ss = 0.f, c1 = 0.f, c2 = 0.f, bn = 0.f;
            float kkv[8];
#pragma unroll
            for (int e = 0; e < 8; ++e) { kkv[e] = k[e] * p.in[21][ch0 + e]; ss += kkv[e] * kkv[e]; }
            ss = red8(ss);
            const float rn = rsqrtf(ss + 1e-6f);
#pragma unroll
            for (int e = 0; e < 8; ++e) {
                const float w = __expf(-dd[e]);
                const float kkn = kkv[e] * rn, ka = kkn * a[e];
                const float k2 = k[e] * (1.f + (a[e] - 1.f) * p.in[22][ch0 + e]);
                B6[t * 64 + sub * 8 + e] = kkn; B7[t * 64 + sub * 8 + e] = ka; B1[t * 64 + sub * 8 + e] = k2; B0[t * 64 + sub * 8 + e] = w * r[e];
                B3[t * 64 + sub * 8 + e] = w; B2[t * 64 + sub * 8 + e] = v[e]; B5[t * 64 + sub * 8 + e] = g[e];
                c1 += ka * r[e]; c2 += k2 * r[e]; bn += r[e] * k2 * p.in[23][ch0 + e];
            }
            c1 = red8(c1); c2 = red8(c2); bn = red8(bn);
            if (sub == 0) { SCL[t] = c1; SCL[64 + t] = c2; SCL[128 + t] = bn; }
        }
        __syncthreads();
        {
            const f32x4* KKp = (const f32x4*)(B6 + l16 * 4); const f32x4* WRp = (const f32x4*)(B0 + l16 * 4); const f32x4* Wp = (const f32x4*)(B3 + l16 * 4);
            const f32x4* KAp = (const f32x4*)(B7 + l16 * 4); const f32x4* K2p = (const f32x4*)(B1 + l16 * 4);
#pragma unroll 2
            for (int t = 0; t < 64; ++t) {
                const f32x4 kk4 = KKp[t * 16], wr4 = WRp[t * 16], w4 = Wp[t * 16], ka4 = KAp[t * 16], k24 = K2p[t * 16];
                const f32x2 kk[2] = {{kk4.x, kk4.y}, {kk4.z, kk4.w}}, wrr[2] = {{wr4.x, wr4.y}, {wr4.z, wr4.w}}, ww[2] = {{w4.x, w4.y}, {w4.z, w4.w}};
                const f32x2 ka[2] = {{ka4.x, ka4.y}, {ka4.z, ka4.w}}, k2[2] = {{k24.x, k24.y}, {k24.z, k24.w}};
                const float v0 = B2[t * 64 + r0], v1 = B2[t * 64 + r0 + 32], c1 = SCL[t], c2 = SCL[64 + t];
                f32x2 a0 = S0[0] * kk[0], b0 = S0[0] * wrr[0], a1 = S1[0] * kk[0], b1 = S1[0] * wrr[0];
                a0 = __builtin_elementwise_fma(S0[1], kk[1], a0); b0 = __builtin_elementwise_fma(S0[1], wrr[1], b0);
                a1 = __builtin_elementwise_fma(S1[1], kk[1], a1); b1 = __builtin_elementwise_fma(S1[1], wrr[1], b1);
                float d10 = a0.x + a0.y, d20 = b0.x + b0.y, d11 = a1.x + a1.y, d21 = b1.x + b1.y;
                d10 += dpp_x1(d10); d11 += dpp_x1(d11); d20 += dpp_x1(d20); d21 += dpp_x1(d21);
                d10 += dpp_x2(d10); d11 += dpp_x2(d11); d20 += dpp_x2(d20); d21 += dpp_x2(d21);
                d10 += dpp_hm(d10); d11 += dpp_hm(d11); d20 += dpp_hm(d20); d21 += dpp_hm(d21);
                d10 += dpp_rm(d10); d11 += dpp_rm(d11); d20 += dpp_rm(d20); d21 += dpp_rm(d21);
                const float sa0 = -d10, sa1 = -d11;
                const f32x2 sa02 = {sa0, sa0}, sa12 = {sa1, sa1}, v02 = {v0, v0}, v12 = {v1, v1};
#pragma unroll
                for (int q = 0; q < 2; ++q) {
                    S0[q] = __builtin_elementwise_fma(S0[q], ww[q], __builtin_elementwise_fma(sa02, ka[q], v02 * k2[q]));
                    S1[q] = __builtin_elementwise_fma(S1[q], ww[q], __builtin_elementwise_fma(sa12, ka[q], v12 * k2[q]));
                }
                if (l16 == 0) { B4[t * 64 + r0] = d20 + sa0 * c1 + v0 * c2; B4[t * 64 + r0 + 32] = d21 + sa1 * c1 + v1 * c2; }
            }
        }
        __syncthreads();
        {
            const int t = row, ch0 = l * 512 + h * 64 + sub * 8;
            float o[8]; float s = 0.f;
#pragma unroll
            for (int e = 0; e < 8; ++e) { o[e] = B4[t * 64 + sub * 8 + e]; s += o[e]; }
            const float mean = red8(s) * (1.f / 64.f); float s2 = 0.f;
#pragma unroll
            for (int e = 0; e < 8; ++e) { o[e] -= mean; s2 += o[e] * o[e]; }
            const float rstd = rsqrtf(red8(s2) * (1.f / 64.f) + 64e-5f);
            const float bn = SCL[128 + t];
#pragma unroll
            for (int e = 0; e < 8; ++e) o[e] = (o[e] * rstd * p.in[24][ch0 + e] + p.in[25][ch0 + e] + bn * B2[t * 64 + sub * 8 + e]) * B5[t * 64 + sub * 8 + e];
            *(u32x4*)(YIN + (size_t)(t0 + t) * 1024 + 512 + h * 64 + sub * 8) = pack8(o);
        }
        __syncthreads();
    }
    {
        float* so = p.out + (prompt ? O_PRW + ((size_t)(l * 16 + b) * 8 + h) * 4096 : O_SRW + ((size_t)(l * 8 + b) * 8 + h) * 4096) + l16 * 4;
#pragma unroll
        for (int q = 0; q < 2; ++q) { *(f32x2*)(so + r0 * 64 + 2 * q) = S0[q]; *(f32x2*)(so + (r0 + 32) * 64 + 2 * q) = S1[q]; }
        if (h == 0) {
            const int tlast = prompt ? (seq + 1) * 2048 - 1 : NTP + (b + 1) * 64 - 1;
            float* sh = p.out + (prompt ? O_PSHIFT + (size_t)(l * 16 + b) * RWP : O_SSHIFT + (size_t)(l * 8 + b) * RWP);
            for (int i = tid; i < RWP; i += 512) sh[i] = bf2f(PROJ[(size_t)tlast * PJ + C_RW + i]);
        }
    }
    __syncthreads();
}

__device__ __forceinline__ void rwkv_chunk_unit(const Ctx& cx, const Params& p, int l, int seq, int h) {
    const int tid = cx.tid, lane = tid & 63, wave = tid >> 6, fr = lane & 15, fq = lane >> 4;
    constexpr int MS = 72;
    bf16_t* R0 = (bf16_t*)(smem);
    bf16_t* R2 = (bf16_t*)(smem + 9216);
    bf16_t* R3 = (bf16_t*)(smem + 18432);
    bf16_t* R1 = (bf16_t*)(smem + 27648);
    bf16_t* R4 = (bf16_t*)(smem + 36864);
    bf16_t* R5 = (bf16_t*)(smem + 46080);
    bf16_t* R6 = (bf16_t*)(smem + 55296);
    bf16_t* R7 = (bf16_t*)(smem + 64512);
    bf16_t* R8 = (bf16_t*)(smem + 73728);
    bf16_t* R9 = (bf16_t*)(smem + 82944);
    bf16_t* R10 = (bf16_t*)(smem + 92160);
    bf16_t* PT = (bf16_t*)(smem + 101376);
    float* GA = (float*)(smem + 110592);
    float* OW = (float*)(smem + 128000);
    float* GC = (float*)(smem + 145408);
    float* PRM = (float*)(smem + 145664);
    float* TF = (float*)(smem);
    const bf16_t* PROJ = (const bf16_t*)(p.ws + WS_R1);
    bf16_t* YIN = (bf16_t*)(p.ws + WS_H);
    const bool prompt = seq < 16;
    const int b = prompt ? seq : seq - 16;
    const int nch = prompt ? 32 : 1;
    const float* mu = p.in[15] + l * RWP;
    const float* shift_state = p.in[7] + (size_t)(l * 8 + b) * RWP;
    const int row = tid >> 3, sub = tid & 7;
    const int tm = wave & 3, ih = (wave >> 2) * 2;
    f32x4 Pacc[2];
#pragma unroll
    for (int q = 0; q < 2; ++q) Pacc[q] = (f32x4){0.f, 0.f, 0.f, 0.f};
    if (!prompt) {
        const float* s0 = p.in[6] + ((size_t)(l * 8 + b) * 8 + h) * 4096;
#pragma unroll
        for (int q = 0; q < 2; ++q)
#pragma unroll
            for (int jj = 0; jj < 4; ++jj) Pacc[q][jj] = s0[((ih + q) * 16 + fr) * 64 + tm * 16 + fq * 4 + jj];
    }
#pragma unroll
    for (int q = 0; q < 2; ++q) { u32x2 w; w.x = cvt_pk_bf16(Pacc[q][0], Pacc[q][1]); w.y = cvt_pk_bf16(Pacc[q][2], Pacc[q][3]); *(u32x2*)(PT + ((ih + q) * 16 + fr) * MS + tm * 16 + fq * 4) = w; }
    {
        const int pk = tid >> 6, pc = tid & 63;
        const float* s21 = p.in[21]; const float* s22 = p.in[22]; const float* s23 = p.in[23]; const float* s24 = p.in[24]; const float* s25 = p.in[25];
        const float* src = pk < 3 ? mu + pk * 512 + h * 64 : (pk == 3 ? s21 : (pk == 4 ? s22 : (pk == 5 ? s23 : (pk == 6 ? s24 : s25)))) + l * 512 + h * 64;
        PRM[pk * 64 + pc] = src[pc];
    }
    __syncthreads();
    u32x4 nx[9];
    {
        const int t_ = cx.tid >> 3, c_ = (cx.tid & 7) * 8;
        const int t0_ = prompt ? (seq * 32) * 64 : NTP + b * 64;
        const bf16_t* pr = PROJ + (size_t)(t0_ + t_) * PJ + h * 64 + c_;
        const bf16_t* pp = t_ > 0 ? pr - PJ : pr;
#pragma unroll
        for (int q = 0; q < 3; ++q) { nx[q] = *(const u32x4*)(pr + C_RW + q * 512); nx[3 + q] = *(const u32x4*)(pp + C_RW + q * 512); nx[6 + q] = *(const u32x4*)(pr + q * 512); }
    }
#pragma unroll 1
    for (int ci = 0; ci < nch; ++ci) {
        const int t0 = prompt ? (seq * 32 + ci) * 64 : NTP + b * 64;
        const bool first = (ci == 0);
        int tq = cx.tid; asm volatile("" : "+v"(tq));
        const int tid = tq, lane = tid & 63, wave = tid >> 6, fr = lane & 15, fq = lane >> 4, row = tid >> 3, sub = tid & 7, tm = wave & 3, ih = (wave >> 2) * 2;
        const int t = row, c0 = sub * 8, ch0 = l * 512 + h * 64 + c0;
        float v[8], g[8], bn;
        {
            float r[8], k[8], dd[8], a[8], kkn[8], be[8], k2[8];
            u32x4 raw[9];
#pragma unroll
            for (int q = 0; q < 9; ++q) raw[q] = nx[q];
            if (ci + 1 < nch) {
                const bf16_t* pr = PROJ + (size_t)(t0 + 64 + t) * PJ + h * 64 + c0;
#pragma unroll
                for (int q = 0; q < 3; ++q) { nx[q] = *(const u32x4*)(pr + C_RW + q * 512); nx[3 + q] = *(const u32x4*)(pr - PJ + C_RW + q * 512); nx[6 + q] = *(const u32x4*)(pr + q * 512); }
            }
            {
                float cur[8], prv[8];
#pragma unroll
                for (int kind = 0; kind < 3; ++kind) {
                    const int idx0 = kind * 512 + h * 64 + c0;
                    unpack8(raw[kind], cur);
                    if (t > 0 || !first) unpack8(raw[3 + kind], prv);
                    else if (!prompt) {
#pragma unroll
                        for (int e = 0; e < 8; ++e) prv[e] = shift_state[idx0 + e];
                    } else {
#pragma unroll
                        for (int e = 0; e < 8; ++e) prv[e] = 0.f;
                    }
                    float* dst = kind == 0 ? r : (kind == 1 ? k : v);
#pragma unroll
                    for (int e = 0; e < 8; ++e) dst[e] = cur[e] + (prv[e] - cur[e]) * PRM[kind * 64 + c0 + e];
                }
            }
            unpack8(raw[6], dd); unpack8(raw[7], a); unpack8(raw[8], g);
            float ss = 0.f; bn = 0.f;
#pragma unroll
            for (int e = 0; e < 8; ++e) { kkn[e] = k[e] * PRM[192 + c0 + e]; ss += kkn[e] * kkn[e]; }
            ss = red8(ss);
            const float rn = rsqrtf(ss + 1e-6f);
#pragma unroll
            for (int e = 0; e < 8; ++e) {
                kkn[e] *= rn; be[e] = kkn[e] * a[e];
                k2[e] = k[e] * (1.f + (a[e] - 1.f) * PRM[256 + c0 + e]);
                bn += r[e] * k2[e] * PRM[320 + c0 + e];
                GA[t * 64 + c0 + e] = dd[e];
            }
            bn = red8(bn);
            __syncthreads();
            {
                const int j = tid & 63, sg = tid >> 6;
                float sacc = 0.f;
#pragma unroll
                for (int q = 0; q < 8; ++q) { sacc += GA[(sg * 8 + q) * 64 + j]; GA[(sg * 8 + q) * 64 + j] = sacc; }
                OW[sg * 64 + j] = sacc;
                __syncthreads();
                float pre = 0.f;
                for (int q = 0; q < sg; ++q) pre += OW[q * 64 + j];
#pragma unroll
                for (int q = 0; q < 8; ++q) GA[(sg * 8 + q) * 64 + j] += pre;
            }
            __syncthreads();
            {
                float at[8], bt[8], kt[8], rt[8];
#pragma unroll
                for (int e = 0; e < 8; ++e) {
                    const int j = c0 + e;
                    const float Gt = GA[t * 64 + j], Gp = t > 0 ? GA[(t - 1) * 64 + j] : 0.f, Gc = GA[63 * 64 + j];
                    const float em = __expf(-Gp), ep = __expf(Gt), en = __expf(-Gt), ec = __expf(Gt - Gc);
                    at[e] = -kkn[e] * em; bt[e] = be[e] * ep; kt[e] = k2[e] * ep; rt[e] = r[e] * en;
                    const int so = swz_el(j, t);
                    R1[so] = f2bf(at[e]); R5[so] = f2bf(be[e] * ec); R6[so] = f2bf(k2[e] * ec); R7[so] = f2bf(v[e]);
                    if (t == 63) GC[j] = __expf(-Gc);
                }
                *(u32x4*)(R0 + t * MS + c0) = pack8(at); *(u32x4*)(R2 + t * MS + c0) = pack8(bt); *(u32x4*)(R3 + t * MS + c0) = pack8(kt); *(u32x4*)(R4 + t * MS + c0) = pack8(rt);
            }
        }
        __syncthreads();
#pragma unroll
        for (int q = 0; q < 2; ++q) {
            const int tile = wave * 2 + q, sm = tile >> 2, tn = tile & 3;
            f32x4 lb = {0.f, 0.f, 0.f, 0.f}, lk = lb, mb = lb, mk = lb;
#pragma unroll
            for (int kk = 0; kk < 2; ++kk) {
                const bf16x8 yb = *(const bf16x8*)(R2 + (sm * 16 + fr) * MS + kk * 32 + fq * 8), yk = *(const bf16x8*)(R3 + (sm * 16 + fr) * MS + kk * 32 + fq * 8);
                const bf16x8 xa = *(const bf16x8*)(R0 + (tn * 16 + fr) * MS + kk * 32 + fq * 8), xr = *(const bf16x8*)(R4 + (tn * 16 + fr) * MS + kk * 32 + fq * 8);
                lb = __builtin_amdgcn_mfma_f32_16x16x32_bf16(yb, xa, lb, 0, 0, 0); lk = __builtin_amdgcn_mfma_f32_16x16x32_bf16(yk, xa, lk, 0, 0, 0);
                mb = __builtin_amdgcn_mfma_f32_16x16x32_bf16(yb, xr, mb, 0, 0, 0); mk = __builtin_amdgcn_mfma_f32_16x16x32_bf16(yk, xr, mk, 0, 0, 0);
            }
            const int tt = tn * 16 + fr, s0i = sm * 16 + fq * 4;
            float olk[4], omb[4], omk[4];
#pragma unroll
            for (int jj = 0; jj < 4; ++jj) {
                const int si = s0i + jj;
                olk[jj] = (si < tt) ? lk[jj] : 0.f; omb[jj] = (si <= tt) ? mb[jj] : 0.f; omk[jj] = (si <= tt) ? mk[jj] : 0.f;
            }
            u32x2 w;
            w.x = cvt_pk_bf16(olk[0], olk[1]); w.y = cvt_pk_bf16(olk[2], olk[3]); *(u32x2*)(R8 + tt * MS + s0i) = w;
            w.x = cvt_pk_bf16(omb[0], omb[1]); w.y = cvt_pk_bf16(omb[2], omb[3]); *(u32x2*)(R9 + tt * MS + s0i) = w;
            w.x = cvt_pk_bf16(omk[0], omk[1]); w.y = cvt_pk_bf16(omk[2], omk[3]); *(u32x2*)(R10 + tt * MS + s0i) = w;
#pragma unroll
            for (int jj = 0; jj < 4; ++jj) { const int si = s0i + jj; GA[tt * 68 + si] = (si < tt) ? -lb[jj] : 0.f; }
        }
        __syncthreads();
        {
            bf16_t* TM = R3;
            tri_inv64(GA, TF, OW, tid);
            __syncthreads();
#pragma unroll
            for (int q = 0; q < 8; ++q) { const int e = tid + q * 512, i = e >> 6, cc = e & 63; TM[i * MS + cc] = ((cc >> 4) <= (i >> 4)) ? f2bf(TF[i * 68 + cc]) : (bf16_t)0; }
        }
        __syncthreads();
#pragma unroll
        for (int q = 0; q < 2; ++q) {
            f32x4 x1 = {0.f, 0.f, 0.f, 0.f}, w1 = x1;
#pragma unroll
            for (int kk = 0; kk < 2; ++kk) {
                x1 = __builtin_amdgcn_mfma_f32_16x16x32_bf16(*(const bf16x8*)(R8 + (tm * 16 + fr) * MS + kk * 32 + fq * 8), *(const bf16x8*)(R7 + swz_ch((ih + q) * 16 + fr, kk * 4 + fq)), x1, 0, 0, 0);
                w1 = __builtin_amdgcn_mfma_f32_16x16x32_bf16(*(const bf16x8*)(R1 + swz_ch(tm * 16 + fr, kk * 4 + fq)), *(const bf16x8*)(R3 + ((ih + q) * 16 + fr) * MS + kk * 32 + fq * 8), w1, 0, 0, 0);
            }
            u32x2 w;
            w.x = cvt_pk_bf16(x1[0], x1[1]); w.y = cvt_pk_bf16(x1[2], x1[3]); *(u32x2*)(R0 + ((ih + q) * 16 + fr) * MS + tm * 16 + fq * 4) = w;
            w.x = cvt_pk_bf16(w1[0], w1[1]); w.y = cvt_pk_bf16(w1[2], w1[3]); *(u32x2*)(R2 + ((ih + q) * 16 + fr) * MS + tm * 16 + fq * 4) = w;
        }
        __syncthreads();
        f32x4 Uacc[2];
#pragma unroll
        for (int q = 0; q < 2; ++q) {
            Uacc[q] = (f32x4){0.f, 0.f, 0.f, 0.f};
#pragma unroll
            for (int kk = 0; kk < 2; ++kk) {
                Uacc[q] = __builtin_amdgcn_mfma_f32_16x16x32_bf16(*(const bf16x8*)(R3 + (tm * 16 + fr) * MS + kk * 32 + fq * 8), *(const bf16x8*)(R0 + ((ih + q) * 16 + fr) * MS + kk * 32 + fq * 8), Uacc[q], 0, 0, 0);
                Uacc[q] = __builtin_amdgcn_mfma_f32_16x16x32_bf16(*(const bf16x8*)(R2 + (tm * 16 + fr) * MS + kk * 32 + fq * 8), *(const bf16x8*)(PT + ((ih + q) * 16 + fr) * MS + kk * 32 + fq * 8), Uacc[q], 0, 0, 0);
            }
        }
        __syncthreads();
#pragma unroll
        for (int q = 0; q < 2; ++q) { u32x2 w; w.x = cvt_pk_bf16(Uacc[q][0], Uacc[q][1]); w.y = cvt_pk_bf16(Uacc[q][2], Uacc[q][3]); *(u32x2*)(R3 + ((ih + q) * 16 + fr) * MS + tm * 16 + fq * 4) = w; }
        __syncthreads();
#pragma unroll
        for (int q = 0; q < 2; ++q) {
            f32x4 o = {0.f, 0.f, 0.f, 0.f};
            const f32x4 gc = *(const f32x4*)(GC + tm * 16 + fq * 4);
            Pacc[q] = Pacc[q] * gc;
#pragma unroll
            for (int kk = 0; kk < 2; ++kk) {
                const bf16x8 vt = *(const bf16x8*)(R7 + swz_ch((ih + q) * 16 + fr, kk * 4 + fq)), ut = *(const bf16x8*)(R3 + ((ih + q) * 16 + fr) * MS + kk * 32 + fq * 8);
                const bf16x8 pt = *(const bf16x8*)(PT + ((ih + q) * 16 + fr) * MS + kk * 32 + fq * 8);
                o = __builtin_amdgcn_mfma_f32_16x16x32_bf16(*(const bf16x8*)(R10 + (tm * 16 + fr) * MS + kk * 32 + fq * 8), vt, o, 0, 0, 0);
                o = __builtin_amdgcn_mfma_f32_16x16x32_bf16(*(const bf16x8*)(R4 + (tm * 16 + fr) * MS + kk * 32 + fq * 8), pt, o, 0, 0, 0);
                o = __builtin_amdgcn_mfma_f32_16x16x32_bf16(*(const bf16x8*)(R9 + (tm * 16 + fr) * MS + kk * 32 + fq * 8), ut, o, 0, 0, 0);
                Pacc[q] = __builtin_amdgcn_mfma_f32_16x16x32_bf16(*(const bf16x8*)(R5 + swz_ch(tm * 16 + fr, kk * 4 + fq)), ut, Pacc[q], 0, 0, 0);
                Pacc[q] = __builtin_amdgcn_mfma_f32_16x16x32_bf16(*(const bf16x8*)(R6 + swz_ch(tm * 16 + fr, kk * 4 + fq)), vt, Pacc[q], 0, 0, 0);
            }
#pragma unroll
            for (int jj = 0; jj < 4; ++jj) OW[(tm * 16 + fq * 4 + jj) * 68 + (ih + q) * 16 + fr] = o[jj];
        }
        __syncthreads();
#pragma unroll
        for (int q = 0; q < 2; ++q) { u32x2 w; w.x = cvt_pk_bf16(Pacc[q][0], Pacc[q][1]); w.y = cvt_pk_bf16(Pacc[q][2], Pacc[q][3]); *(u32x2*)(PT + ((ih + q) * 16 + fr) * MS + tm * 16 + fq * 4) = w; }
        {
            float o[8]; float sm = 0.f;
#pragma unroll
            for (int e = 0; e < 8; ++e) { o[e] = OW[t * 68 + c0 + e]; sm += o[e]; }
            const float mean = red8(sm) * (1.f / 64.f); float s2 = 0.f;
#pragma unroll
            for (int e = 0; e < 8; ++e) { o[e] -= mean; s2 += o[e] * o[e]; }
            const float rstd = rsqrtf(red8(s2) * (1.f / 64.f) + 64e-5f);
#pragma unroll
            for (int e = 0; e < 8; ++e) o[e] = (o[e] * rstd * PRM[384 + c0 + e] + PRM[448 + c0 + e] + bn * v[e]) * g[e];
            *(u32x4*)(YIN + (size_t)(t0 + t) * 1024 + 512 + h * 64 + c0) = pack8(o);
        }
        __syncthreads();
    }
    {
        float* so = p.out + (prompt ? O_PRW + ((size_t)(l * 16 + b) * 8 + h) * 4096 : O_SRW + ((size_t)(l * 8 + b) * 8 + h) * 4096);
#pragma unroll
        for (int q = 0; q < 2; ++q)
#pragma unroll
            for (int jj = 0; jj < 4; ++jj) so[((ih + q) * 16 + fr) * 64 + tm * 16 + fq * 4 + jj] = Pacc[q][jj];
        if (h == 0) {
            const int tlast = prompt ? (seq + 1) * 2048 - 1 : NTP + (b + 1) * 64 - 1;
            float* sh = p.out + (prompt ? O_PSHIFT + (size_t)(l * 16 + b) * RWP : O_SSHIFT + (size_t)(l * 8 + b) * RWP);
            for (int i = tid; i < RWP; i += 512) sh[i] = bf2f(PROJ[(size_t)tlast * PJ + C_RW + i]);
        }
    }
    __syncthreads();
}

__device__ __forceinline__ void phase_scan(const Ctx& cx, const Params& p, int l) {
#ifndef REP_SCAN
#define REP_SCAN 1
#endif
    for (int rep = 0; rep < REP_SCAN; ++rep)
    for (int w = cx.bid; w < 288; w += cx.nb) {
        bool isr; int seq, h;
        if (w < 128) { isr = true; seq = w >> 3; h = w & 7; }
        else if (w < 192) { isr = false; seq = (w - 128) >> 2; h = (w - 128) & 3; }
        else if (w < 224) { isr = false; seq = 16 + ((w - 192) >> 2); h = (w - 192) & 3; }
        else { isr = true; seq = 16 + ((w - 224) >> 3); h = (w - 224) & 7; }
#ifndef SCANM
#define SCANM 3
#endif
#ifndef REP_R
#define REP_R 1
#endif
#ifndef REP_GD
#define REP_GD 1
#endif
        if (isr) { if (SCANM & 1) for (int rr = 0; rr < REP_R; ++rr) rwkv_chunk_unit(cx, p, l, seq, h); }
        else { if (SCANM & 2) for (int rr = 0; rr < REP_GD; ++rr) gdn_scan_unit(cx, p, l, seq, h); }
    }
}

#define XB_TMO      128
#define XB_XCNT(j)  (256  + 64 * (j))
#define XB_XSUB(j)  (1280 + 64 * (j))
#define XB_XGEN(j)  (2304 + 64 * (j))
#define XB_TOP      3328
#define XB_TOPGEN   3392
#define XCD_BAR_WORDS 3456
#define XB_SPIN_CAP (1u << 18)
#define XLAS __attribute__((address_space(3)))
__device__ __forceinline__ unsigned xb_ld(unsigned* p)              { return __hip_atomic_load(p, __ATOMIC_RELAXED, __HIP_MEMORY_SCOPE_AGENT); }
__device__ __forceinline__ unsigned xb_add(unsigned* p, unsigned v) { return __hip_atomic_fetch_add(p, v, __ATOMIC_RELAXED, __HIP_MEMORY_SCOPE_AGENT); }
__device__ __forceinline__ unsigned xb_xcc_id() { return (unsigned)__builtin_amdgcn_s_getreg((3 << 11) | 20) & 0xFu; }
#define XB_SPIN(cond, bar) do { unsigned _sp = 0; while (cond) { __builtin_amdgcn_s_sleep(1); \
    if ((++_sp & 255u) == 0u) { if (xb_ld(&(bar)[XB_TMO])) break; if (_sp > XB_SPIN_CAP) { atomicAdd(&(bar)[XB_TMO], 1u); break; } } } } while (0)
struct XcdBarrier { unsigned* bar; unsigned x; volatile XLAS unsigned* st; };
__device__ __forceinline__ XcdBarrier xcd_barrier_post(unsigned* bar, volatile XLAS unsigned* st) {
    XcdBarrier b; b.bar = bar; b.x = xb_xcc_id(); b.st = st;
    if (threadIdx.x == 0) (void)xb_add(&bar[XB_XCNT(b.x)], 1u);
    return b;
}
__device__ __forceinline__ void xcd_barrier_complete(unsigned* bar, unsigned x, unsigned& nloc, unsigned& nx) {
    const unsigned G = gridDim.x * gridDim.y * gridDim.z;
    unsigned sum, cnt, mine, sp = 0u;
    for (;;) {
        sum = 0u; cnt = 0u; mine = 0u;
#pragma unroll
        for (unsigned j = 0; j < 16; ++j) { const unsigned c = xb_ld(&bar[XB_XCNT(j)]); sum += c; cnt += (c > 0u) ? 1u : 0u; mine = (j == x) ? c : mine; }
        if (sum == G) break;
        __builtin_amdgcn_s_sleep(1);
        if ((++sp & 255u) == 0u) { if (xb_ld(&bar[XB_TMO])) break; if (sp > XB_SPIN_CAP) { atomicAdd(&bar[XB_TMO], 1u); break; } }
    }
    nloc = mine > 0u ? mine : 1u; nx = cnt > 0u ? cnt : 1u;
}
__device__ __forceinline__ void xcd_barrier(const XcdBarrier& b) {
    asm volatile("s_waitcnt vmcnt(0)" ::: "memory");
    __syncthreads();
    if (threadIdx.x == 0) {
        unsigned* bar = b.bar;
        __builtin_amdgcn_s_waitcnt(0);
        unsigned nloc = b.st[0], nx = b.st[1];
        if (nloc == 0u) { xcd_barrier_complete(bar, b.x, nloc, nx); b.st[0] = nloc; b.st[1] = nx; }
        const unsigned old = xb_add(&bar[XB_XSUB(b.x)], 1u);
        const unsigned gen = old / nloc;
        if (old + 1u == (gen + 1u) * nloc) {
            __builtin_amdgcn_fence(__ATOMIC_RELEASE, "agent");
            asm volatile("s_waitcnt vmcnt(0)" ::: "memory");
            const unsigned og = xb_add(&bar[XB_TOP], 1u);
            const unsigned tg = og / nx;
            if (og + 1u == (tg + 1u) * nx) xb_add(&bar[XB_TOPGEN], 1u);
            else XB_SPIN(xb_ld(&bar[XB_TOPGEN]) == tg, bar);
            __builtin_amdgcn_fence(__ATOMIC_ACQUIRE, "agent");
            xb_add(&bar[XB_XGEN(b.x)], 1u);
            asm volatile("s_waitcnt vmcnt(0)" ::: "memory");
        } else {
            XB_SPIN(xb_ld(&bar[XB_XGEN(b.x)]) == gen, bar);
            __builtin_amdgcn_fence(__ATOMIC_ACQUIRE, "agent");
            asm volatile("s_waitcnt vmcnt(0)" ::: "memory");
        }
    }
    __syncthreads();
}

__device__ __forceinline__ void run_phase(const Ctx& cx, const Params& p, int ph) {
    unsigned char* ws = p.ws;
    const float* MOD = (const float*)(ws + WS_MOD);
#ifndef PHM
#define PHM 0xFFFF
#endif
    if (ph == 0) { if (PHM & 1) phase_mod(cx, p); __syncthreads(); if (PHM & 2) phase_weights(cx, p, 0); return; }
    if (ph == 1) { if (PHM & 4) phase_mod0(cx, p); return; }
    const int l = (ph - 2) / 9, s = (ph - 2) % 9;
    const float* modl = MOD + (size_t)l * 24 * 6144;
    gm::Epi E{};
    const bf16_t* gA = (const bf16_t*)(ws + WS_H); const bf16_t* gB = nullptr; int gN = 0, gK = 1024;
    switch (s) {
    case 0: E.kind = 1; E.O = (bf16_t*)(ws + WS_R1); E.ldo = PJ; gB = (const bf16_t*)(ws + WS_WIN); gN = PJ; break;
    case 1: if (PHM & 16) phase_gdn_prep(cx, p, l); break;
    case 2: if (PHM & 128) phase_rwkv_prep(cx, p, l); break;
    case 3: if (PHM & 32) phase_scan(cx, p, l); break;
    case 4: E.kind = 2; E.X = p.out; E.O = (bf16_t*)(ws + WS_PREP); E.gate = modl + 2048; gB = (const bf16_t*)(ws + WS_WOUT); gN = 1024;
        if (l == 0) { E.xp = p.in[0]; E.xs = p.in[1] - (size_t)NTP * 1024; E.xb = nullptr; } else { E.xp = p.out; E.xs = p.out; E.xb = (const bf16_t*)p.out; }
        break;
    case 5: if (PHM & 64) phase_ln(cx, p, p.in[27] + l * 1024, p.in[28] + l * 1024, modl, 3072, 4096, false); break;
    case 6: E.kind = 3; E.O = (bf16_t*)(ws + WS_R1); E.ldo = DFF; gB = (const bf16_t*)(ws + WS_W1); gN = DFF; break;
    case 7: E.kind = 2; E.X = p.out; E.O = (bf16_t*)(ws + WS_PREP); E.gate = modl + 5120; E.xp = p.out; E.xs = p.out; E.xb = (const bf16_t*)p.out;
        gA = (const bf16_t*)(ws + WS_R1); gB = (const bf16_t*)(ws + WS_W2); gN = 1024; gK = DFF; break;
    default:
        if (PHM & 64) phase_ln(cx, p, p.in[31] + l * 1024, p.in[32] + l * 1024, l < NLAYER - 1 ? modl + 24 * 6144 : nullptr, 0, 1024, l == NLAYER - 1);
        if ((PHM & 2) && l < NLAYER - 1) { __syncthreads(); phase_weights(cx, p, l + 1); }
        break;
    }
#ifndef REP_G
#define REP_G 1
#endif
#ifndef REP_G2
#define REP_G2 0
#endif
    if ((PHM & 8) && gB) {
        const int reps = (E.kind == 2) ? 1 + REP_G2 : REP_G;
        for (int r = 0; r < reps; ++r) { gm::Epi E2 = E; if (E.kind == 2 && r + 1 < reps) E2.kind = 0; gemm_phase(cx, gA, gB, NTOK, gN, gK, E2); }
    }
}

#ifndef DBG_STOP
#define DBG_STOP 0
#endif
#ifndef DBG_OFF
#define DBG_OFF WS_PREP
#endif
#ifndef DBG_MOD
#define DBG_MOD 76677120
#endif
#ifndef DBG_SZ
#define DBG_SZ 20480
#define DBG_POFF 16384
#endif
#ifndef DBG_STRIDE
#define DBG_STRIDE 5
#endif
__global__ void __launch_bounds__(512) mk_fwd(Params p) {
    cg::grid_group grid = cg::this_grid();
    if (p.ph_lo == 1000) {
        const bf16_t* src = (const bf16_t*)(p.ws + DBG_OFF);
        for (size_t i = (size_t)blockIdx.x * 512 + threadIdx.x; i < 44130304; i += (size_t)gridDim.x * 512) p.out[i] = bf2f(src[((i / DBG_SZ) % 2080) * 36864 + DBG_POFF + (i % DBG_SZ)]);
        return;
    }
    volatile XLAS unsigned* xst = (volatile XLAS unsigned*)((XLAS unsigned char*)smem + (LDS_BYTES - 16));
    if (threadIdx.x == 0) { xst[0] = 0u; xst[1] = 0u; xst[2] = 0u; xst[3] = 0u; }
    __syncthreads();
    const XcdBarrier xb = xcd_barrier_post((unsigned*)(p.ws + WS_BAR), xst);
    for (int ph = p.ph_lo; ph < p.ph_hi; ++ph) {
        if (ph > p.ph_lo) { if (ph == p.ph_lo + 1) grid.sync(); else xcd_barrier(xb); }
        Ctx cx; cx.tid = threadIdx.x; cx.bid = blockIdx.x; cx.nb = gridDim.x;
        asm volatile("" : "+v"(cx.tid)); asm volatile("" : "+s"(cx.bid)); asm volatile("" : "+s"(cx.nb));
        run_phase(cx, p, ph);
        __syncthreads();
    }
}

extern "C" void kernel_launch(void* const* d_in, const int* in_sizes, int n_in, void* d_out, int out_size, void* d_ws, size_t ws_size, hipStream_t stream) {
    static int grid = 0;
    if (grid == 0) {
        if (n_in != 33 || ws_size < WS_END) { fprintf(stderr, "kernel_launch: unexpected n_in %d / ws %zu (need %zu)\n", n_in, ws_size, (size_t)WS_END); grid = -1; return; }
        int dev = 0, cus = 0, per_cu = 0;
        hipGetDevice(&dev);
        hipDeviceGetAttribute(&cus, hipDeviceAttributeMultiprocessorCount, dev);
        if (hipFuncSetAttribute((const void*)mk_fwd, hipFuncAttributeMaxDynamicSharedMemorySize, LDS_BYTES) != hipSuccess) { fprintf(stderr, "kernel_launch: hipFuncSetAttribute failed\n"); grid = -1; return; }
        if (hipOccupancyMaxActiveBlocksPerMultiprocessor(&per_cu, (const void*)mk_fwd, 512, LDS_BYTES) != hipSuccess || per_cu < 1) { fprintf(stderr, "kernel_launch: occupancy query says %d\n", per_cu); per_cu = 1; }
        (void)hipGetLastError();
        grid = cus;
    }
    if (grid < 0) return;
    if (hipMemsetAsync((char*)d_ws + WS_BAR, 0, 16384, stream) != hipSuccess) { fprintf(stderr, "kernel_launch: memset of the barrier words failed\n"); return; }
    Params p{};
    for (int i = 0; i < 33; ++i) p.in[i] = (const float*)d_in[i];
    p.out = (float*)d_out; p.ws = (unsigned char*)d_ws;
#if MK_ONE_LAUNCH
    p.ph_lo = 0; p.ph_hi = NPHASE;
    void* args[] = {&p};
    hipError_t e = hipLaunchCooperativeKernel((const void*)mk_fwd, dim3(grid), dim3(512), args, LDS_BYTES, stream);
    if (e != hipSuccess) fprintf(stderr, "cooperative launch failed: %s (grid %d)\n", hipGetErrorString(e), grid);
#else
    for (int ph = 0; ph < (DBG_STOP ? DBG_STOP + 1 : NPHASE); ++ph) {
        p.ph_lo = ph; p.ph_hi = ph + 1;
        if (DBG_STOP && ph == DBG_STOP) { p.ph_lo = 1000; p.ph_hi = 1000; }
        void* args[] = {&p};
        hipError_t e = hipLaunchCooperativeKernel((const void*)mk_fwd, dim3(grid), dim3(512), args, LDS_BYTES, stream);
        if (e != hipSuccess) { fprintf(stderr, "launch %d failed: %s\n", ph, hipGetErrorString(e)); break; }
    }
#endif
}
```

```cpp
#include <hip/hip_runtime.h>
#include <hip/hip_cooperative_groups.h>
#include <cstdio>
#include <cstdint>
namespace cg = cooperative_groups;

#ifndef MK_ONE_LAUNCH
#define MK_ONE_LAUNCH 1
#define DBL_MASK 0x6
#endif

typedef unsigned short bf16_t;
typedef short bf16x8 __attribute__((ext_vector_type(8)));
typedef float f32x4 __attribute__((ext_vector_type(4)));
typedef float f32x2 __attribute__((ext_vector_type(2)));
typedef unsigned u32x4 __attribute__((ext_vector_type(4)));
typedef unsigned u32x2 __attribute__((ext_vector_type(2)));

constexpr int DM = 1024, NTOK = 33280, NTP = 32768, NSEQ = 24, NLAYER = 4;
constexpr int PJ = 4096;
constexpr int PTOT = 3848;
constexpr int C_Z = 1536, C_RW = 2048, C_GA = 3840, C_GB = 3844;
constexpr int DFF = 4096;
constexpr int RWP = 1792;
constexpr float DN_ALPHA = 1.681792830507429f;
constexpr int LDS_BYTES = 151552;
constexpr int NPHASE = 2 + 9 * NLAYER;

constexpr size_t WS_MOD = 0;
constexpr size_t WS_WIN = 2359296;
constexpr size_t WS_WOUT = WS_WIN + 8388608;
constexpr size_t WS_W1 = WS_WOUT + 2097152;
constexpr size_t WS_W2 = WS_W1 + 8388608;
constexpr size_t WS_LW2 = WS_W2 + 8388608;
constexpr size_t WS_LA2 = WS_LW2 + 65536;
constexpr size_t WS_LG2 = WS_LA2 + 65536;
constexpr size_t WS_DL = WS_LG2 + 131072;
constexpr size_t WS_H = WS_DL + 16384;
constexpr size_t WS_R1 = WS_H + 68157440;
constexpr size_t WS_PREP = WS_R1 + 272629760;
constexpr size_t WS_BAR = WS_PREP + 153354240;
constexpr size_t WS_END = WS_BAR + 16384;
constexpr int PREP_STRIDE = 36864;
constexpr int PO_U0T = 0, PO_WKN = 8192, PO_QD = 16384, PO_KDT = 24576, PO_QK = 32768;

constexpr size_t O_PGDN = 34078720, O_PCONV = 38273024, O_PRW = 38567936, O_PSHIFT = 40665088;
constexpr size_t O_SGDN = 40779776, O_SCONV = 42876928, O_SRW = 43024384, O_SSHIFT = 44072960;

struct Ctx { int tid, bid, nb; };
struct Params {
    const float* in[33];
    float* out;
    unsigned char* ws;
    int ph_lo, ph_hi;
};

extern __shared__ __attribute__((aligned(16))) unsigned char smem[];

typedef __bf16 bf16x2_t __attribute__((ext_vector_type(2)));
__device__ __forceinline__ unsigned cvt_pk_bf16(float lo, float hi) { f32x2 f = {lo, hi}; bf16x2_t v = __builtin_convertvector(f, bf16x2_t); return __builtin_bit_cast(unsigned, v); }
__device__ __forceinline__ bf16_t f2bf(float f) { return (bf16_t)(cvt_pk_bf16(f, 0.f) & 0xffffu); }
__device__ __forceinline__ float bf2f(bf16_t b) { return __uint_as_float(((unsigned)b) << 16); }
__device__ __forceinline__ float bflo(unsigned w) { return __uint_as_float(w << 16); }
__device__ __forceinline__ float bfhi(unsigned w) { return __uint_as_float(w & 0xffff0000u); }
__device__ __forceinline__ void unpack8(u32x4 w, float* f) {
    f[0] = bflo(w.x); f[1] = bfhi(w.x); f[2] = bflo(w.y); f[3] = bfhi(w.y);
    f[4] = bflo(w.z); f[5] = bfhi(w.z); f[6] = bflo(w.w); f[7] = bfhi(w.w);
}
__device__ __forceinline__ u32x4 pack8(const float* f) {
    u32x4 w; w.x = cvt_pk_bf16(f[0], f[1]); w.y = cvt_pk_bf16(f[2], f[3]); w.z = cvt_pk_bf16(f[4], f[5]); w.w = cvt_pk_bf16(f[6], f[7]); return w;
}
__device__ __forceinline__ float silu_f(float x) { return x / (1.f + __expf(-x)); }
__device__ __forceinline__ float sigmoid_f(float x) { return 1.f / (1.f + __expf(-x)); }
__device__ __forceinline__ float softplus_f(float x) { return fmaxf(x, 0.f) + __logf(1.f + __expf(-fabsf(x))); }
__device__ __forceinline__ float tanh_f(float x) { return 1.f - 2.f / (1.f + __expf(2.f * x)); }
__device__ __forceinline__ float dpp_x1(float x) { return __int_as_float(__builtin_amdgcn_mov_dpp(__float_as_int(x), 0xB1, 0xF, 0xF, true)); }
__device__ __forceinline__ float dpp_x2(float x) { return __int_as_float(__builtin_amdgcn_mov_dpp(__float_as_int(x), 0x4E, 0xF, 0xF, true)); }
__device__ __forceinline__ float dpp_hm(float x) { return __int_as_float(__builtin_amdgcn_mov_dpp(__float_as_int(x), 0x141, 0xF, 0xF, true)); }
__device__ __forceinline__ float dpp_rm(float x) { return __int_as_float(__builtin_amdgcn_mov_dpp(__float_as_int(x), 0x140, 0xF, 0xF, true)); }
__device__ __forceinline__ float red8(float x) { x += dpp_x1(x); x += dpp_x2(x); x += dpp_hm(x); return x; }
__device__ __forceinline__ float red16(float x) { x = red8(x); x += dpp_rm(x); return x; }
__device__ __forceinline__ float wave_sum(float v) {
#pragma unroll
    for (int o = 1; o < 64; o <<= 1) v += __shfl_xor(v, o);
    return v;
}
__device__ __forceinline__ int seq_of_row(int row) { return row < NTP ? (row >> 11) : 16 + ((row - NTP) >> 6); }
#define LDS_WAIT() asm volatile("s_waitcnt lgkmcnt(0)" ::: "memory")

__device__ __forceinline__ void phase_mod(const Ctx& cx, const Params& p) {
    float* sc = (float*)smem;
    const int tid = cx.tid;
    const float* c_p = p.in[2]; const float* c_s = p.in[3];
    const float* w_ada = p.in[8]; const float* b_ada = p.in[9];
    float* MOD = (float*)(p.ws + WS_MOD);
    for (int item = cx.bid; item < NLAYER * 96; item += cx.nb) {
        const int l = item / 96, cgp = item % 96;
        for (int idx = tid; idx < 24 * 1024; idx += 512) {
            const int s = idx >> 10, k = idx & 1023;
            const float c = s < 16 ? c_p[s * 1024 + k] : c_s[(s - 16) * 1024 + k];
            sc[k * 24 + s] = silu_f(c);
        }
        __syncthreads();
        const int kg = tid >> 6, col = tid & 63;
        float acc[24];
#pragma unroll
        for (int s = 0; s < 24; ++s) acc[s] = 0.f;
        const float* wp = w_ada + (size_t)l * 1024 * 6144 + (size_t)(kg * 128) * 6144 + cgp * 64 + col;
#pragma unroll 16
        for (int k = 0; k < 128; ++k) {
            const float w = wp[(size_t)k * 6144];
            const f32x4* sp = (const f32x4*)(sc + (kg * 128 + k) * 24);
#pragma unroll
            for (int q = 0; q < 6; ++q) { const f32x4 v = sp[q]; acc[4 * q] += v.x * w; acc[4 * q + 1] += v.y * w; acc[4 * q + 2] += v.z * w; acc[4 * q + 3] += v.w * w; }
        }
        __syncthreads();
#pragma unroll
        for (int s = 0; s < 24; ++s) sc[(kg * 24 + s) * 64 + col] = acc[s];
        __syncthreads();
        for (int o = tid; o < 24 * 64; o += 512) {
            const int s = o >> 6, c = o & 63;
            float sum = b_ada[l * 6144 + cgp * 64 + c];
#pragma unroll
            for (int g = 0; g < 8; ++g) sum += sc[(g * 24 + s) * 64 + c];
            MOD[(size_t)(l * 24 + s) * 6144 + cgp * 64 + c] = sum;
        }
        __syncthreads();
    }
}

__device__ __forceinline__ int win_map(int n) { return n < 2048 ? n : (n < 2056 ? n - 2048 + C_GA : n - 8); }
__device__ __forceinline__ void transpose_w(const Ctx& cx, const float* W, int K, int N, bf16_t* WT, int mode, int gw, int NGW, int rot) {
    const int lane = cx.tid & 63, wave = cx.tid >> 6;
    float* scr = (float*)(smem + wave * 8448);
    const int nblk = (N + 31) / 32, nitems = (K / 64) * nblk;
    int start = gw - rot; while (start < 0) start += NGW;
    for (int it = start; it < nitems; it += NGW) {
        const int kb = it / nblk, nb = it % nblk, k0 = 64 * kb, n0 = 32 * nb;
        const int nn = n0 + (lane & 31);
#pragma unroll
        for (int i = 0; i < 32; ++i) { const int kk = 2 * i + (lane >> 5); scr[kk * 33 + (lane & 31)] = nn < N ? W[(size_t)(k0 + kk) * N + nn] : 0.f; }
        LDS_WAIT();
        const int c = lane & 7;
#pragma unroll
        for (int j = 0; j < 4; ++j) {
            const int nl = (lane >> 3) + 8 * j, n = n0 + nl;
            const float* s = scr + (8 * c) * 33 + nl;
            u32x4 o; o.x = cvt_pk_bf16(s[0], s[33]); o.y = cvt_pk_bf16(s[66], s[99]); o.z = cvt_pk_bf16(s[132], s[165]); o.w = cvt_pk_bf16(s[198], s[231]);
            if (n < N) { const int row = mode ? win_map(n) : n; *(u32x4*)(WT + (size_t)row * K + k0 + 8 * c) = o; }
        }
        LDS_WAIT();
    }
}
__device__ __forceinline__ void phase_weights(const Ctx& cx, const Params& p, int l) {
    const int gw = cx.bid * 8 + (cx.tid >> 6), NGW = cx.nb * 8;
    unsigned char* ws = p.ws;
    transpose_w(cx, p.in[10] + (size_t)l * 1024 * PTOT, 1024, PTOT, (bf16_t*)(ws + WS_WIN), 1, gw, NGW, 0);
    transpose_w(cx, p.in[26] + (size_t)l * 1024 * 1024, 1024, 1024, (bf16_t*)(ws + WS_WOUT), 0, gw, NGW, 1936 % NGW);
    transpose_w(cx, p.in[29] + (size_t)l * 1024 * 4096, 1024, 4096, (bf16_t*)(ws + WS_W1), 0, gw, NGW, (1936 + 512) % NGW);
    transpose_w(cx, p.in[30] + (size_t)l * 4096 * 1024, 4096, 1024, (bf16_t*)(ws + WS_W2), 0, gw, NGW, (1936 + 512 + 2048) % NGW);
    transpose_w(cx, p.in[17] + (size_t)l * 64 * 512, 64, 512, (bf16_t*)(ws + WS_LW2), 0, gw, NGW, (1936 + 512 + 4096) % NGW);
    transpose_w(cx, p.in[19] + (size_t)l * 64 * 512, 64, 512, (bf16_t*)(ws + WS_LA2), 0, gw, NGW, (1936 + 512 + 4096 + 16) % NGW);
    transpose_w(cx, p.in[20] + (size_t)l * 128 * 512, 128, 512, (bf16_t*)(ws + WS_LG2), 0, gw, NGW, (1936 + 512 + 4096 + 32) % NGW);
    u32x4* z = (u32x4*)(ws + WS_WIN + (size_t)PTOT * 1024 * 2);
    const u32x4 zero = {0u, 0u, 0u, 0u};
    for (int i = cx.bid * 512 + cx.tid; i < (PJ - PTOT) * 128; i += cx.nb * 512) z[i] = zero;
}

__device__ __forceinline__ void phase_mod0(const Ctx& cx, const Params& p) {
    const int lane = cx.tid & 63;
    const int gw = cx.bid * 8 + (cx.tid >> 6), NGW = cx.nb * 8;
    const float* MOD = (const float*)(p.ws + WS_MOD);
    bf16_t* H = (bf16_t*)(p.ws + WS_H);
#pragma unroll 2
    for (int row = gw; row < NTOK; row += NGW) {
        const float* xr = row < NTP ? p.in[0] + (size_t)row * 1024 : p.in[1] + (size_t)(row - NTP) * 1024;
        const float* md = MOD + (size_t)seq_of_row(row) * 6144;
#pragma unroll
        for (int j = 0; j < 4; ++j) {
            const int col = lane * 4 + 256 * j;
            const f32x4 x = *(const f32x4*)(xr + col), sh = *(const f32x4*)(md + col), scv = *(const f32x4*)(md + 1024 + col);
            u32x2 o; o.x = cvt_pk_bf16(x.x * (1.f + scv.x) + sh.x, x.y * (1.f + scv.y) + sh.y); o.y = cvt_pk_bf16(x.z * (1.f + scv.z) + sh.z, x.w * (1.f + scv.w) + sh.w);
            *(u32x2*)(H + (size_t)row * 1024 + col) = o;
        }
    }
}

__device__ __forceinline__ void phase_ln(const Ctx& cx, const Params& p, const float* lw, const float* lb, const float* modl  , int sh_off, int sc_off, bool final_out) {
    const int lane = cx.tid & 63;
    const int gw = cx.bid * 8 + (cx.tid >> 6), NGW = cx.nb * 8;
    float* X = p.out;
    bf16_t* H = (bf16_t*)(p.ws + WS_H);
#ifndef REP_LN
#define REP_LN 0
#endif
    for (int rep = 0; rep <= REP_LN; ++rep)
    for (int row = gw; row < NTOK; row += NGW) {
        const bool dry = rep < REP_LN;
        float* xr = X + (size_t)row * 1024;
        const bf16_t* vr = (const bf16_t*)(p.ws + WS_PREP) + (size_t)row * 1024;
        f32x4 v[4]; float s = 0.f;
#pragma unroll
        for (int j = 0; j < 4; ++j) { const u32x2 w = *(const u32x2*)(vr + lane * 4 + 256 * j); v[j] = (f32x4){bflo(w.x), bfhi(w.x), bflo(w.y), bfhi(w.y)}; s += (v[j].x + v[j].y) + (v[j].z + v[j].w); }
        const float mean = wave_sum(s) * (1.f / 1024.f); float s2 = 0.f;
#pragma unroll
        for (int j = 0; j < 4; ++j) { v[j] = v[j] - mean; s2 += (v[j].x * v[j].x + v[j].y * v[j].y) + (v[j].z * v[j].z + v[j].w * v[j].w); }
        const float rstd = rsqrtf(wave_sum(s2) * (1.f / 1024.f) + 1e-5f);
        if (dry && rstd != -1.f) continue;
        const float* md = modl ? modl + (size_t)seq_of_row(row) * 6144 : nullptr;
#pragma unroll
        for (int j = 0; j < 4; ++j) {
            const int col = lane * 4 + 256 * j;
            const f32x4 w = *(const f32x4*)(lw + col), b = *(const f32x4*)(lb + col);
            const f32x4 x = v[j] * rstd * w + b;
            if (final_out) *(f32x4*)(xr + col) = x;
            else { u32x2 ox; ox.x = cvt_pk_bf16(x.x, x.y); ox.y = cvt_pk_bf16(x.z, x.w); *(u32x2*)((bf16_t*)X + (size_t)row * 1024 + col) = ox; }
            if (md) {
                const f32x4 sh = *(const f32x4*)(md + sh_off + col), scv = *(const f32x4*)(md + sc_off + col);
                u32x2 o; o.x = cvt_pk_bf16(x.x * (1.f + scv.x) + sh.x, x.y * (1.f + scv.y) + sh.y); o.y = cvt_pk_bf16(x.z * (1.f + scv.z) + sh.z, x.w * (1.f + scv.w) + sh.w);
                *(u32x2*)(H + (size_t)row * 1024 + col) = o;
            }
        }
    }
}

#define LAS __attribute__((address_space(3)))
namespace gm {
constexpr int BM = 256, BK = 64, HALF = 128, HTB = HALF * BK * 2, NXCD = 8, WGM = 8;
__device__ __forceinline__ int lds_byte(int r, int c) { const int st = (r >> 4) * 2 + (c >> 5), rr = r & 15, cc = c & 31, ob = rr * 64 + cc * 2; return st * 1024 + (ob ^ (((ob >> 9) & 1) << 5)); }
__device__ __forceinline__ void stage_rc(int b, int& R, int& C) { const int st = b / 1024, sb = b % 1024, swz = sb ^ (((sb >> 9) & 1) << 5); R = (st >> 1) * 16 + swz / 64; C = (st & 1) * 32 + (swz % 64) / 2; }
__device__ __forceinline__ int perm32(int rho) { const int n = rho >> 4, i = rho & 15; return 8 * (i >> 2) + 4 * n + (i & 3); }
struct Unit { int pm, pn; };
struct Order {
    int nM, nN, nwg, G, c;
    __device__ __forceinline__ bool next(int i, Unit& u) const {
        const long L = (long)i * G + c; if (L >= nwg) return false;
        int wgid = (int)L; { const int q = nwg / NXCD, r = nwg % NXCD, xcd = wgid % NXCD, off = wgid / NXCD; wgid = (xcd < r ? xcd * (q + 1) : r * (q + 1) + (xcd - r) * q) + off; }
        const int nig = WGM * nN, gid = wgid / nig, fm = gid * WGM, gsz = (nM - fm) < WGM ? (nM - fm) : WGM;
        u.pm = fm + ((wgid % nig) % gsz); u.pn = (wgid % nig) / gsz; return true;
    }
};
struct Epi {
    int kind;
    bf16_t* O; int ldo;
    const float* xp; const float* xs; float* X; const float* gate;
    const bf16_t* xb;
};
__device__ __forceinline__ void epilogue(const Epi& E, const f32x4 (&acc)[2][2][4][2], const Unit& u, int wr, int wc, int fr, int fq) {
    const int brow = u.pm * BM, bcol = u.pn * BM;
    if (E.kind == 0) return;
    if (E.kind == 2) {
#pragma unroll
        for (int ai = 0; ai < 2; ++ai)
#pragma unroll
            for (int m = 0; m < 4; ++m) {
                const int row = brow + ai * HALF + wr * 64 + m * 16 + fr;
                const float* xsrc = (row < NTP ? E.xp : E.xs) + (size_t)row * 1024;
                const bf16_t* xb = E.xb + (size_t)row * 1024;
                const float* gt = E.gate + (size_t)seq_of_row(row) * 6144;
                bf16_t* xo = E.O + (size_t)row * 1024;
#pragma unroll
                for (int bj = 0; bj < 2; ++bj) {
                    const int col = bcol + bj * HALF + wc * 32 + fq * 8;
                    f32x4 x0, x1;
                    if (E.xb) { const u32x4 w = *(const u32x4*)(xb + col); x0 = (f32x4){bflo(w.x), bfhi(w.x), bflo(w.y), bfhi(w.y)}; x1 = (f32x4){bflo(w.z), bfhi(w.z), bflo(w.w), bfhi(w.w)}; }
                    else { x0 = *(const f32x4*)(xsrc + col); x1 = *(const f32x4*)(xsrc + col + 4); }
                    const f32x4 g0 = *(const f32x4*)(gt + col), g1 = *(const f32x4*)(gt + col + 4);
                    const f32x4 v0 = x0 * DN_ALPHA + g0 * acc[ai][bj][m][0], v1 = x1 * DN_ALPHA + g1 * acc[ai][bj][m][1];
                    u32x4 o; o.x = cvt_pk_bf16(v0.x, v0.y); o.y = cvt_pk_bf16(v0.z, v0.w); o.z = cvt_pk_bf16(v1.x, v1.y); o.w = cvt_pk_bf16(v1.z, v1.w);
                    *(u32x4*)(xo + col) = o;
                }
            }
    } else {
        const bool sq = (E.kind == 3);
#pragma unroll
        for (int ai = 0; ai < 2; ++ai)
#pragma unroll
            for (int m = 0; m < 4; ++m) {
                const int row = brow + ai * HALF + wr * 64 + m * 16 + fr;
                bf16_t* orow = E.O + (size_t)row * E.ldo;
#pragma unroll
                for (int bj = 0; bj < 2; ++bj) {
                    const int col = bcol + bj * HALF + wc * 32 + fq * 8;
                    f32x4 v0 = acc[ai][bj][m][0], v1 = acc[ai][bj][m][1];
                    if (sq) {
                        v0.x = fmaxf(v0.x, 0.f); v0.y = fmaxf(v0.y, 0.f); v0.z = fmaxf(v0.z, 0.f); v0.w = fmaxf(v0.w, 0.f); v0 = v0 * v0;
                        v1.x = fmaxf(v1.x, 0.f); v1.y = fmaxf(v1.y, 0.f); v1.z = fmaxf(v1.z, 0.f); v1.w = fmaxf(v1.w, 0.f); v1 = v1 * v1;
                    }
                    u32x4 o; o.x = cvt_pk_bf16(v0.x, v0.y); o.y = cvt_pk_bf16(v0.z, v0.w); o.z = cvt_pk_bf16(v1.x, v1.y); o.w = cvt_pk_bf16(v1.z, v1.w);
                    *(u32x4*)(orow + col) = o;
                }
            }
    }
}
}

__device__ __forceinline__ void gemm_phase(const Ctx& cx, const bf16_t* gA, const bf16_t* gBt, int M, int N, int K, const gm::Epi& E) {
    using namespace gm;
    LAS unsigned char* lds = (LAS unsigned char*)smem;
    Order S; S.nM = M / BM; S.nN = N / BM; S.nwg = S.nM * S.nN; S.G = cx.nb; S.c = cx.bid;
    const int tid = cx.tid, wid = __builtin_amdgcn_readfirstlane(tid >> 6), lane = tid & 63, wr = wid >> 2, wc = wid & 3, fr = lane & 15, fq = lane >> 4;
    const int nt = K / BK;
    unsigned voffA[2], voffB[2];
#pragma unroll
    for (int i = 0; i < 2; ++i) { int R, C; stage_rc(tid * 16 + i * 8192, R, C); const int Rb = (R & ~31) + perm32(R & 31);
        voffA[i] = (unsigned)(R * K + C) * 2u; voffB[i] = (unsigned)(Rb * K + C) * 2u; }
    const size_t kstep = (size_t)(BK * 2);
    const size_t hstep = (size_t)HALF * K * 2;
    const size_t tstep = 2 * hstep;
    const unsigned ldsw = (unsigned)wid * 1024u;
    const int aoff = lds_byte(wr * 64 + fr, fq * 8), boff = lds_byte(wc * 32 + fr, fq * 8);
#define PG8_SA(b, h) (((b) * 2 + (h)) * HTB)
#define PG8_SB(b, h) ((4 + (b) * 2 + (h)) * HTB)
#define PG8_STAGE(bufoff, gbase, voff) do { _Pragma("unroll") for (int _i = 0; _i < 2; ++_i) \
        __builtin_amdgcn_global_load_lds((const unsigned*)((const char*)(gbase) + (voff)[_i]), (LAS unsigned*)(lds + (bufoff) + ldsw + _i * 8192), 16, 0, 0); } while (0)
#define PG8_LDA(dst, b, h) do { _Pragma("unroll") for (int m = 0; m < 4; ++m) _Pragma("unroll") for (int k = 0; k < 2; ++k) dst[m][k] = *(const LAS bf16x8*)(lds + PG8_SA(b, h) + aoff + m * 2048 + k * 1024); } while (0)
#define PG8_LDB(dst, b, h) do { _Pragma("unroll") for (int n = 0; n < 2; ++n) _Pragma("unroll") for (int k = 0; k < 2; ++k) dst[n][k] = *(const LAS bf16x8*)(lds + PG8_SB(b, h) + boff + n * 2048 + k * 1024); } while (0)
#define PG8_MMA(ai, bj, At, Bt) do { __builtin_amdgcn_s_setprio(1); _Pragma("unroll") for (int m = 0; m < 4; ++m) _Pragma("unroll") for (int n = 0; n < 2; ++n) _Pragma("unroll") for (int k = 0; k < 2; ++k) \
        acc[ai][bj][m][n] = __builtin_amdgcn_mfma_f32_16x16x32_bf16(Bt[n][k], At[m][k], acc[ai][bj][m][n], 0, 0, 0); __builtin_amdgcn_s_setprio(0); } while (0)
#define PG8_WAIT_V(n) asm volatile("s_waitcnt vmcnt(" #n ")" ::: "memory")
#define PG8_WAIT_L(n) asm volatile("s_waitcnt lgkmcnt(" #n ")" ::: "memory")
#define PG8_BAR __builtin_amdgcn_s_barrier()
#define PG8_SCHED __builtin_amdgcn_sched_barrier(0)
    Unit cur, nxt; int ui = 0;
    if (S.next(0, cur)) {
    f32x4 acc[2][2][4][2];
#pragma unroll
    for (int a = 0; a < 2; ++a)
#pragma unroll
        for (int b = 0; b < 2; ++b)
#pragma unroll
            for (int m = 0; m < 4; ++m)
#pragma unroll
                for (int n = 0; n < 2; ++n) acc[a][b][m][n] = (f32x4){0.f, 0.f, 0.f, 0.f};
    bf16x8 At[4][2], B0[2][2], B1[2][2];
    const char* cA = (const char*)gA + (size_t)cur.pm * tstep; const char* cB = (const char*)gBt + (size_t)cur.pn * tstep;
    PG8_STAGE(PG8_SB(0, 0), cB, voffB); PG8_STAGE(PG8_SB(0, 1), cB + hstep, voffB); PG8_STAGE(PG8_SA(0, 0), cA, voffA); PG8_STAGE(PG8_SA(0, 1), cA + hstep, voffA);
    if (wr == 1) PG8_BAR;
    PG8_WAIT_V(2); PG8_BAR;
    PG8_STAGE(PG8_SB(1, 0), cB + kstep, voffB); PG8_STAGE(PG8_SA(1, 0), cA + kstep, voffA); PG8_STAGE(PG8_SB(1, 1), cB + hstep + kstep, voffB);
    PG8_WAIT_V(6); PG8_BAR;
    for (;;) {
        const bool has_next = S.next(ui + 1, nxt);
        const char* nA = has_next ? (const char*)gA + (size_t)nxt.pm * tstep : cA; const char* nB = has_next ? (const char*)gBt + (size_t)nxt.pn * tstep : cB;
        for (int t = 0; t < nt; t += 2) {
            const bool last = (t == nt - 2);
            const char* a1 = cA + (size_t)(t + 1) * kstep;
            const char* a2 = last ? nA : cA + (size_t)(t + 2) * kstep; const char* b2 = last ? nB : cB + (size_t)(t + 2) * kstep;
            const char* a3 = a2 + kstep; const char* b3 = b2 + kstep;
            PG8_LDB(B0, 0, 0); PG8_LDB(B1, 0, 1); PG8_SCHED; PG8_LDA(At, 0, 0); PG8_STAGE(PG8_SA(1, 1), a1 + hstep, voffA);
            PG8_WAIT_V(8); PG8_WAIT_L(0); PG8_BAR; PG8_MMA(0, 0, At, B0); PG8_MMA(0, 1, At, B1); PG8_BAR; PG8_SCHED;
            PG8_LDA(At, 0, 1); PG8_STAGE(PG8_SB(0, 0), b2, voffB); PG8_STAGE(PG8_SB(0, 1), b2 + hstep, voffB); PG8_STAGE(PG8_SA(0, 0), a2, voffA);
            PG8_WAIT_V(8); PG8_WAIT_L(0); PG8_BAR; PG8_MMA(1, 0, At, B0); PG8_MMA(1, 1, At, B1); PG8_BAR; PG8_SCHED;
            PG8_LDB(B0, 1, 0); PG8_LDB(B1, 1, 1); PG8_SCHED; PG8_LDA(At, 1, 0); PG8_STAGE(PG8_SA(0, 1), a2 + hstep, voffA);
            PG8_WAIT_V(8); PG8_WAIT_L(0); PG8_BAR; PG8_MMA(0, 0, At, B0); PG8_MMA(0, 1, At, B1); PG8_BAR; PG8_SCHED;
            PG8_LDA(At, 1, 1); PG8_STAGE(PG8_SB(1, 0), b3, voffB); PG8_STAGE(PG8_SB(1, 1), b3 + hstep, voffB); PG8_STAGE(PG8_SA(1, 0), a3, voffA);
            PG8_WAIT_V(8); PG8_WAIT_L(0); PG8_BAR; PG8_MMA(1, 0, At, B0); PG8_MMA(1, 1, At, B1); PG8_BAR; PG8_SCHED;
        }
        if (wr == 0) PG8_BAR;
        epilogue(E, acc, cur, wr, wc, fr, fq);
        if (!has_next) break;
#pragma unroll
        for (int a = 0; a < 2; ++a)
#pragma unroll
            for (int b = 0; b < 2; ++b)
#pragma unroll
                for (int m = 0; m < 4; ++m)
#pragma unroll
                    for (int n = 0; n < 2; ++n) acc[a][b][m][n] = (f32x4){0.f, 0.f, 0.f, 0.f};
        cur = nxt; cA = nA; cB = nB; ++ui;
        if (wr == 1) PG8_BAR;
    }
    PG8_WAIT_V(0);
    PG8_BAR;
    }
#undef PG8_SA
#undef PG8_SB
#undef PG8_STAGE
#undef PG8_LDA
#undef PG8_LDB
#undef PG8_MMA
}

__device__ __forceinline__ void tri_inv64(const float* AM, float* TF, float* WSB, int tid) {
    const int lane = tid & 63, wave = tid >> 6;
    if (wave == 0) {
        const int bb = lane >> 4, cc = lane & 15;
        const float* Ab = AM + (16 * bb) * 68 + 16 * bb;
        float x[16];
#pragma unroll
        for (int i = 0; i < 16; ++i) {
            float a = (i == cc) ? 1.f : 0.f;
#pragma unroll
            for (int j = 0; j < i; ++j) a -= Ab[i * 68 + j] * x[j];
            x[i] = a;
            TF[(16 * bb + i) * 68 + 16 * bb + cc] = a;
        }
    }
    __syncthreads();
    {
        const int g = tid >> 8, i = (tid >> 4) & 15, c = tid & 15, o = 32 * g;
        const float* ar = AM + (o + 16 + i) * 68 + o;
        float acc = 0.f;
#pragma unroll
        for (int k = 0; k < 16; ++k) acc += ar[k] * TF[(o + k) * 68 + o + c];
        WSB[(o + 16 + i) * 68 + o + c] = acc;
        __syncthreads();
        const float* dr = TF + (o + 16 + i) * 68 + o + 16;
        acc = 0.f;
#pragma unroll
        for (int k = 0; k < 16; ++k) acc += dr[k] * WSB[(o + 16 + k) * 68 + o + c];
        TF[(o + 16 + i) * 68 + o + c] = -acc;
    }
    __syncthreads();
    {
        const int i = tid >> 4, c = tid & 15;
        const float* ar = AM + (32 + i) * 68;
        float a0 = 0.f, a1 = 0.f;
#pragma unroll
        for (int k = 0; k < 16; ++k) a0 += ar[k] * TF[k * 68 + c];
#pragma unroll
        for (int k = 16; k < 32; ++k) { const float av = ar[k]; a0 += av * TF[k * 68 + c]; a1 += av * TF[k * 68 + 16 + c]; }
        WSB[(32 + i) * 68 + c] = a0; WSB[(32 + i) * 68 + 16 + c] = a1;
        __syncthreads();
        const float* dr = TF + (32 + i) * 68 + 32;
        a0 = 0.f; a1 = 0.f;
#pragma unroll
        for (int k = 0; k < 16; ++k) { const float dv = dr[k]; a0 += dv * WSB[(32 + k) * 68 + c]; a1 += dv * WSB[(32 + k) * 68 + 16 + c]; }
        if (i >= 16) {
#pragma unroll
            for (int k = 16; k < 32; ++k) { const float dv = dr[k]; a0 += dv * WSB[(32 + k) * 68 + c]; a1 += dv * WSB[(32 + k) * 68 + 16 + c]; }
        }
        TF[(32 + i) * 68 + c] = -a0; TF[(32 + i) * 68 + 16 + c] = -a1;
    }
}
__device__ __forceinline__ int swz_el(int row, int t) { return row * 72 + ((((t >> 3) ^ (row >> 3)) & 7) << 3) + (t & 7); }
__device__ __forceinline__ int swz_ch(int row, int c8) { return row * 72 + (((c8 ^ (row >> 3)) & 7) << 3); }

__device__ __forceinline__ void phase_gdn_prep(const Ctx& cx, const Params& p, int l) {
    const int tid = cx.tid, lane = tid & 63, wave = tid >> 6, fr = lane & 15, fq = lane >> 4;
    bf16_t* QN = (bf16_t*)(smem);
    bf16_t* KN = (bf16_t*)(smem + 17408);
    bf16_t* KBG = (bf16_t*)(smem + 34816);
    bf16_t* VB = (bf16_t*)(smem + 53248);
    float* AM = (float*)(smem + 71680);
    bf16_t* TM = (bf16_t*)(smem + 89088);
    float* GV = (float*)(smem + 98304);
    float* TF = (float*)(smem + 99328);
    float* WSB = (float*)(smem + 116736);
    const bf16_t* PROJ = (const bf16_t*)(p.ws + WS_R1);
    bf16_t* PREP = (bf16_t*)(p.ws + WS_PREP);
    float* DL = (float*)(p.ws + WS_DL);
    const float* convw = p.in[11] + (size_t)l * 4 * 1536;
    const float* conv_state = p.in[5];
#ifndef REP_PREP
#define REP_PREP 1
#endif
    for (int rep = 0; rep < REP_PREP; ++rep)
    for (int u = cx.bid; u < 2080; u += cx.nb) {
        const int c = u >> 2, h = u & 3, t0 = c * 64;
        const bool prompt = c < 512;
        const bool first = prompt ? ((c & 31) == 0) : true;
        const int sb = prompt ? 0 : (c - 512);
        bf16_t* P = PREP + (size_t)u * PREP_STRIDE;
#pragma unroll 1
        for (int pb = 0; pb < 2; ++pb) {
        u32x4 rawc[3][4];
#pragma unroll
        for (int pi = 0; pi < 3; ++pi) {
            const int ps = pb * 3 + pi;
            const int t = (ps & 1) * 32 + wave * 4 + fq, ch0 = (ps >> 1) * 512 + h * 128 + fr * 8;
#pragma unroll
            for (int j = 0; j < 4; ++j) { const int tt = t - 3 + j; rawc[pi][j] = *(const u32x4*)(PROJ + (size_t)(t0 + ((tt >= 0 || !first) ? tt : 0)) * PJ + ch0); }
        }
        if (pb == 0) {
        if (tid < 64) {
                const float ga = bf2f(PROJ[(size_t)(t0 + tid) * PJ + C_GA + h]), gb = bf2f(PROJ[(size_t)(t0 + tid) * PJ + C_GB + h]);
                float g = -__expf(p.in[12][l * 4 + h]) * softplus_f(ga + p.in[13][l * 4 + h]);
                GV[64 + tid] = sigmoid_f(gb);
#pragma unroll
                for (int off = 1; off < 64; off <<= 1) { const float o = __shfl_up(g, off); g += (tid >= off) ? o : 0.f; }
                GV[tid] = g;
            }
            __syncthreads();
        }
#pragma unroll
        for (int pi = 0; pi < 3; ++pi) {
            const int ps = pb * 3 + pi;
            const int kind = ps >> 1, t = (ps & 1) * 32 + wave * 4 + fq, cgp = fr;
            const int ch0 = kind * 512 + h * 128 + cgp * 8;
            float y[8];
#pragma unroll
            for (int e = 0; e < 8; ++e) y[e] = 0.f;
#pragma unroll
            for (int j = 0; j < 4; ++j) {
                const int tt = t - 3 + j;
                float x[8];
                if (tt >= 0 || !first) {
                    unpack8(rawc[pi][j], x);
                } else if (!prompt) {
                    const float* cs = conv_state + ((size_t)(l * 8 + sb) * 3 + (tt + 3)) * 1536 + ch0;
                    const f32x4 a = *(const f32x4*)cs, b = *(const f32x4*)(cs + 4);
                    x[0] = a.x; x[1] = a.y; x[2] = a.z; x[3] = a.w; x[4] = b.x; x[5] = b.y; x[6] = b.z; x[7] = b.w;
                } else {
#pragma unroll
                    for (int e = 0; e < 8; ++e) x[e] = 0.f;
                }
                const f32x4 w0 = *(const f32x4*)(convw + j * 1536 + ch0), w1 = *(const f32x4*)(convw + j * 1536 + ch0 + 4);
                y[0] += x[0] * w0.x; y[1] += x[1] * w0.y; y[2] += x[2] * w0.z; y[3] += x[3] * w0.w;
                y[4] += x[4] * w1.x; y[5] += x[5] * w1.y; y[6] += x[6] * w1.z; y[7] += x[7] * w1.w;
            }
            float ss = 0.f;
#pragma unroll
            for (int e = 0; e < 8; ++e) { y[e] = silu_f(y[e]); ss += y[e] * y[e]; }
            const float gt = GV[t], bt = GV[64 + t];
            if (kind == 0) {
                ss = red16(ss);
                const float rn = rsqrtf(ss + 1e-6f) * 0.08838834764831845f;
                float q[8], qd[8]; const float eg = __expf(gt);
#pragma unroll
                for (int e = 0; e < 8; ++e) { q[e] = y[e] * rn; qd[e] = q[e] * eg; }
                *(u32x4*)(QN + t * 136 + cgp * 8) = pack8(q);
                *(u32x4*)(P + PO_QD + t * 128 + cgp * 8) = pack8(qd);
            } else if (kind == 1) {
                ss = red16(ss);
                const float rn = rsqrtf(ss + 1e-6f);
                float k[8]; const float sc2 = bt * __expf(gt);
#pragma unroll
                for (int e = 0; e < 8; ++e) { k[e] = y[e] * rn; KBG[swz_el(cgp * 8 + e, t)] = f2bf(k[e] * sc2); }
                *(u32x4*)(KN + t * 136 + cgp * 8) = pack8(k);
            } else {
#pragma unroll
                for (int e = 0; e < 8; ++e) VB[swz_el(cgp * 8 + e, t)] = f2bf(y[e] * bt);
            }
        }
        }
        __syncthreads();
        const float g_last = GV[63];
        if (h == 0 && (!prompt || (c & 31) == 31)) {
            float* co = p.out + (prompt ? O_PCONV + (size_t)(l * 16 + (c >> 5)) * 4608 : O_SCONV + (size_t)(l * 8 + sb) * 4608);
            for (int i = tid; i < 4608; i += 512) { const int r = i / 1536, ch = i % 1536; co[i] = bf2f(PROJ[(size_t)(t0 + 61 + r) * PJ + ch]); }
        }
        {
            const int d = tid >> 2, tq = tid & 3;
            float v[16];
#pragma unroll
            for (int i = 0; i < 16; ++i) { const int t = tq * 16 + i; v[i] = bf2f(KN[t * 136 + d]) * __expf(g_last - GV[t]); }
            *(u32x4*)(P + PO_KDT + d * 64 + tq * 16) = pack8(v);
            *(u32x4*)(P + PO_KDT + d * 64 + tq * 16 + 8) = pack8(v + 8);
        }
#pragma unroll
        for (int q = 0; q < 2; ++q) {
            const int tile = wave * 2 + q, tm = tile >> 2, tn = tile & 3;
            f32x4 akk = {0.f, 0.f, 0.f, 0.f}, aqk = {0.f, 0.f, 0.f, 0.f};
#pragma unroll
            for (int kk = 0; kk < 4; ++kk) {
                const bf16x8 ka = *(const bf16x8*)(KN + (tm * 16 + fr) * 136 + kk * 32 + fq * 8);
                const bf16x8 kb = *(const bf16x8*)(KN + (tn * 16 + fr) * 136 + kk * 32 + fq * 8);
                const bf16x8 qb = *(const bf16x8*)(QN + (tn * 16 + fr) * 136 + kk * 32 + fq * 8);
                akk = __builtin_amdgcn_mfma_f32_16x16x32_bf16(ka, kb, akk, 0, 0, 0);
                aqk = __builtin_amdgcn_mfma_f32_16x16x32_bf16(ka, qb, aqk, 0, 0, 0);
            }
            {
                const int i = tn * 16 + fr; const float gi = GV[i];
#pragma unroll
                for (int j = 0; j < 4; ++j) { const int t = tm * 16 + fq * 4 + j; AM[t * 68 + i] = (t > i) ? GV[64 + t] * akk[j] * __expf(GV[t] - gi) : 0.f; }
            }
            {
                const int t = tn * 16 + fr; const float gtt = GV[t]; float o[4];
#pragma unroll
                for (int j = 0; j < 4; ++j) { const int i = tm * 16 + fq * 4 + j; o[j] = (t >= i) ? aqk[j] * __expf(gtt - GV[i]) : 0.f; }
                u32x2 w; w.x = cvt_pk_bf16(o[0], o[1]); w.y = cvt_pk_bf16(o[2], o[3]);
                *(u32x2*)(P + PO_QK + t * 64 + tm * 16 + fq * 4) = w;
            }
        }
        __syncthreads();
        tri_inv64(AM, TF, WSB, tid);
        __syncthreads();
        for (int e = tid; e < 4096; e += 512) {
            const int i = e >> 6, cc = e & 63;
            TM[i * 72 + cc] = ((cc >> 4) <= (i >> 4)) ? f2bf(TF[i * 68 + cc]) : (bf16_t)0;
        }
        if (tid == 64) DL[u] = __expf(g_last);
        __syncthreads();
        {
            const int tm = wave & 3, vh = wave >> 2;
            bf16x8 ta[2];
#pragma unroll
            for (int kk = 0; kk < 2; ++kk) ta[kk] = *(const bf16x8*)(TM + (tm * 16 + fr) * 72 + kk * 32 + fq * 8);
#pragma unroll
            for (int n = 0; n < 4; ++n) {
                const int v = (vh * 4 + n) * 16 + fr;
                f32x4 a = {0.f, 0.f, 0.f, 0.f};
#pragma unroll
                for (int kk = 0; kk < 2; ++kk) a = __builtin_amdgcn_mfma_f32_16x16x32_bf16(ta[kk], *(const bf16x8*)(VB + swz_ch(v, kk * 4 + fq)), a, 0, 0, 0);
                u32x2 w; w.x = cvt_pk_bf16(a[0], a[1]); w.y = cvt_pk_bf16(a[2], a[3]);
                *(u32x2*)(P + PO_U0T + v * 64 + tm * 16 + fq * 4) = w;
            }
            bf16x8 ka[2];
#pragma unroll
            for (int kk = 0; kk < 2; ++kk) ka[kk] = *(const bf16x8*)(KBG + swz_ch(wave * 16 + fr, kk * 4 + fq));
#pragma unroll
            for (int tn = 0; tn < 4; ++tn) {
                f32x4 a = {0.f, 0.f, 0.f, 0.f};
#pragma unroll
                for (int kk = 0; kk < 2; ++kk) a = __builtin_amdgcn_mfma_f32_16x16x32_bf16(ka[kk], *(const bf16x8*)(TM + (tn * 16 + fr) * 72 + kk * 32 + fq * 8), a, 0, 0, 0);
                u32x2 w; w.x = cvt_pk_bf16(-a[0], -a[1]); w.y = cvt_pk_bf16(-a[2], -a[3]);
                *(u32x2*)(P + PO_WKN + (tn * 16 + fr) * 128 + wave * 16 + fq * 4) = w;
            }
        }
        __syncthreads();
    }
}

__device__ __forceinline__ void gdn_scan_unit(const Ctx& cx, const Params& p, int l, int seq, int h) {
    const int tid = cx.tid, lane = tid & 63, wave = tid >> 6, fr = lane & 15, fq = lane >> 4;
    bf16_t* ST = (bf16_t*)(smem);
    bf16_t* UT = (bf16_t*)(smem + 34816);
    float* OB = (float*)(smem + 53248);
    const bf16_t* PROJ = (const bf16_t*)(p.ws + WS_R1);
    const bf16_t* PREP = (const bf16_t*)(p.ws + WS_PREP);
    const float* DL = (const float*)(p.ws + WS_DL);
    bf16_t* YIN = (bf16_t*)(p.ws + WS_H);
    const bool prompt = seq < 16;
    const int b = prompt ? seq : seq - 16;
    const int nch = prompt ? 32 : 1;
    const float* nw = p.in[14] + l * 128;
    f32x4 S[8];
    if (prompt) {
#pragma unroll
        for (int n = 0; n < 8; ++n) S[n] = (f32x4){0.f, 0.f, 0.f, 0.f};
    } else {
        const float* s0 = p.in[4] + ((size_t)(l * 8 + b) * 4 + h) * 16384;
#pragma unroll
        for (int n = 0; n < 8; ++n)
#pragma unroll
            for (int j = 0; j < 4; ++j) S[n][j] = s0[(wave * 16 + fq * 4 + j) * 128 + n * 16 + fr];
    }
#pragma unroll
    for (int n = 0; n < 8; ++n) { u32x2 w; w.x = cvt_pk_bf16(S[n][0], S[n][1]); w.y = cvt_pk_bf16(S[n][2], S[n][3]); *(u32x2*)(ST + (n * 16 + fr) * 136 + wave * 16 + fq * 4) = w; }
    __syncthreads();
    const int tm = wave & 3, vh = wave >> 2;
#pragma unroll 1
    for (int ci = 0; ci < nch; ++ci) {
        const int c = prompt ? seq * 32 + ci : 512 + b;
        const int u = c * 4 + h, t0 = c * 64;
        const bf16_t* P = PREP + (size_t)u * PREP_STRIDE;
        bf16x8 wkn[4], qd[4], qk[2], kdt[2];
#pragma unroll
        for (int kk = 0; kk < 4; ++kk) { wkn[kk] = *(const bf16x8*)(P + PO_WKN + (tm * 16 + fr) * 128 + kk * 32 + fq * 8); qd[kk] = *(const bf16x8*)(P + PO_QD + (tm * 16 + fr) * 128 + kk * 32 + fq * 8); }
#pragma unroll
        for (int kk = 0; kk < 2; ++kk) { qk[kk] = *(const bf16x8*)(P + PO_QK + (tm * 16 + fr) * 64 + kk * 32 + fq * 8); kdt[kk] = *(const bf16x8*)(P + PO_KDT + (wave * 16 + fr) * 64 + kk * 32 + fq * 8); }
        f32x4 U[4], O[4];
#pragma unroll
        for (int n = 0; n < 4; ++n) {
            const u32x2 w = *(const u32x2*)(P + PO_U0T + ((vh * 4 + n) * 16 + fr) * 64 + tm * 16 + fq * 4);
            U[n] = (f32x4){bflo(w.x), bfhi(w.x), bflo(w.y), bfhi(w.y)};
            O[n] = (f32x4){0.f, 0.f, 0.f, 0.f};
        }
        const float dl = DL[u];
#pragma unroll
        for (int kk = 0; kk < 4; ++kk)
#pragma unroll
            for (int n = 0; n < 4; ++n) {
                const bf16x8 sf = *(const bf16x8*)(ST + ((vh * 4 + n) * 16 + fr) * 136 + kk * 32 + fq * 8);
                U[n] = __builtin_amdgcn_mfma_f32_16x16x32_bf16(wkn[kk], sf, U[n], 0, 0, 0);
                O[n] = __builtin_amdgcn_mfma_f32_16x16x32_bf16(qd[kk], sf, O[n], 0, 0, 0);
            }
#pragma unroll
        for (int n = 0; n < 4; ++n) { u32x2 w; w.x = cvt_pk_bf16(U[n][0], U[n][1]); w.y = cvt_pk_bf16(U[n][2], U[n][3]); *(u32x2*)(UT + ((vh * 4 + n) * 16 + fr) * 72 + tm * 16 + fq * 4) = w; }
        __syncthreads();
#pragma unroll
        for (int kk = 0; kk < 2; ++kk)
#pragma unroll
            for (int n = 0; n < 4; ++n) O[n] = __builtin_amdgcn_mfma_f32_16x16x32_bf16(qk[kk], *(const bf16x8*)(UT + ((vh * 4 + n) * 16 + fr) * 72 + kk * 32 + fq * 8), O[n], 0, 0, 0);
#pragma unroll
        for (int n = 0; n < 8; ++n) {
            S[n] = S[n] * dl;
#pragma unroll
            for (int kk = 0; kk < 2; ++kk) S[n] = __builtin_amdgcn_mfma_f32_16x16x32_bf16(kdt[kk], *(const bf16x8*)(UT + (n * 16 + fr) * 72 + kk * 32 + fq * 8), S[n], 0, 0, 0);
        }
        __syncthreads();
#pragma unroll
        for (int n = 0; n < 8; ++n) { u32x2 w; w.x = cvt_pk_bf16(S[n][0], S[n][1]); w.y = cvt_pk_bf16(S[n][2], S[n][3]); *(u32x2*)(ST + (n * 16 + fr) * 136 + wave * 16 + fq * 4) = w; }
#pragma unroll
        for (int n = 0; n < 4; ++n)
#pragma unroll
            for (int j = 0; j < 4; ++j) OB[(tm * 16 + fq * 4 + j) * 132 + (vh * 4 + n) * 16 + fr] = O[n][j];
        __syncthreads();
        {
            const int t = tid >> 3, part = tid & 7;
            float o[16]; float ss = 0.f;
#pragma unroll
            for (int q = 0; q < 4; ++q) { const f32x4 v = *(const f32x4*)(OB + t * 132 + part * 16 + q * 4); o[4 * q] = v.x; o[4 * q + 1] = v.y; o[4 * q + 2] = v.z; o[4 * q + 3] = v.w; ss += v.x * v.x + v.y * v.y + v.z * v.z + v.w * v.w; }
            ss = red8(ss);
            const float rstd = rsqrtf(ss * (1.f / 128.f) + 1e-6f);
            const bf16_t* zp = PROJ + (size_t)(t0 + t) * PJ + C_Z + h * 128 + part * 16;
            float z[16]; unpack8(*(const u32x4*)zp, z); unpack8(*(const u32x4*)(zp + 8), z + 8);
#pragma unroll
            for (int e = 0; e < 16; ++e) o[e] = o[e] * rstd * nw[part * 16 + e] * silu_f(z[e]);
            bf16_t* yp = YIN + (size_t)(t0 + t) * 1024 + h * 128 + part * 16;
            *(u32x4*)yp = pack8(o); *(u32x4*)(yp + 8) = pack8(o + 8);
        }
    }
    {
        float* so = p.out + (prompt ? O_PGDN + ((size_t)(l * 16 + b) * 4 + h) * 16384 : O_SGDN + ((size_t)(l * 8 + b) * 4 + h) * 16384);
#pragma unroll
        for (int n = 0; n < 8; ++n)
#pragma unroll
            for (int j = 0; j < 4; ++j) so[(wave * 16 + fq * 4 + j) * 128 + n * 16 + fr] = S[n][j];
    }
    __syncthreads();
}

__device__ __forceinline__ void phase_rwkv_prep(const Ctx& cx, const Params& p, int l) {
    const int tid = cx.tid, lane = tid & 63, wave = tid >> 6, fr = lane & 15, fq = lane >> 4;
    bf16_t* XW = (bf16_t*)(smem);
    bf16_t* XA = (bf16_t*)(smem + 9216);
    bf16_t* XG = (bf16_t*)(smem + 18432);
    bf16_t* PROJ = (bf16_t*)(p.ws + WS_R1);
    const bf16_t* LW2 = (const bf16_t*)(p.ws + WS_LW2); const bf16_t* LA2 = (const bf16_t*)(p.ws + WS_LA2); const bf16_t* LG2 = (const bf16_t*)(p.ws + WS_LG2);
    const float* mu = p.in[15] + l * RWP;
#ifndef REP_RP
#define REP_RP 1
#endif
    for (int rep = 0; rep < REP_RP; ++rep)
    for (int c = cx.bid; c < 520; c += cx.nb) {
        const int t0 = c * 64;
        const bool prompt = c < 512;
        const bool first = prompt ? ((c & 31) == 0) : true;
        const float* shift_state = p.in[7] + (size_t)(l * 8 + (prompt ? 0 : c - 512)) * RWP;
        {
            const int t = tid >> 3, part = tid & 7;
#pragma unroll
            for (int q = 0; q < 4; ++q) {
                const int cl = part * 32 + q * 8;
                const int idx0 = 1536 + cl;
                float cur[8], prv[8], o[8];
                unpack8(*(const u32x4*)(PROJ + (size_t)(t0 + t) * PJ + C_RW + idx0), cur);
                if (t > 0 || !first) unpack8(*(const u32x4*)(PROJ + (size_t)(t0 + t - 1) * PJ + C_RW + idx0), prv);
                else if (!prompt) {
#pragma unroll
                    for (int e = 0; e < 8; ++e) prv[e] = shift_state[idx0 + e];
                } else {
#pragma unroll
                    for (int e = 0; e < 8; ++e) prv[e] = 0.f;
                }
#pragma unroll
                for (int e = 0; e < 8; ++e) {
                    const float x = cur[e] + (prv[e] - cur[e]) * mu[idx0 + e];
                    o[e] = cl < 64 ? tanh_f(x) : (cl < 128 ? x : sigmoid_f(x));
                }
                bf16_t* dst = cl < 64 ? XW + t * 72 + cl : (cl < 128 ? XA + t * 72 + (cl - 64) : XG + t * 136 + (cl - 128));
                *(u32x4*)dst = pack8(o);
            }
        }
        __syncthreads();
#pragma unroll 1
        for (int cp = 0; cp < 2; ++cp) {
            const int cb = wave * 64 + cp * 32;
            bf16x8 bw[2][2], ba[2][2], bg[2][4];
#pragma unroll
            for (int n = 0; n < 2; ++n) {
                const int nrow = cb + 8 * (fr >> 2) + 4 * n + (fr & 3);
#pragma unroll
                for (int kk = 0; kk < 2; ++kk) { bw[n][kk] = *(const bf16x8*)(LW2 + nrow * 64 + kk * 32 + fq * 8); ba[n][kk] = *(const bf16x8*)(LA2 + nrow * 64 + kk * 32 + fq * 8); }
#pragma unroll
                for (int kk = 0; kk < 4; ++kk) bg[n][kk] = *(const bf16x8*)(LG2 + nrow * 128 + kk * 32 + fq * 8);
            }
            const int ch = cb + 8 * fq;
            f32x4 w0[2], a0[2];
#pragma unroll
            for (int n = 0; n < 2; ++n) { w0[n] = *(const f32x4*)(p.in[16] + l * 512 + ch + 4 * n); a0[n] = *(const f32x4*)(p.in[18] + l * 512 + ch + 4 * n); }
#pragma unroll 1
            for (int tm = 0; tm < 4; ++tm) {
                f32x4 dw[2], da[2], dg[2];
#pragma unroll
                for (int n = 0; n < 2; ++n) { dw[n] = (f32x4){0.f, 0.f, 0.f, 0.f}; da[n] = dw[n]; dg[n] = dw[n]; }
#pragma unroll
                for (int kk = 0; kk < 2; ++kk) {
                    const bf16x8 xw = *(const bf16x8*)(XW + (tm * 16 + fr) * 72 + kk * 32 + fq * 8), xa = *(const bf16x8*)(XA + (tm * 16 + fr) * 72 + kk * 32 + fq * 8);
#pragma unroll
                    for (int n = 0; n < 2; ++n) { dw[n] = __builtin_amdgcn_mfma_f32_16x16x32_bf16(bw[n][kk], xw, dw[n], 0, 0, 0); da[n] = __builtin_amdgcn_mfma_f32_16x16x32_bf16(ba[n][kk], xa, da[n], 0, 0, 0); }
                }
#pragma unroll
                for (int kk = 0; kk < 4; ++kk) {
                    const bf16x8 xg = *(const bf16x8*)(XG + (tm * 16 + fr) * 136 + kk * 32 + fq * 8);
#pragma unroll
                    for (int n = 0; n < 2; ++n) dg[n] = __builtin_amdgcn_mfma_f32_16x16x32_bf16(bg[n][kk], xg, dg[n], 0, 0, 0);
                }
                float dv[8], av[8];
#pragma unroll
                for (int n = 0; n < 2; ++n)
#pragma unroll
                    for (int j = 0; j < 4; ++j) {
                        dv[4 * n + j] = __expf(-softplus_f(-(w0[n][j] + dw[n][j])) - 0.5f);
                        av[4 * n + j] = sigmoid_f(a0[n][j] + da[n][j]);
                    }
                bf16_t* orow = PROJ + (size_t)(t0 + tm * 16 + fr) * PJ + ch;
                *(u32x4*)(orow) = pack8(dv);
                *(u32x4*)(orow + 512) = pack8(av);
                u32x4 og; og.x = cvt_pk_bf16(dg[0][0], dg[0][1]); og.y = cvt_pk_bf16(dg[0][2], dg[0][3]); og.z = cvt_pk_bf16(dg[1][0], dg[1][1]); og.w = cvt_pk_bf16(dg[1][2], dg[1][3]);
                *(u32x4*)(orow + 1024) = og;
            }
        }
        __syncthreads();
    }
}

__device__ __forceinline__ void rwkv_scan_unit(const Ctx& cx, const Params& p, int l, int seq, int h) {
    const int tid = cx.tid, lane = tid & 63, wave = tid >> 6, fr = lane & 15, fq = lane >> 4;
    float* B0 = (float*)(smem);
    float* B1 = (float*)(smem + 16384);
    float* B2 = (float*)(smem + 32768);
    float* B3 = (float*)(smem + 49152);
    float* B4 = (float*)(smem + 65536);
    float* B5 = (float*)(smem + 81920);
    float* B6 = (float*)(smem + 98304);
    float* B7 = (float*)(smem + 114688);
    float* SCL = (float*)(smem + 131072);
    const bf16_t* PROJ = (const bf16_t*)(p.ws + WS_R1);
    bf16_t* YIN = (bf16_t*)(p.ws + WS_H);
    const bool prompt = seq < 16;
    const int b = prompt ? seq : seq - 16;
    const int nch = prompt ? 32 : 1;
    const float* mu = p.in[15] + l * RWP;
    const float* shift_state = p.in[7] + (size_t)(l * 8 + b) * RWP;
    const int row = tid >> 3, sub = tid & 7;
    const int r0 = tid >> 4, l16 = tid & 15;
    f32x2 S0[2], S1[2];
    if (prompt) {
#pragma unroll
        for (int q = 0; q < 2; ++q) { S0[q] = (f32x2){0.f, 0.f}; S1[q] = (f32x2){0.f, 0.f}; }
    } else {
        const float* s0 = p.in[6] + ((size_t)(l * 8 + b) * 8 + h) * 4096 + l16 * 4;
#pragma unroll
        for (int q = 0; q < 2; ++q) { S0[q] = *(const f32x2*)(s0 + r0 * 64 + 2 * q); S1[q] = *(const f32x2*)(s0 + (r0 + 32) * 64 + 2 * q); }
    }
#pragma unroll 1
    for (int ci = 0; ci < nch; ++ci) {
        const int t0 = prompt ? (seq * 32 + ci) * 64 : NTP + b * 64;
        const bool first = (ci == 0);
        {
            const int t = row, c0 = h * 64 + sub * 8, ch0 = l * 512 + c0;
            const bf16_t* prow = PROJ + (size_t)(t0 + t) * PJ;
            float r[8], k[8], v[8], dd[8], a[8], g[8];
            {
                float cur[8], prv[8];
#pragma unroll
                for (int kind = 0; kind < 3; ++kind) {
                    const int idx0 = kind * 512 + c0;
                    unpack8(*(const u32x4*)(prow + C_RW + idx0), cur);
                    if (t > 0 || !first) unpack8(*(const u32x4*)(prow - PJ + C_RW + idx0), prv);
                    else if (!prompt) {
#pragma unroll
                        for (int e = 0; e < 8; ++e) prv[e] = shift_state[idx0 + e];
                    } else {
#pragma unroll
                        for (int e = 0; e < 8; ++e) prv[e] = 0.f;
                    }
                    float* dst = kind == 0 ? r : (kind == 1 ? k : v);
#pragma unroll
                    for (int e = 0; e < 8; ++e) dst[e] = cur[e] + (prv[e] - cur[e]) * mu[idx0 + e];
                }
            }
            unpack8(*(const u32x4*)(prow + c0), dd); unpack8(*(const u32x4*)(prow + 512 + c0), a); unpack8(*(const u32x4*)(prow + 1024 + c0), g);
            float ss = 0.f, c1 = 0.f, c2 = 0.f, bn = 0.f;
            float kkv[8];
#pragma unroll
            for (int e = 0; e < 8; ++e) { kkv[e] = k[e] * p.in[21][ch0 + e]; ss += kkv[e] * kkv[e]; }
            ss = red8(ss);
            const float rn = rsqrtf(ss + 1e-6f);
#pragma unroll
            for (int e = 0; e < 8; ++e) {
                const float w = __expf(-dd[e]);
                const float kkn = kkv[e] * rn, ka = kkn * a[e];
                const float k2 = k[e] * (1.f + (a[e] - 1.f) * p.in[22][ch0 + e]);
                B6[t * 64 + sub * 8 + e] = kkn; B7[t * 64 + sub * 8 + e] = ka; B1[t * 64 + sub * 8 + e] = k2; B0[t * 64 + sub * 8 + e] = w * r[e];
                B3[t * 64 + sub * 8 + e] = w; B2[t * 64 + sub * 8 + e] = v[e]; B5[t * 64 + sub * 8 + e] = g[e];
                c1 += ka * r[e]; c2 += k2 * r[e]; bn += r[e] * k2 * p.in[23][ch0 + e];
            }
            c1 = red8(c1); c2 = red8(c2); bn = red8(bn);
            if (sub == 0) { SCL[t] = c1; SCL[64 + t] = c2; SCL[128 + t] = bn; }
        }
        __syncthreads();
        {
            const f32x4* KKp = (const f32x4*)(B6 + l16 * 4); const f32x4* WRp = (const f32x4*)(B0 + l16 * 4); const f32x4* Wp = (const f32x4*)(B3 + l16 * 4);
            const f32x4* KAp = (const f32x4*)(B7 + l16 * 4); const f32x4* K2p = (const f32x4*)(B1 + l16 * 4);
#pragma unroll 2
            for (int t = 0; t < 64; ++t) {
                const f32x4 kk4 = KKp[t * 16], wr4 = WRp[t * 16], w4 = Wp[t * 16], ka4 = KAp[t * 16], k24 = K2p[t * 16];
                const f32x2 kk[2] = {{kk4.x, kk4.y}, {kk4.z, kk4.w}}, wrr[2] = {{wr4.x, wr4.y}, {wr4.z, wr4.w}}, ww[2] = {{w4.x, w4.y}, {w4.z, w4.w}};
                const f32x2 ka[2] = {{ka4.x, ka4.y}, {ka4.z, ka4.w}}, k2[2] = {{k24.x, k24.y}, {k24.z, k24.w}};
                const float v0 = B2[t * 64 + r0], v1 = B2[t * 64 + r0 + 32], c1 = SCL[t], c2 = SCL[64 + t];
                f32x2 a0 = S0[0] * kk[0], b0 = S0[0] * wrr[0], a1 = S1[0] * kk[0], b1 = S1[0] * wrr[0];
                a0 = __builtin_elementwise_fma(S0[1], kk[1], a0); b0 = __builtin_elementwise_fma(S0[1], wrr[1], b0);
                a1 = __builtin_elementwise_fma(S1[1], kk[1], a1); b1 = __builtin_elementwise_fma(S1[1], wrr[1], b1);
                float d10 = a0.x + a0.y, d20 = b0.x + b0.y, d11 = a1.x + a1.y, d21 = b1.x + b1.y;
                d10 += dpp_x1(d10); d11 += dpp_x1(d11); d20 += dpp_x1(d20); d21 += dpp_x1(d21);
                d10 += dpp_x2(d10); d11 += dpp_x2(d11); d20 += dpp_x2(d20); d21 += dpp_x2(d21);
                d10 += dpp_hm(d10); d11 += dpp_hm(d11); d20 += dpp_hm(d20); d21 += dpp_hm(d21);
                d10 += dpp_rm(d10); d11 += dpp_rm(d11); d20 += dpp_rm(d20); d21 += dpp_rm(d21);
                const float sa0 = -d10, sa1 = -d11;
                const f32x2 sa02 = {sa0, sa0}, sa12 = {sa1, sa1}, v02 = {v0, v0}, v12 = {v1, v1};
#pragma unroll
                for (int q = 0; q < 2; ++q) {
                    S0[q] = __builtin_elementwise_fma(S0[q], ww[q], __builtin_elementwise_fma(sa02, ka[q], v02 * k2[q]));
                    S1[q] = __builtin_elementwise_fma(S1[q], ww[q], __builtin_elementwise_fma(sa12, ka[q], v12 * k2[q]));
                }
                if (l16 == 0) { B4[t * 64 + r0] = d20 + sa0 * c1 + v0 * c2; B4[t * 64 + r0 + 32] = d21 + sa1 * c1 + v1 * c2; }
            }
        }
        __syncthreads();
        {
            const int t = row, ch0 = l * 512 + h * 64 + sub * 8;
            float o[8]; float s = 0.f;
#pragma unroll
            for (int e = 0; e < 8; ++e) { o[e] = B4[t * 64 + sub * 8 + e]; s += o[e]; }
            const float mean = red8(s) * (1.f / 64.f); float s2 = 0.f;
#pragma unroll
            for (int e = 0; e < 8; ++e) { o[e] -= mean; s2 += o[e] * o[e]; }
            const float rstd = rsqrtf(red8(s2) * (1.f / 64.f) + 64e-5f);
            const float bn = SCL[128 + t];
#pragma unroll
            for (int e = 0; e < 8; ++e) o[e] = (o[e] * rstd * p.in[24][ch0 + e] + p.in[25][ch0 + e] + bn * B2[t * 64 + sub * 8 + e]) * B5[t * 64 + sub * 8 + e];
            *(u32x4*)(YIN + (size_t)(t0 + t) * 1024 + 512 + h * 64 + sub * 8) = pack8(o);
        }
        __syncthreads();
    }
    {
        float* so = p.out + (prompt ? O_PRW + ((size_t)(l * 16 + b) * 8 + h) * 4096 : O_SRW + ((size_t)(l * 8 + b) * 8 + h) * 4096) + l16 * 4;
#pragma unroll
        for (int q = 0; q < 2; ++q) { *(f32x2*)(so + r0 * 64 + 2 * q) = S0[q]; *(f32x2*)(so + (r0 + 32) * 64 + 2 * q) = S1[q]; }
        if (h == 0) {
            const int tlast = prompt ? (seq + 1) * 2048 - 1 : NTP + (b + 1) * 64 - 1;
            float* sh = p.out + (prompt ? O_PSHIFT + (size_t)(l * 16 + b) * RWP : O_SSHIFT + (size_t)(l * 8 + b) * RWP);
            for (int i = tid; i < RWP; i += 512) sh[i] = bf2f(PROJ[(size_t)tlast * PJ + C_RW + i]);
        }
    }
    __syncthreads();
}

__device__ __forceinline__ void rwkv_chunk_unit(const Ctx& cx, const Params& p, int l, int seq, int h) {
    const int tid = cx.tid, lane = tid & 63, wave = tid >> 6, fr = lane & 15, fq = lane >> 4;
    constexpr int MS = 72;
    bf16_t* R0 = (bf16_t*)(smem);
    bf16_t* R2 = (bf16_t*)(smem + 9216);
    bf16_t* R3 = (bf16_t*)(smem + 18432);
    bf16_t* R1 = (bf16_t*)(smem + 27648);
    bf16_t* R4 = (bf16_t*)(smem + 36864);
    bf16_t* R5 = (bf16_t*)(smem + 46080);
    bf16_t* R6 = (bf16_t*)(smem + 55296);
    bf16_t* R7 = (bf16_t*)(smem + 64512);
    bf16_t* R8 = (bf16_t*)(smem + 73728);
    bf16_t* R9 = (bf16_t*)(smem + 82944);
    bf16_t* R10 = (bf16_t*)(smem + 92160);
    bf16_t* PT = (bf16_t*)(smem + 101376);
    float* GA = (float*)(smem + 110592);
    float* OW = (float*)(smem + 128000);
    float* GC = (float*)(smem + 145408);
    float* PRM = (float*)(smem + 145664);
    float* TF = (float*)(smem);
    const bf16_t* PROJ = (const bf16_t*)(p.ws + WS_R1);
    bf16_t* YIN = (bf16_t*)(p.ws + WS_H);
    const bool prompt = seq < 16;
    const int b = prompt ? seq : seq - 16;
    const int nch = prompt ? 32 : 1;
    const float* mu = p.in[15] + l * RWP;
    const float* shift_state = p.in[7] + (size_t)(l * 8 + b) * RWP;
    const int row = tid >> 3, sub = tid & 7;
    const int tm = wave & 3, ih = (wave >> 2) * 2;
    f32x4 Pacc[2];
#pragma unroll
    for (int q = 0; q < 2; ++q) Pacc[q] = (f32x4){0.f, 0.f, 0.f, 0.f};
    if (!prompt) {
        const float* s0 = p.in[6] + ((size_t)(l * 8 + b) * 8 + h) * 4096;
#pragma unroll
        for (int q = 0; q < 2; ++q)
#pragma unroll
            for (int jj = 0; jj < 4; ++jj) Pacc[q][jj] = s0[((ih + q) * 16 + fr) * 64 + tm * 16 + fq * 4 + jj];
    }
#pragma unroll
    for (int q = 0; q < 2; ++q) { u32x2 w; w.x = cvt_pk_bf16(Pacc[q][0], Pacc[q][1]); w.y = cvt_pk_bf16(Pacc[q][2], Pacc[q][3]); *(u32x2*)(PT + ((ih + q) * 16 + fr) * MS + tm * 16 + fq * 4) = w; }
    {
        const int pk = tid >> 6, pc = tid & 63;
        const float* s21 = p.in[21]; const float* s22 = p.in[22]; const float* s23 = p.in[23]; const float* s24 = p.in[24]; const float* s25 = p.in[25];
        const float* src = pk < 3 ? mu + pk * 512 + h * 64 : (pk == 3 ? s21 : (pk == 4 ? s22 : (pk == 5 ? s23 : (pk == 6 ? s24 : s25)))) + l * 512 + h * 64;
        PRM[pk * 64 + pc] = src[pc];
    }
    __syncthreads();
    u32x4 nx[9];
    {
        const int t_ = cx.tid >> 3, c_ = (cx.tid & 7) * 8;
        const int t0_ = prompt ? (seq * 32) * 64 : NTP + b * 64;
        const bf16_t* pr = PROJ + (size_t)(t0_ + t_) * PJ + h * 64 + c_;
        const bf16_t* pp = t_ > 0 ? pr - PJ : pr;
#pragma unroll
        for (int q = 0; q < 3; ++q) { nx[q] = *(const u32x4*)(pr + C_RW + q * 512); nx[3 + q] = *(const u32x4*)(pp + C_RW + q * 512); nx[6 + q] = *(const u32x4*)(pr + q * 512); }
    }
#pragma unroll 1
    for (int ci = 0; ci < nch; ++ci) {
        const int t0 = prompt ? (seq * 32 + ci) * 64 : NTP + b * 64;
        const bool first = (ci == 0);
        int tq = cx.tid; asm volatile("" : "+v"(tq));
        const int tid = tq, lane = tid & 63, wave = tid >> 6, fr = lane & 15, fq = lane >> 4, row = tid >> 3, sub = tid & 7, tm = wave & 3, ih = (wave >> 2) * 2;
        const int t = row, c0 = sub * 8, ch0 = l * 512 + h * 64 + c0;
        float v[8], g[8], bn;
        {
            float r[8], k[8], dd[8], a[8], kkn[8], be[8], k2[8];
            u32x4 raw[9];
#pragma unroll
            for (int q = 0; q < 9; ++q) raw[q] = nx[q];
            if (ci + 1 < nch) {
                const bf16_t* pr = PROJ + (size_t)(t0 + 64 + t) * PJ + h * 64 + c0;
#pragma unroll
                for (int q = 0; q < 3; ++q) { nx[q] = *(const u32x4*)(pr + C_RW + q * 512); nx[3 + q] = *(const u32x4*)(pr - PJ + C_RW + q * 512); nx[6 + q] = *(const u32x4*)(pr + q * 512); }
            }
            {
                float cur[8], prv[8];
#pragma unroll
                for (int kind = 0; kind < 3; ++kind) {
                    const int idx0 = kind * 512 + h * 64 + c0;
                    unpack8(raw[kind], cur);
                    if (t > 0 || !first) unpack8(raw[3 + kind], prv);
                    else if (!prompt) {
#pragma unroll
                        for (int e = 0; e < 8; ++e) prv[e] = shift_state[idx0 + e];
                    } else {
#pragma unroll
                        for (int e = 0; e < 8; ++e) prv[e] = 0.f;
                    }
                    float* dst = kind == 0 ? r : (kind == 1 ? k : v);
#pragma unroll
                    for (int e = 0; e < 8; ++e) dst[e] = cur[e] + (prv[e] - cur[e]) * PRM[kind * 64 + c0 + e];
                }
            }
            unpack8(raw[6], dd); unpack8(raw[7], a); unpack8(raw[8], g);
            float ss = 0.f; bn = 0.f;
#pragma unroll
            for (int e = 0; e < 8; ++e) { kkn[e] = k[e] * PRM[192 + c0 + e]; ss += kkn[e] * kkn[e]; }
            ss = red8(ss);
            const float rn = rsqrtf(ss + 1e-6f);
#pragma unroll
            for (int e = 0; e < 8; ++e) {
                kkn[e] *= rn; be[e] = kkn[e] * a[e];
                k2[e] = k[e] * (1.f + (a[e] - 1.f) * PRM[256 + c0 + e]);
                bn += r[e] * k2[e] * PRM[320 + c0 + e];
                GA[t * 64 + c0 + e] = dd[e];
            }
            bn = red8(bn);
            __syncthreads();
            {
                const int j = tid & 63, sg = tid >> 6;
                float sacc = 0.f;
#pragma unroll
                for (int q = 0; q < 8; ++q) { sacc += GA[(sg * 8 + q) * 64 + j]; GA[(sg * 8 + q) * 64 + j] = sacc; }
                OW[sg * 64 + j] = sacc;
                __syncthreads();
                float pre = 0.f;
                for (int q = 0; q < sg; ++q) pre += OW[q * 64 + j];
#pragma unroll
                for (int q = 0; q < 8; ++q) GA[(sg * 8 + q) * 64 + j] += pre;
            }
            __syncthreads();
            {
                float at[8], bt[8], kt[8], rt[8];
#pragma unroll
                for (int e = 0; e < 8; ++e) {
                    const int j = c0 + e;
                    const float Gt = GA[t * 64 + j], Gp = t > 0 ? GA[(t - 1) * 64 + j] : 0.f, Gc = GA[63 * 64 + j];
                    const float em = __expf(-Gp), ep = __expf(Gt), en = __expf(-Gt), ec = __expf(Gt - Gc);
                    at[e] = -kkn[e] * em; bt[e] = be[e] * ep; kt[e] = k2[e] * ep; rt[e] = r[e] * en;
                    const int so = swz_el(j, t);
                    R5[so] = f2bf(be[e] * ec); R6[so] = f2bf(k2[e] * ec); R7[so] = f2bf(v[e]);
                    if (t == 63) GC[j] = __expf(-Gc);
                }
                *(u32x4*)(R0 + t * MS + c0) = pack8(at); *(u32x4*)(R2 + t * MS + c0) = pack8(bt); *(u32x4*)(R3 + t * MS + c0) = pack8(kt); *(u32x4*)(R4 + t * MS + c0) = pack8(rt);
            }
        }
        __syncthreads();
#pragma unroll
        for (int q = 0; q < 2; ++q) {
            const int tile = wave * 2 + q, sm = tile >> 2, tn = tile & 3;
            f32x4 lb = {0.f, 0.f, 0.f, 0.f}, lk = lb, mb = lb, mk = lb;
#pragma unroll
            for (int kk = 0; kk < 2; ++kk) {
                const bf16x8 yb = *(const bf16x8*)(R2 + (sm * 16 + fr) * MS + kk * 32 + fq * 8), yk = *(const bf16x8*)(R3 + (sm * 16 + fr) * MS + kk * 32 + fq * 8);
                const bf16x8 xa = *(const bf16x8*)(R0 + (tn * 16 + fr) * MS + kk * 32 + fq * 8), xr = *(const bf16x8*)(R4 + (tn * 16 + fr) * MS + kk * 32 + fq * 8);
                lb = __builtin_amdgcn_mfma_f32_16x16x32_bf16(yb, xa, lb, 0, 0, 0); lk = __builtin_amdgcn_mfma_f32_16x16x32_bf16(yk, xa, lk, 0, 0, 0);
                mb = __builtin_amdgcn_mfma_f32_16x16x32_bf16(yb, xr, mb, 0, 0, 0); mk = __builtin_amdgcn_mfma_f32_16x16x32_bf16(yk, xr, mk, 0, 0, 0);
            }
            const int tt = tn * 16 + fr, s0i = sm * 16 + fq * 4;
            float olk[4], omb[4], omk[4];
#pragma unroll
            for (int jj = 0; jj < 4; ++jj) {
                const int si = s0i + jj;
                olk[jj] = (si < tt) ? lk[jj] : 0.f; omb[jj] = (si <= tt) ? mb[jj] : 0.f; omk[jj] = (si <= tt) ? mk[jj] : 0.f;
            }
            u32x2 w;
            w.x = cvt_pk_bf16(olk[0], olk[1]); w.y = cvt_pk_bf16(olk[2], olk[3]); *(u32x2*)(R8 + tt * MS + s0i) = w;
            w.x = cvt_pk_bf16(omb[0], omb[1]); w.y = cvt_pk_bf16(omb[2], omb[3]); *(u32x2*)(R9 + tt * MS + s0i) = w;
            w.x = cvt_pk_bf16(omk[0], omk[1]); w.y = cvt_pk_bf16(omk[2], omk[3]); *(u32x2*)(R10 + tt * MS + s0i) = w;
#pragma unroll
            for (int jj = 0; jj < 4; ++jj) { const int si = s0i + jj; GA[tt * 68 + si] = (si < tt) ? -lb[jj] : 0.f; }
        }
        __syncthreads();
#pragma unroll
        for (int q = 0; q < 2; ++q) {
            f32x4 y = {0.f, 0.f, 0.f, 0.f};
#pragma unroll
            for (int kk = 0; kk < 2; ++kk) {
                y = __builtin_amdgcn_mfma_f32_16x16x32_bf16(*(const bf16x8*)(R8 + (tm * 16 + fr) * MS + kk * 32 + fq * 8), *(const bf16x8*)(R7 + swz_ch((ih + q) * 16 + fr, kk * 4 + fq)), y, 0, 0, 0);
                y = __builtin_amdgcn_mfma_f32_16x16x32_bf16(*(const bf16x8*)(R0 + (tm * 16 + fr) * MS + kk * 32 + fq * 8), *(const bf16x8*)(PT + ((ih + q) * 16 + fr) * MS + kk * 32 + fq * 8), y, 0, 0, 0);
            }
            u32x2 w; w.x = cvt_pk_bf16(y[0], y[1]); w.y = cvt_pk_bf16(y[2], y[3]); *(u32x2*)(R1 + ((ih + q) * 16 + fr) * MS + tm * 16 + fq * 4) = w;
        }
        __syncthreads();
        {
            bf16_t* TM = R3;
            tri_inv64(GA, TF, OW, tid);
            __syncthreads();
#pragma unroll
            for (int q = 0; q < 8; ++q) { const int e = tid + q * 512, i = e >> 6, cc = e & 63; TM[i * MS + cc] = ((cc >> 4) <= (i >> 4)) ? f2bf(TF[i * 68 + cc]) : (bf16_t)0; }
        }
        __syncthreads();
#pragma unroll
        for (int q = 0; q < 2; ++q) {
            f32x4 uacc = {0.f, 0.f, 0.f, 0.f};
#pragma unroll
            for (int kk = 0; kk < 2; ++kk)
                uacc = __builtin_amdgcn_mfma_f32_16x16x32_bf16(*(const bf16x8*)(R3 + (tm * 16 + fr) * MS + kk * 32 + fq * 8), *(const bf16x8*)(R1 + ((ih + q) * 16 + fr) * MS + kk * 32 + fq * 8), uacc, 0, 0, 0);
            u32x2 w; w.x = cvt_pk_bf16(uacc[0], uacc[1]); w.y = cvt_pk_bf16(uacc[2], uacc[3]); *(u32x2*)(R2 + ((ih + q) * 16 + fr) * MS + tm * 16 + fq * 4) = w;
        }
        __syncthreads();
#pragma unroll
        for (int q = 0; q < 2; ++q) {
            f32x4 o = {0.f, 0.f, 0.f, 0.f};
            const f32x4 gc = *(const f32x4*)(GC + tm * 16 + fq * 4);
            Pacc[q] = Pacc[q] * gc;
#pragma unroll
            for (int kk = 0; kk < 2; ++kk) {
                const bf16x8 vt = *(const bf16x8*)(R7 + swz_ch((ih + q) * 16 + fr, kk * 4 + fq)), ut = *(const bf16x8*)(R2 + ((ih + q) * 16 + fr) * MS + kk * 32 + fq * 8);
                const bf16x8 pt = *(const bf16x8*)(PT + ((ih + q) * 16 + fr) * MS + kk * 32 + fq * 8);
                o = __builtin_amdgcn_mfma_f32_16x16x32_bf16(*(const bf16x8*)(R10 + (tm * 16 + fr) * MS + kk * 32 + fq * 8), vt, o, 0, 0, 0);
                o = __builtin_amdgcn_mfma_f32_16x16x32_bf16(*(const bf16x8*)(R4 + (tm * 16 + fr) * MS + kk * 32 + fq * 8), pt, o, 0, 0, 0);
                o = __builtin_amdgcn_mfma_f32_16x16x32_bf16(*(const bf16x8*)(R9 + (tm * 16 + fr) * MS + kk * 32 + fq * 8), ut, o, 0, 0, 0);
                Pacc[q] = __builtin_amdgcn_mfma_f32_16x16x32_bf16(*(const bf16x8*)(R5 + swz_ch(tm * 16 + fr, kk * 4 + fq)), ut, Pacc[q], 0, 0, 0);
                Pacc[q] = __builtin_amdgcn_mfma_f32_16x16x32_bf16(*(const bf16x8*)(R6 + swz_ch(tm * 16 + fr, kk * 4 + fq)), vt, Pacc[q], 0, 0, 0);
            }
#pragma unroll
            for (int jj = 0; jj < 4; ++jj) OW[(tm * 16 + fq * 4 + jj) * 68 + (ih + q) * 16 + fr] = o[jj];
        }
        __syncthreads();
#pragma unroll
        for (int q = 0; q < 2; ++q) { u32x2 w; w.x = cvt_pk_bf16(Pacc[q][0], Pacc[q][1]); w.y = cvt_pk_bf16(Pacc[q][2], Pacc[q][3]); *(u32x2*)(PT + ((ih + q) * 16 + fr) * MS + tm * 16 + fq * 4) = w; }
        {
            float o[8]; float sm = 0.f;
#pragma unroll
            for (int e = 0; e < 8; ++e) { o[e] = OW[t * 68 + c0 + e]; sm += o[e]; }
            const float mean = red8(sm) * (1.f / 64.f); float s2 = 0.f;
#pragma unroll
            for (int e = 0; e < 8; ++e) { o[e] -= mean; s2 += o[e] * o[e]; }
            const float rstd = rsqrtf(red8(s2) * (1.f / 64.f) + 64e-5f);
#pragma unroll
            for (int e = 0; e < 8; ++e) o[e] = (o[e] * rstd * PRM[384 + c0 + e] + PRM[448 + c0 + e] + bn * v[e]) * g[e];
            *(u32x4*)(YIN + (size_t)(t0 + t) * 1024 + 512 + h * 64 + c0) = pack8(o);
        }
        __syncthreads();
    }
    {
        float* so = p.out + (prompt ? O_PRW + ((size_t)(l * 16 + b) * 8 + h) * 4096 : O_SRW + ((size_t)(l * 8 + b) * 8 + h) * 4096);
#pragma unroll
        for (int q = 0; q < 2; ++q)
#pragma unroll
            for (int jj = 0; jj < 4; ++jj) so[((ih + q) * 16 + fr) * 64 + tm * 16 + fq * 4 + jj] = Pacc[q][jj];
        if (h == 0) {
            const int tlast = prompt ? (seq + 1) * 2048 - 1 : NTP + (b + 1) * 64 - 1;
            float* sh = p.out + (prompt ? O_PSHIFT + (size_t)(l * 16 + b) * RWP : O_SSHIFT + (size_t)(l * 8 + b) * RWP);
            for (int i = tid; i < RWP; i += 512) sh[i] = bf2f(PROJ[(size_t)tlast * PJ + C_RW + i]);
        }
    }
    __syncthreads();
}

__device__ __forceinline__ void phase_scan(const Ctx& cx, const Params& p, int l) {
#ifndef REP_SCAN
#define REP_SCAN 1
#endif
    for (int rep = 0; rep < REP_SCAN; ++rep)
    for (int w = cx.bid; w < 288; w += cx.nb) {
        bool isr; int seq, h;
        if (w < 128) { isr = true; seq = w >> 3; h = w & 7; }
        else if (w < 192) { isr = false; seq = (w - 128) >> 2; h = (w - 128) & 3; }
        else if (w < 224) { isr = false; seq = 16 + ((w - 192) >> 2); h = (w - 192) & 3; }
        else { isr = true; seq = 16 + ((w - 224) >> 3); h = (w - 224) & 7; }
#ifndef SCANM
#define SCANM 3
#endif
#ifndef REP_R
#define REP_R 1
#endif
#ifndef REP_GD
#define REP_GD 1
#endif
        if (isr) { if (SCANM & 1) for (int rr = 0; rr < REP_R; ++rr) rwkv_chunk_unit(cx, p, l, seq, h); }
        else { if (SCANM & 2) for (int rr = 0; rr < REP_GD; ++rr) gdn_scan_unit(cx, p, l, seq, h); }
    }
}

#define XB_TMO      128
#define XB_XCNT(j)  (256  + 64 * (j))
#define XB_XSUB(j)  (1280 + 64 * (j))
#define XB_XGEN(j)  (2304 + 64 * (j))
#define XB_TOP      3328
#define XB_TOPGEN   3392
#define XCD_BAR_WORDS 3456
#define XB_SPIN_CAP (1u << 18)
#define XLAS __attribute__((address_space(3)))
__device__ __forceinline__ unsigned xb_ld(unsigned* p)              { return __hip_atomic_load(p, __ATOMIC_RELAXED, __HIP_MEMORY_SCOPE_AGENT); }
__device__ __forceinline__ unsigned xb_add(unsigned* p, unsigned v) { return __hip_atomic_fetch_add(p, v, __ATOMIC_RELAXED, __HIP_MEMORY_SCOPE_AGENT); }
__device__ __forceinline__ unsigned xb_xcc_id() { return (unsigned)__builtin_amdgcn_s_getreg((3 << 11) | 20) & 0xFu; }
#define XB_SPIN(cond, bar) do { unsigned _sp = 0; while (cond) { __builtin_amdgcn_s_sleep(1); \
    if ((++_sp & 255u) == 0u) { if (xb_ld(&(bar)[XB_TMO])) break; if (_sp > XB_SPIN_CAP) { atomicAdd(&(bar)[XB_TMO], 1u); break; } } } } while (0)
struct XcdBarrier { unsigned* bar; unsigned x; volatile XLAS unsigned* st; };
__device__ __forceinline__ XcdBarrier xcd_barrier_post(unsigned* bar, volatile XLAS unsigned* st) {
    XcdBarrier b; b.bar = bar; b.x = xb_xcc_id(); b.st = st;
    if (threadIdx.x == 0) (void)xb_add(&bar[XB_XCNT(b.x)], 1u);
    return b;
}
__device__ __forceinline__ void xcd_barrier_complete(unsigned* bar, unsigned x, unsigned& nloc, unsigned& nx) {
    const unsigned G = gridDim.x * gridDim.y * gridDim.z;
    unsigned sum, cnt, mine, sp = 0u;
    for (;;) {
        sum = 0u; cnt = 0u; mine = 0u;
#pragma unroll
        for (unsigned j = 0; j < 16; ++j) { const unsigned c = xb_ld(&bar[XB_XCNT(j)]); sum += c; cnt += (c > 0u) ? 1u : 0u; mine = (j == x) ? c : mine; }
        if (sum == G) break;
        __builtin_amdgcn_s_sleep(1);
        if ((++sp & 255u) == 0u) { if (xb_ld(&bar[XB_TMO])) break; if (sp > XB_SPIN_CAP) { atomicAdd(&bar[XB_TMO], 1u); break; } }
    }
    nloc = mine > 0u ? mine : 1u; nx = cnt > 0u ? cnt : 1u;
}
__device__ __forceinline__ void xcd_barrier(const XcdBarrier& b) {
    asm volatile("s_waitcnt vmcnt(0)" ::: "memory");
    __syncthreads();
    if (threadIdx.x == 0) {
        unsigned* bar = b.bar;
        __builtin_amdgcn_s_waitcnt(0);
        unsigned nloc = b.st[0], nx = b.st[1];
        if (nloc == 0u) { xcd_barrier_complete(bar, b.x, nloc, nx); b.st[0] = nloc; b.st[1] = nx; }
        const unsigned old = xb_add(&bar[XB_XSUB(b.x)], 1u);
        const unsigned gen = old / nloc;
        if (old + 1u == (gen + 1u) * nloc) {
            __builtin_amdgcn_fence(__ATOMIC_RELEASE, "agent");
            asm volatile("s_waitcnt vmcnt(0)" ::: "memory");
            const unsigned og = xb_add(&bar[XB_TOP], 1u);
            const unsigned tg = og / nx;
            if (og + 1u == (tg + 1u) * nx) xb_add(&bar[XB_TOPGEN], 1u);
            else XB_SPIN(xb_ld(&bar[XB_TOPGEN]) == tg, bar);
            __builtin_amdgcn_fence(__ATOMIC_ACQUIRE, "agent");
            xb_add(&bar[XB_XGEN(b.x)], 1u);
            asm volatile("s_waitcnt vmcnt(0)" ::: "memory");
        } else {
            XB_SPIN(xb_ld(&bar[XB_XGEN(b.x)]) == gen, bar);
            __builtin_amdgcn_fence(__ATOMIC_ACQUIRE, "agent");
            asm volatile("s_waitcnt vmcnt(0)" ::: "memory");
        }
    }
    __syncthreads();
}

__device__ __forceinline__ void run_phase(const Ctx& cx, const Params& p, int ph) {
    unsigned char* ws = p.ws;
    const float* MOD = (const float*)(ws + WS_MOD);
#ifndef PHM
#define PHM 0xFFFF
#endif
    if (ph == 0) { if (PHM & 1) phase_mod(cx, p); __syncthreads(); if (PHM & 2) phase_weights(cx, p, 0); return; }
    if (ph == 1) { if (PHM & 4) phase_mod0(cx, p); return; }
    const int l = (ph - 2) / 9, s = (ph - 2) % 9;
    const float* modl = MOD + (size_t)l * 24 * 6144;
    gm::Epi E{};
    const bf16_t* gA = (const bf16_t*)(ws + WS_H); const bf16_t* gB = nullptr; int gN = 0, gK = 1024;
    switch (s) {
    case 0: E.kind = 1; E.O = (bf16_t*)(ws + WS_R1); E.ldo = PJ; gB = (const bf16_t*)(ws + WS_WIN); gN = PJ; break;
    case 1: if (PHM & 16) phase_gdn_prep(cx, p, l); break;
    case 2: if (PHM & 128) phase_rwkv_prep(cx, p, l); break;
    case 3: if (PHM & 32) phase_scan(cx, p, l); break;
    case 4: E.kind = 2; E.X = p.out; E.O = (bf16_t*)(ws + WS_PREP); E.gate = modl + 2048; gB = (const bf16_t*)(ws + WS_WOUT); gN = 1024;
        if (l == 0) { E.xp = p.in[0]; E.xs = p.in[1] - (size_t)NTP * 1024; E.xb = nullptr; } else { E.xp = p.out; E.xs = p.out; E.xb = (const bf16_t*)p.out; }
        break;
    case 5: if (PHM & 64) phase_ln(cx, p, p.in[27] + l * 1024, p.in[28] + l * 1024, modl, 3072, 4096, false); break;
    case 6: E.kind = 3; E.O = (bf16_t*)(ws + WS_R1); E.ldo = DFF; gB = (const bf16_t*)(ws + WS_W1); gN = DFF; break;
    case 7: E.kind = 2; E.X = p.out; E.O = (bf16_t*)(ws + WS_PREP); E.gate = modl + 5120; E.xp = p.out; E.xs = p.out; E.xb = (const bf16_t*)p.out;
        gA = (const bf16_t*)(ws + WS_R1); gB = (const bf16_t*)(ws + WS_W2); gN = 1024; gK = DFF; break;
    default:
        if (PHM & 64) phase_ln(cx, p, p.in[31] + l * 1024, p.in[32] + l * 1024, l < NLAYER - 1 ? modl + 24 * 6144 : nullptr, 0, 1024, l == NLAYER - 1);
        if ((PHM & 2) && l < NLAYER - 1) { __syncthreads(); phase_weights(cx, p, l + 1); }
        break;
    }
#ifndef REP_G
#define REP_G 1
#endif
#ifndef REP_G2
#define REP_G2 0
#endif
    if ((PHM & 8) && gB) {
        const int reps = (E.kind == 2) ? 1 + REP_G2 : REP_G;
        for (int r = 0; r < reps; ++r) { gm::Epi E2 = E; if (E.kind == 2 && r + 1 < reps) E2.kind = 0; gemm_phase(cx, gA, gB, NTOK, gN, gK, E2); }
    }
}

#ifndef DBG_STOP
#define DBG_STOP 0
#endif
#ifndef DBG_OFF
#define DBG_OFF WS_PREP
#endif
#ifndef DBG_MOD
#define DBG_MOD 76677120
#endif
#ifndef DBG_SZ
#define DBG_SZ 20480
#define DBG_POFF 16384
#endif
#ifndef DBG_STRIDE
#define DBG_STRIDE 5
#endif
__global__ void __launch_bounds__(512) mk_fwd(Params p) {
    cg::grid_group grid = cg::this_grid();
    if (p.ph_lo == 1000) {
        const bf16_t* src = (const bf16_t*)(p.ws + DBG_OFF);
        for (size_t i = (size_t)blockIdx.x * 512 + threadIdx.x; i < 44130304; i += (size_t)gridDim.x * 512) p.out[i] = bf2f(src[((i / DBG_SZ) % 2080) * 36864 + DBG_POFF + (i % DBG_SZ)]);
        return;
    }
    volatile XLAS unsigned* xst = (volatile XLAS unsigned*)((XLAS unsigned char*)smem + (LDS_BYTES - 16));
    if (threadIdx.x == 0) { xst[0] = 0u; xst[1] = 0u; xst[2] = 0u; xst[3] = 0u; }
    __syncthreads();
    const XcdBarrier xb = xcd_barrier_post((unsigned*)(p.ws + WS_BAR), xst);
    for (int ph = p.ph_lo; ph < p.ph_hi; ++ph) {
        if (ph > p.ph_lo) { if (p.ph_hi == 0x7fffffff) grid.sync(); else xcd_barrier(xb); }
        Ctx cx; cx.tid = threadIdx.x; cx.bid = blockIdx.x; cx.nb = gridDim.x;
        asm volatile("" : "+v"(cx.tid)); asm volatile("" : "+s"(cx.bid)); asm volatile("" : "+s"(cx.nb));
        run_phase(cx, p, ph);
        __syncthreads();
    }
}

extern "C" void kernel_launch(void* const* d_in, const int* in_sizes, int n_in, void* d_out, int out_size, void* d_ws, size_t ws_size, hipStream_t stream) {
    static int grid = 0;
    if (grid == 0) {
        if (n_in != 33 || ws_size < WS_END) { fprintf(stderr, "kernel_launch: unexpected n_in %d / ws %zu (need %zu)\n", n_in, ws_size, (size_t)WS_END); grid = -1; return; }
        int dev = 0, cus = 0, per_cu = 0;
        hipGetDevice(&dev);
        hipDeviceGetAttribute(&cus, hipDeviceAttributeMultiprocessorCount, dev);
        if (hipFuncSetAttribute((const void*)mk_fwd, hipFuncAttributeMaxDynamicSharedMemorySize, LDS_BYTES) != hipSuccess) { fprintf(stderr, "kernel_launch: hipFuncSetAttribute failed\n"); grid = -1; return; }
        if (hipOccupancyMaxActiveBlocksPerMultiprocessor(&per_cu, (const void*)mk_fwd, 512, LDS_BYTES) != hipSuccess || per_cu < 1) { fprintf(stderr, "kernel_launch: occupancy query says %d\n", per_cu); per_cu = 1; }
        (void)hipGetLastError();
        grid = cus;
    }
    if (grid < 0) return;
    if (hipMemsetAsync((char*)d_ws + WS_BAR, 0, 16384, stream) != hipSuccess) { fprintf(stderr, "kernel_launch: memset of the barrier words failed\n"); return; }
    Params p{};
    for (int i = 0; i < 33; ++i) p.in[i] = (const float*)d_in[i];
    p.out = (float*)d_out; p.ws = (unsigned char*)d_ws;
#if MK_ONE_LAUNCH
    p.ph_lo = 0; p.ph_hi = NPHASE;
    void* args[] = {&p};
    hipError_t e = hipLaunchCooperativeKernel((const void*)mk_fwd, dim3(grid), dim3(512), args, LDS_BYTES, stream);
    if (e != hipSuccess) fprintf(stderr, "cooperative launch failed: %s (grid %d)\n", hipGetErrorString(e), grid);
#else
    for (int ph = 0; ph < (DBG_STOP ? DBG_STOP + 1 : NPHASE); ++ph) {
        p.ph_lo = ph; p.ph_hi = ph + 1;
        if (DBG_STOP && ph == DBG_STOP) { p.ph_lo = 1000; p.ph_hi = 1000; }
        void* args[] = {&p};
        hipError_t e = hipLaunchCooperativeKernel((const void*)mk_fwd, dim3(grid), dim3(512), args, LDS_BYTES, stream);
        if (e != hipSuccess) { fprintf(stderr, "launch %d failed: %s\n", ph, hipGetErrorString(e)); break; }
    }
#endif
}
```

```cpp
#include <hip/hip_runtime.h>
#include <hip/hip_cooperative_groups.h>
#include <cstdio>
#include <cstdint>
namespace cg = cooperative_groups;

#ifndef MK_ONE_LAUNCH
#define MK_ONE_LAUNCH 1
#define DBL_MASK 0x6
#endif

typedef unsigned short bf16_t;
typedef short bf16x8 __attribute__((ext_vector_type(8)));
typedef float f32x4 __attribute__((ext_vector_type(4)));
typedef float f32x2 __attribute__((ext_vector_type(2)));
typedef unsigned u32x4 __attribute__((ext_vector_type(4)));
typedef unsigned u32x2 __attribute__((ext_vector_type(2)));

constexpr int DM = 1024, NTOK = 33280, NTP = 32768, NSEQ = 24, NLAYER = 4;
constexpr int PJ = 4096;
constexpr int PTOT = 3848;
constexpr int C_Z = 1536, C_RW = 2048, C_GA = 3840, C_GB = 3844;
constexpr int DFF = 4096;
constexpr int RWP = 1792;
constexpr float DN_ALPHA = 1.681792830507429f;
constexpr int LDS_BYTES = 151552;
constexpr int NPHASE = 2 + 9 * NLAYER;

constexpr size_t WS_MOD = 0;
constexpr size_t WS_WIN = 2359296;
constexpr size_t WS_WOUT = WS_WIN + 8388608;
constexpr size_t WS_W1 = WS_WOUT + 2097152;
constexpr size_t WS_W2 = WS_W1 + 8388608;
constexpr size_t WS_LW2 = WS_W2 + 8388608;
constexpr size_t WS_LA2 = WS_LW2 + 65536;
constexpr size_t WS_LG2 = WS_LA2 + 65536;
constexpr size_t WS_DL = WS_LG2 + 131072;
constexpr size_t WS_H = WS_DL + 16384;
constexpr size_t WS_R1 = WS_H + 68157440;
constexpr size_t WS_PREP = WS_R1 + 272629760;
constexpr size_t WS_BAR = WS_PREP + 153354240;
constexpr size_t WS_END = WS_BAR + 16384;
constexpr int PREP_STRIDE = 36864;
constexpr int PO_U0T = 0, PO_WKN = 8192, PO_QD = 16384, PO_KDT = 24576, PO_QK = 32768;

constexpr size_t O_PGDN = 34078720, O_PCONV = 38273024, O_PRW = 38567936, O_PSHIFT = 40665088;
constexpr size_t O_SGDN = 40779776, O_SCONV = 42876928, O_SRW = 43024384, O_SSHIFT = 44072960;

struct Ctx { int tid, bid, nb; };
struct Params {
    const float* in[33];
    float* out;
    unsigned char* ws;
    int ph_lo, ph_hi;
};

extern __shared__ __attribute__((aligned(16))) unsigned char smem[];

typedef __bf16 bf16x2_t __attribute__((ext_vector_type(2)));
__device__ __forceinline__ unsigned cvt_pk_bf16(float lo, float hi) { f32x2 f = {lo, hi}; bf16x2_t v = __builtin_convertvector(f, bf16x2_t); return __builtin_bit_cast(unsigned, v); }
__device__ __forceinline__ bf16_t f2bf(float f) { return (bf16_t)(cvt_pk_bf16(f, 0.f) & 0xffffu); }
__device__ __forceinline__ float bf2f(bf16_t b) { return __uint_as_float(((unsigned)b) << 16); }
__device__ __forceinline__ float bflo(unsigned w) { return __uint_as_float(w << 16); }
__device__ __forceinline__ float bfhi(unsigned w) { return __uint_as_float(w & 0xffff0000u); }
__device__ __forceinline__ void unpack8(u32x4 w, float* f) {
    f[0] = bflo(w.x); f[1] = bfhi(w.x); f[2] = bflo(w.y); f[3] = bfhi(w.y);
    f[4] = bflo(w.z); f[5] = bfhi(w.z); f[6] = bflo(w.w); f[7] = bfhi(w.w);
}
__device__ __forceinline__ u32x4 pack8(const float* f) {
    u32x4 w; w.x = cvt_pk_bf16(f[0], f[1]); w.y = cvt_pk_bf16(f[2], f[3]); w.z = cvt_pk_bf16(f[4], f[5]); w.w = cvt_pk_bf16(f[6], f[7]); return w;
}
__device__ __forceinline__ float silu_f(float x) { return x / (1.f + __expf(-x)); }
__device__ __forceinline__ float sigmoid_f(float x) { return 1.f / (1.f + __expf(-x)); }
__device__ __forceinline__ float softplus_f(float x) { return fmaxf(x, 0.f) + __logf(1.f + __expf(-fabsf(x))); }
__device__ __forceinline__ float tanh_f(float x) { return 1.f - 2.f / (1.f + __expf(2.f * x)); }
__device__ __forceinline__ float dpp_x1(float x) { return __int_as_float(__builtin_amdgcn_mov_dpp(__float_as_int(x), 0xB1, 0xF, 0xF, true)); }
__device__ __forceinline__ float dpp_x2(float x) { return __int_as_float(__builtin_amdgcn_mov_dpp(__float_as_int(x), 0x4E, 0xF, 0xF, true)); }
__device__ __forceinline__ float dpp_hm(float x) { return __int_as_float(__builtin_amdgcn_mov_dpp(__float_as_int(x), 0x141, 0xF, 0xF, true)); }
__device__ __forceinline__ float dpp_rm(float x) { return __int_as_float(__builtin_amdgcn_mov_dpp(__float_as_int(x), 0x140, 0xF, 0xF, true)); }
__device__ __forceinline__ float red8(float x) { x += dpp_x1(x); x += dpp_x2(x); x += dpp_hm(x); return x; }
__device__ __forceinline__ float red16(float x) { x = red8(x); x += dpp_rm(x); return x; }
__device__ __forceinline__ float wave_sum(float v) {
#pragma unroll
    for (int o = 1; o < 64; o <<= 1) v += __shfl_xor(v, o);
    return v;
}
__device__ __forceinline__ int seq_of_row(int row) { return row < NTP ? (row >> 11) : 16 + ((row - NTP) >> 6); }
#define LDS_WAIT() asm volatile("s_waitcnt lgkmcnt(0)" ::: "memory")

__device__ __forceinline__ void phase_mod(const Ctx& cx, const Params& p) {
    float* sc = (float*)smem;
    const int tid = cx.tid;
    const float* c_p = p.in[2]; const float* c_s = p.in[3];
    const float* w_ada = p.in[8]; const float* b_ada = p.in[9];
    float* MOD = (float*)(p.ws + WS_MOD);
    for (int item = cx.bid; item < NLAYER * 96; item += cx.nb) {
        const int l = item / 96, cgp = item % 96;
        for (int idx = tid; idx < 24 * 1024; idx += 512) {
            const int s = idx >> 10, k = idx & 1023;
            const float c = s < 16 ? c_p[s * 1024 + k] : c_s[(s - 16) * 1024 + k];
            sc[k * 24 + s] = silu_f(c);
        }
        __syncthreads();
        const int kg = tid >> 6, col = tid & 63;
        float acc[24];
#pragma unroll
        for (int s = 0; s < 24; ++s) acc[s] = 0.f;
        const float* wp = w_ada + (size_t)l * 1024 * 6144 + (size_t)(kg * 128) * 6144 + cgp * 64 + col;
#pragma unroll 16
        for (int k = 0; k < 128; ++k) {
            const float w = wp[(size_t)k * 6144];
            const f32x4* sp = (const f32x4*)(sc + (kg * 128 + k) * 24);
#pragma unroll
            for (int q = 0; q < 6; ++q) { const f32x4 v = sp[q]; acc[4 * q] += v.x * w; acc[4 * q + 1] += v.y * w; acc[4 * q + 2] += v.z * w; acc[4 * q + 3] += v.w * w; }
        }
        __syncthreads();
#pragma unroll
        for (int s = 0; s < 24; ++s) sc[(kg * 24 + s) * 64 + col] = acc[s];
        __syncthreads();
        for (int o = tid; o < 24 * 64; o += 512) {
            const int s = o >> 6, c = o & 63;
            float sum = b_ada[l * 6144 + cgp * 64 + c];
#pragma unroll
            for (int g = 0; g < 8; ++g) sum += sc[(g * 24 + s) * 64 + c];
            MOD[(size_t)(l * 24 + s) * 6144 + cgp * 64 + c] = sum;
        }
        __syncthreads();
    }
}

__device__ __forceinline__ int win_map(int n) { return n < 2048 ? n : (n < 2056 ? n - 2048 + C_GA : n - 8); }
__device__ __forceinline__ void transpose_w(const Ctx& cx, const float* W, int K, int N, bf16_t* WT, int mode, int gw, int NGW, int rot) {
    const int lane = cx.tid & 63, wave = cx.tid >> 6;
    float* scr = (float*)(smem + wave * 8448);
    const int nblk = (N + 31) / 32, nitems = (K / 64) * nblk;
    int start = gw - rot; while (start < 0) start += NGW;
    for (int it = start; it < nitems; it += NGW) {
        const int kb = it / nblk, nb = it % nblk, k0 = 64 * kb, n0 = 32 * nb;
        const int nn = n0 + (lane & 31);
#pragma unroll
        for (int i = 0; i < 32; ++i) { const int kk = 2 * i + (lane >> 5); scr[kk * 33 + (lane & 31)] = nn < N ? W[(size_t)(k0 + kk) * N + nn] : 0.f; }
        LDS_WAIT();
        const int c = lane & 7;
#pragma unroll
        for (int j = 0; j < 4; ++j) {
            const int nl = (lane >> 3) + 8 * j, n = n0 + nl;
            const float* s = scr + (8 * c) * 33 + nl;
            u32x4 o; o.x = cvt_pk_bf16(s[0], s[33]); o.y = cvt_pk_bf16(s[66], s[99]); o.z = cvt_pk_bf16(s[132], s[165]); o.w = cvt_pk_bf16(s[198], s[231]);
            if (n < N) { const int row = mode ? win_map(n) : n; *(u32x4*)(WT + (size_t)row * K + k0 + 8 * c) = o; }
        }
        LDS_WAIT();
    }
}
__device__ __forceinline__ void phase_weights(const Ctx& cx, const Params& p, int l) {
    const int gw = cx.bid * 8 + (cx.tid >> 6), NGW = cx.nb * 8;
    unsigned char* ws = p.ws;
    transpose_w(cx, p.in[10] + (size_t)l * 1024 * PTOT, 1024, PTOT, (bf16_t*)(ws + WS_WIN), 1, gw, NGW, 0);
    transpose_w(cx, p.in[26] + (size_t)l * 1024 * 1024, 1024, 1024, (bf16_t*)(ws + WS_WOUT), 0, gw, NGW, 1936 % NGW);
    transpose_w(cx, p.in[29] + (size_t)l * 1024 * 4096, 1024, 4096, (bf16_t*)(ws + WS_W1), 0, gw, NGW, (1936 + 512) % NGW);
    transpose_w(cx, p.in[30] + (size_t)l * 4096 * 1024, 4096, 1024, (bf16_t*)(ws + WS_W2), 0, gw, NGW, (1936 + 512 + 2048) % NGW);
    transpose_w(cx, p.in[17] + (size_t)l * 64 * 512, 64, 512, (bf16_t*)(ws + WS_LW2), 0, gw, NGW, (1936 + 512 + 4096) % NGW);
    transpose_w(cx, p.in[19] + (size_t)l * 64 * 512, 64, 512, (bf16_t*)(ws + WS_LA2), 0, gw, NGW, (1936 + 512 + 4096 + 16) % NGW);
    transpose_w(cx, p.in[20] + (size_t)l * 128 * 512, 128, 512, (bf16_t*)(ws + WS_LG2), 0, gw, NGW, (1936 + 512 + 4096 + 32) % NGW);
    u32x4* z = (u32x4*)(ws + WS_WIN + (size_t)PTOT * 1024 * 2);
    const u32x4 zero = {0u, 0u, 0u, 0u};
    for (int i = cx.bid * 512 + cx.tid; i < (PJ - PTOT) * 128; i += cx.nb * 512) z[i] = zero;
}

__device__ __forceinline__ void phase_mod0(const Ctx& cx, const Params& p) {
    const int lane = cx.tid & 63;
    const int gw = cx.bid * 8 + (cx.tid >> 6), NGW = cx.nb * 8;
    const float* MOD = (const float*)(p.ws + WS_MOD);
    bf16_t* H = (bf16_t*)(p.ws + WS_H);
#pragma unroll 2
    for (int row = gw; row < NTOK; row += NGW) {
        const float* xr = row < NTP ? p.in[0] + (size_t)row * 1024 : p.in[1] + (size_t)(row - NTP) * 1024;
        const float* md = MOD + (size_t)seq_of_row(row) * 6144;
#pragma unroll
        for (int j = 0; j < 4; ++j) {
            const int col = lane * 4 + 256 * j;
            const f32x4 x = *(const f32x4*)(xr + col), sh = *(const f32x4*)(md + col), scv = *(const f32x4*)(md + 1024 + col);
            u32x2 o; o.x = cvt_pk_bf16(x.x * (1.f + scv.x) + sh.x, x.y * (1.f + scv.y) + sh.y); o.y = cvt_pk_bf16(x.z * (1.f + scv.z) + sh.z, x.w * (1.f + scv.w) + sh.w);
            *(u32x2*)(H + (size_t)row * 1024 + col) = o;
        }
    }
}

__device__ __forceinline__ void phase_ln(const Ctx& cx, const Params& p, const float* lw, const float* lb, const float* modl  , int sh_off, int sc_off, bool final_out) {
    const int lane = cx.tid & 63;
    const int gw = cx.bid * 8 + (cx.tid >> 6), NGW = cx.nb * 8;
    float* X = p.out;
    bf16_t* H = (bf16_t*)(p.ws + WS_H);
#ifndef REP_LN
#define REP_LN 0
#endif
    const bf16_t* V16 = (const bf16_t*)(p.ws + WS_PREP);
    for (int rep = 0; rep <= REP_LN; ++rep) {
    u32x2 nv[4];
#pragma unroll
    for (int j = 0; j < 4; ++j) nv[j] = *(const u32x2*)(V16 + (size_t)(gw < NTOK ? gw : 0) * 1024 + lane * 4 + 256 * j);
    for (int row = gw; row < NTOK; row += NGW) {
        const bool dry = rep < REP_LN;
        float* xr = X + (size_t)row * 1024;
        u32x2 cv[4];
#pragma unroll
        for (int j = 0; j < 4; ++j) cv[j] = nv[j];
        if (row + NGW < NTOK) {
#pragma unroll
            for (int j = 0; j < 4; ++j) nv[j] = *(const u32x2*)(V16 + (size_t)(row + NGW) * 1024 + lane * 4 + 256 * j);
        }
        f32x4 v[4]; float s = 0.f;
#pragma unroll
        for (int j = 0; j < 4; ++j) { const u32x2 w = cv[j]; v[j] = (f32x4){bflo(w.x), bfhi(w.x), bflo(w.y), bfhi(w.y)}; s += (v[j].x + v[j].y) + (v[j].z + v[j].w); }
        const float mean = wave_sum(s) * (1.f / 1024.f); float s2 = 0.f;
#pragma unroll
        for (int j = 0; j < 4; ++j) { v[j] = v[j] - mean; s2 += (v[j].x * v[j].x + v[j].y * v[j].y) + (v[j].z * v[j].z + v[j].w * v[j].w); }
        const float rstd = rsqrtf(wave_sum(s2) * (1.f / 1024.f) + 1e-5f);
        if (dry && rstd != -1.f) continue;
        const float* md = modl ? modl + (size_t)seq_of_row(row) * 6144 : nullptr;
#pragma unroll
        for (int j = 0; j < 4; ++j) {
            const int col = lane * 4 + 256 * j;
            const f32x4 w = *(const f32x4*)(lw + col), b = *(const f32x4*)(lb + col);
            const f32x4 x = v[j] * rstd * w + b;
            if (final_out) *(f32x4*)(xr + col) = x;
            else { u32x2 ox; ox.x = cvt_pk_bf16(x.x, x.y); ox.y = cvt_pk_bf16(x.z, x.w); *(u32x2*)((bf16_t*)X + (size_t)row * 1024 + col) = ox; }
            if (md) {
                const f32x4 sh = *(const f32x4*)(md + sh_off + col), scv = *(const f32x4*)(md + sc_off + col);
                u32x2 o; o.x = cvt_pk_bf16(x.x * (1.f + scv.x) + sh.x, x.y * (1.f + scv.y) + sh.y); o.y = cvt_pk_bf16(x.z * (1.f + scv.z) + sh.z, x.w * (1.f + scv.w) + sh.w);
                *(u32x2*)(H + (size_t)row * 1024 + col) = o;
            }
        }
    }
    }
}

#define LAS __attribute__((address_space(3)))
namespace gm {
constexpr int BM = 256, BK = 64, HALF = 128, HTB = HALF * BK * 2, NXCD = 8, WGM = 8;
__device__ __forceinline__ int lds_byte(int r, int c) { const int st = (r >> 4) * 2 + (c >> 5), rr = r & 15, cc = c & 31, ob = rr * 64 + cc * 2; return st * 1024 + (ob ^ (((ob >> 9) & 1) << 5)); }
__device__ __forceinline__ void stage_rc(int b, int& R, int& C) { const int st = b / 1024, sb = b % 1024, swz = sb ^ (((sb >> 9) & 1) << 5); R = (st >> 1) * 16 + swz / 64; C = (st & 1) * 32 + (swz % 64) / 2; }
__device__ __forceinline__ int perm32(int rho) { const int n = rho >> 4, i = rho & 15; return 8 * (i >> 2) + 4 * n + (i & 3); }
struct Unit { int pm, pn; };
struct Order {
    int nM, nN, nwg, G, c;
    __device__ __forceinline__ bool next(int i, Unit& u) const {
        const long L = (long)i * G + c; if (L >= nwg) return false;
        int wgid = (int)L; { const int q = nwg / NXCD, r = nwg % NXCD, xcd = wgid % NXCD, off = wgid / NXCD; wgid = (xcd < r ? xcd * (q + 1) : r * (q + 1) + (xcd - r) * q) + off; }
        const int nig = WGM * nN, gid = wgid / nig, fm = gid * WGM, gsz = (nM - fm) < WGM ? (nM - fm) : WGM;
        u.pm = fm + ((wgid % nig) % gsz); u.pn = (wgid % nig) / gsz; return true;
    }
};
struct Epi {
    int kind;
    bf16_t* O; int ldo;
    const float* xp; const float* xs; float* X; const float* gate;
    const bf16_t* xb;
};
__device__ __forceinline__ void epilogue(const Epi& E, const f32x4 (&acc)[2][2][4][2], const Unit& u, int wr, int wc, int fr, int fq) {
    const int brow = u.pm * BM, bcol = u.pn * BM;
    if (E.kind == 0) return;
    if (E.kind == 2) {
#pragma unroll
        for (int ai = 0; ai < 2; ++ai)
#pragma unroll
            for (int m = 0; m < 4; ++m) {
                const int row = brow + ai * HALF + wr * 64 + m * 16 + fr;
                const float* xsrc = (row < NTP ? E.xp : E.xs) + (size_t)row * 1024;
                const bf16_t* xb = E.xb + (size_t)row * 1024;
                const float* gt = E.gate + (size_t)seq_of_row(row) * 6144;
                bf16_t* xo = E.O + (size_t)row * 1024;
#pragma unroll
                for (int bj = 0; bj < 2; ++bj) {
                    const int col = bcol + bj * HALF + wc * 32 + fq * 8;
                    f32x4 x0, x1;
                    if (E.xb) { const u32x4 w = *(const u32x4*)(xb + col); x0 = (f32x4){bflo(w.x), bfhi(w.x), bflo(w.y), bfhi(w.y)}; x1 = (f32x4){bflo(w.z), bfhi(w.z), bflo(w.w), bfhi(w.w)}; }
                    else { x0 = *(const f32x4*)(xsrc + col); x1 = *(const f32x4*)(xsrc + col + 4); }
                    const f32x4 g0 = *(const f32x4*)(gt + col), g1 = *(const f32x4*)(gt + col + 4);
                    const f32x4 v0 = x0 * DN_ALPHA + g0 * acc[ai][bj][m][0], v1 = x1 * DN_ALPHA + g1 * acc[ai][bj][m][1];
                    u32x4 o; o.x = cvt_pk_bf16(v0.x, v0.y); o.y = cvt_pk_bf16(v0.z, v0.w); o.z = cvt_pk_bf16(v1.x, v1.y); o.w = cvt_pk_bf16(v1.z, v1.w);
                    *(u32x4*)(xo + col) = o;
                }
            }
    } else {
        const bool sq = (E.kind == 3);
#pragma unroll
        for (int ai = 0; ai < 2; ++ai)
#pragma unroll
            for (int m = 0; m < 4; ++m) {
                const int row = brow + ai * HALF + wr * 64 + m * 16 + fr;
                bf16_t* orow = E.O + (size_t)row * E.ldo;
#pragma unroll
                for (int bj = 0; bj < 2; ++bj) {
                    const int col = bcol + bj * HALF + wc * 32 + fq * 8;
                    f32x4 v0 = acc[ai][bj][m][0], v1 = acc[ai][bj][m][1];
                    if (sq) {
                        v0.x = fmaxf(v0.x, 0.f); v0.y = fmaxf(v0.y, 0.f); v0.z = fmaxf(v0.z, 0.f); v0.w = fmaxf(v0.w, 0.f); v0 = v0 * v0;
                        v1.x = fmaxf(v1.x, 0.f); v1.y = fmaxf(v1.y, 0.f); v1.z = fmaxf(v1.z, 0.f); v1.w = fmaxf(v1.w, 0.f); v1 = v1 * v1;
                    }
                    u32x4 o; o.x = cvt_pk_bf16(v0.x, v0.y); o.y = cvt_pk_bf16(v0.z, v0.w); o.z = cvt_pk_bf16(v1.x, v1.y); o.w = cvt_pk_bf16(v1.z, v1.w);
                    *(u32x4*)(orow + col) = o;
                }
            }
    }
}
}

__device__ __forceinline__ void gemm_phase(const Ctx& cx, const bf16_t* gA, const bf16_t* gBt, int M, int N, int K, const gm::Epi& E) {
    using namespace gm;
    LAS unsigned char* lds = (LAS unsigned char*)smem;
    Order S; S.nM = M / BM; S.nN = N / BM; S.nwg = S.nM * S.nN; S.G = cx.nb; S.c = cx.bid;
    const int tid = cx.tid, wid = __builtin_amdgcn_readfirstlane(tid >> 6), lane = tid & 63, wr = wid >> 2, wc = wid & 3, fr = lane & 15, fq = lane >> 4;
    const int nt = K / BK;
    unsigned voffA[2], voffB[2];
#pragma unroll
    for (int i = 0; i < 2; ++i) { int R, C; stage_rc(tid * 16 + i * 8192, R, C); const int Rb = (R & ~31) + perm32(R & 31);
        voffA[i] = (unsigned)(R * K + C) * 2u; voffB[i] = (unsigned)(Rb * K + C) * 2u; }
    const size_t kstep = (size_t)(BK * 2);
    const size_t hstep = (size_t)HALF * K * 2;
    const size_t tstep = 2 * hstep;
    const unsigned ldsw = (unsigned)wid * 1024u;
    const int aoff = lds_byte(wr * 64 + fr, fq * 8), boff = lds_byte(wc * 32 + fr, fq * 8);
#define PG8_SA(b, h) (((b) * 2 + (h)) * HTB)
#define PG8_SB(b, h) ((4 + (b) * 2 + (h)) * HTB)
#define PG8_STAGE(bufoff, gbase, voff) do { _Pragma("unroll") for (int _i = 0; _i < 2; ++_i) \
        __builtin_amdgcn_global_load_lds((const unsigned*)((const char*)(gbase) + (voff)[_i]), (LAS unsigned*)(lds + (bufoff) + ldsw + _i * 8192), 16, 0, 0); } while (0)
#define PG8_LDA(dst, b, h) do { _Pragma("unroll") for (int m = 0; m < 4; ++m) _Pragma("unroll") for (int k = 0; k < 2; ++k) dst[m][k] = *(const LAS bf16x8*)(lds + PG8_SA(b, h) + aoff + m * 2048 + k * 1024); } while (0)
#define PG8_LDB(dst, b, h) do { _Pragma("unroll") for (int n = 0; n < 2; ++n) _Pragma("unroll") for (int k = 0; k < 2; ++k) dst[n][k] = *(const LAS bf16x8*)(lds + PG8_SB(b, h) + boff + n * 2048 + k * 1024); } while (0)
#define PG8_MMA(ai, bj, At, Bt) do { __builtin_amdgcn_s_setprio(1); _Pragma("unroll") for (int m = 0; m < 4; ++m) _Pragma("unroll") for (int n = 0; n < 2; ++n) _Pragma("unroll") for (int k = 0; k < 2; ++k) \
        acc[ai][bj][m][n] = __builtin_amdgcn_mfma_f32_16x16x32_bf16(Bt[n][k], At[m][k], acc[ai][bj][m][n], 0, 0, 0); __builtin_amdgcn_s_setprio(0); } while (0)
#define PG8_WAIT_V(n) asm volatile("s_waitcnt vmcnt(" #n ")" ::: "memory")
#define PG8_WAIT_L(n) asm volatile("s_waitcnt lgkmcnt(" #n ")" ::: "memory")
#define PG8_BAR __builtin_amdgcn_s_barrier()
#define PG8_SCHED __builtin_amdgcn_sched_barrier(0)
    Unit cur, nxt; int ui = 0;
    if (S.next(0, cur)) {
    f32x4 acc[2][2][4][2];
#pragma unroll
    for (int a = 0; a < 2; ++a)
#pragma unroll
        for (int b = 0; b < 2; ++b)
#pragma unroll
            for (int m = 0; m < 4; ++m)
#pragma unroll
                for (int n = 0; n < 2; ++n) acc[a][b][m][n] = (f32x4){0.f, 0.f, 0.f, 0.f};
    bf16x8 At[4][2], B0[2][2], B1[2][2];
    const char* cA = (const char*)gA + (size_t)cur.pm * tstep; const char* cB = (const char*)gBt + (size_t)cur.pn * tstep;
    PG8_STAGE(PG8_SB(0, 0), cB, voffB); PG8_STAGE(PG8_SB(0, 1), cB + hstep, voffB); PG8_STAGE(PG8_SA(0, 0), cA, voffA); PG8_STAGE(PG8_SA(0, 1), cA + hstep, voffA);
    if (wr == 1) PG8_BAR;
    PG8_WAIT_V(2); PG8_BAR;
    PG8_STAGE(PG8_SB(1, 0), cB + kstep, voffB); PG8_STAGE(PG8_SA(1, 0), cA + kstep, voffA); PG8_STAGE(PG8_SB(1, 1), cB + hstep + kstep, voffB);
    PG8_WAIT_V(6); PG8_BAR;
    for (;;) {
        const bool has_next = S.next(ui + 1, nxt);
        const char* nA = has_next ? (const char*)gA + (size_t)nxt.pm * tstep : cA; const char* nB = has_next ? (const char*)gBt + (size_t)nxt.pn * tstep : cB;
        for (int t = 0; t < nt; t += 2) {
            const bool last = (t == nt - 2);
            const char* a1 = cA + (size_t)(t + 1) * kstep;
            const char* a2 = last ? nA : cA + (size_t)(t + 2) * kstep; const char* b2 = last ? nB : cB + (size_t)(t + 2) * kstep;
            const char* a3 = a2 + kstep; const char* b3 = b2 + kstep;
            PG8_LDB(B0, 0, 0); PG8_LDB(B1, 0, 1); PG8_SCHED; PG8_LDA(At, 0, 0); PG8_STAGE(PG8_SA(1, 1), a1 + hstep, voffA);
            PG8_WAIT_V(8); PG8_WAIT_L(0); PG8_BAR; PG8_MMA(0, 0, At, B0); PG8_MMA(0, 1, At, B1); PG8_BAR; PG8_SCHED;
            PG8_LDA(At, 0, 1); PG8_STAGE(PG8_SB(0, 0), b2, voffB); PG8_STAGE(PG8_SB(0, 1), b2 + hstep, voffB); PG8_STAGE(PG8_SA(0, 0), a2, voffA);
            PG8_WAIT_V(8); PG8_WAIT_L(0); PG8_BAR; PG8_MMA(1, 0, At, B0); PG8_MMA(1, 1, At, B1); PG8_BAR; PG8_SCHED;
            PG8_LDB(B0, 1, 0); PG8_LDB(B1, 1, 1); PG8_SCHED; PG8_LDA(At, 1, 0); PG8_STAGE(PG8_SA(0, 1), a2 + hstep, voffA);
            PG8_WAIT_V(8); PG8_WAIT_L(0); PG8_BAR; PG8_MMA(0, 0, At, B0); PG8_MMA(0, 1, At, B1); PG8_BAR; PG8_SCHED;
            PG8_LDA(At, 1, 1); PG8_STAGE(PG8_SB(1, 0), b3, voffB); PG8_STAGE(PG8_SB(1, 1), b3 + hstep, voffB); PG8_STAGE(PG8_SA(1, 0), a3, voffA);
            PG8_WAIT_V(8); PG8_WAIT_L(0); PG8_BAR; PG8_MMA(1, 0, At, B0); PG8_MMA(1, 1, At, B1); PG8_BAR; PG8_SCHED;
        }
        if (wr == 0) PG8_BAR;
        epilogue(E, acc, cur, wr, wc, fr, fq);
        if (!has_next) break;
#pragma unroll
        for (int a = 0; a < 2; ++a)
#pragma unroll
            for (int b = 0; b < 2; ++b)
#pragma unroll
                for (int m = 0; m < 4; ++m)
#pragma unroll
                    for (int n = 0; n < 2; ++n) acc[a][b][m][n] = (f32x4){0.f, 0.f, 0.f, 0.f};
        cur = nxt; cA = nA; cB = nB; ++ui;
        if (wr == 1) PG8_BAR;
    }
    PG8_WAIT_V(0);
    PG8_BAR;
    }
#undef PG8_SA
#undef PG8_SB
#undef PG8_STAGE
#undef PG8_LDA
#undef PG8_LDB
#undef PG8_MMA
}

__device__ __forceinline__ void tri_inv64(const float* AM, float* TF, float* WSB, int tid) {
    const int lane = tid & 63, wave = tid >> 6;
    if (wave == 0) {
        const int bb = lane >> 4, cc = lane & 15;
        const float* Ab = AM + (16 * bb) * 68 + 16 * bb;
        float x[16];
#pragma unroll
        for (int i = 0; i < 16; ++i) {
            float a = (i == cc) ? 1.f : 0.f;
#pragma unroll
            for (int j = 0; j < i; ++j) a -= Ab[i * 68 + j] * x[j];
            x[i] = a;
            TF[(16 * bb + i) * 68 + 16 * bb + cc] = a;
        }
    }
    __syncthreads();
    {
        const int g = tid >> 8, i = (tid >> 4) & 15, c = tid & 15, o = 32 * g;
        const float* ar = AM + (o + 16 + i) * 68 + o;
        float acc = 0.f;
#pragma unroll
        for (int k = 0; k < 16; ++k) acc += ar[k] * TF[(o + k) * 68 + o + c];
        WSB[(o + 16 + i) * 68 + o + c] = acc;
        __syncthreads();
        const float* dr = TF + (o + 16 + i) * 68 + o + 16;
        acc = 0.f;
#pragma unroll
        for (int k = 0; k < 16; ++k) acc += dr[k] * WSB[(o + 16 + k) * 68 + o + c];
        TF[(o + 16 + i) * 68 + o + c] = -acc;
    }
    __syncthreads();
    {
        const int i = tid >> 4, c = tid & 15;
        const float* ar = AM + (32 + i) * 68;
        float a0 = 0.f, a1 = 0.f;
#pragma unroll
        for (int k = 0; k < 16; ++k) a0 += ar[k] * TF[k * 68 + c];
#pragma unroll
        for (int k = 16; k < 32; ++k) { const float av = ar[k]; a0 += av * TF[k * 68 + c]; a1 += av * TF[k * 68 + 16 + c]; }
        WSB[(32 + i) * 68 + c] = a0; WSB[(32 + i) * 68 + 16 + c] = a1;
        __syncthreads();
        const float* dr = TF + (32 + i) * 68 + 32;
        a0 = 0.f; a1 = 0.f;
#pragma unroll
        for (int k = 0; k < 16; ++k) { const float dv = dr[k]; a0 += dv * WSB[(32 + k) * 68 + c]; a1 += dv * WSB[(32 + k) * 68 + 16 + c]; }
        if (i >= 16) {
#pragma unroll
            for (int k = 16; k < 32; ++k) { const float dv = dr[k]; a0 += dv * WSB[(32 + k) * 68 + c]; a1 += dv * WSB[(32 + k) * 68 + 16 + c]; }
        }
        TF[(32 + i) * 68 + c] = -a0; TF[(32 + i) * 68 + 16 + c] = -a1;
    }
}
__device__ __forceinline__ int swz_el(int row, int t) { return row * 72 + ((((t >> 3) ^ (row >> 3)) & 7) << 3) + (t & 7); }
__device__ __forceinline__ int swz_ch(int row, int c8) { return row * 72 + (((c8 ^ (row >> 3)) & 7) << 3); }

__device__ __forceinline__ void phase_gdn_prep(const Ctx& cx, const Params& p, int l) {
    const int tid = cx.tid, lane = tid & 63, wave = tid >> 6, fr = lane & 15, fq = lane >> 4;
    bf16_t* QN = (bf16_t*)(smem);
    bf16_t* KN = (bf16_t*)(smem + 17408);
    bf16_t* KBG = (bf16_t*)(smem + 34816);
    bf16_t* VB = (bf16_t*)(smem + 53248);
    float* AM = (float*)(smem + 71680);
    bf16_t* TM = (bf16_t*)(smem + 89088);
    float* GV = (float*)(smem + 98304);
    float* TF = (float*)(smem + 99328);
    float* WSB = (float*)(smem + 116736);
    const bf16_t* PROJ = (const bf16_t*)(p.ws + WS_R1);
    bf16_t* PREP = (bf16_t*)(p.ws + WS_PREP);
    float* DL = (float*)(p.ws + WS_DL);
    const float* convw = p.in[11] + (size_t)l * 4 * 1536;
    const float* conv_state = p.in[5];
#ifndef REP_PREP
#define REP_PREP 1
#endif
    for (int rep = 0; rep < REP_PREP; ++rep)
    for (int u = cx.bid; u < 2080; u += cx.nb) {
        const int c = u >> 2, h = u & 3, t0 = c * 64;
        const bool prompt = c < 512;
        const bool first = prompt ? ((c & 31) == 0) : true;
        const int sb = prompt ? 0 : (c - 512);
        bf16_t* P = PREP + (size_t)u * PREP_STRIDE;
#pragma unroll 1
        for (int pb = 0; pb < 2; ++pb) {
        u32x4 rawc[3][4];
#pragma unroll
        for (int pi = 0; pi < 3; ++pi) {
            const int ps = pb * 3 + pi;
            const int t = (ps & 1) * 32 + wave * 4 + fq, ch0 = (ps >> 1) * 512 + h * 128 + fr * 8;
#pragma unroll
            for (int j = 0; j < 4; ++j) { const int tt = t - 3 + j; rawc[pi][j] = *(const u32x4*)(PROJ + (size_t)(t0 + ((tt >= 0 || !first) ? tt : 0)) * PJ + ch0); }
        }
        if (pb == 0) {
        if (tid < 64) {
                const float ga = bf2f(PROJ[(size_t)(t0 + tid) * PJ + C_GA + h]), gb = bf2f(PROJ[(size_t)(t0 + tid) * PJ + C_GB + h]);
                float g = -__expf(p.in[12][l * 4 + h]) * softplus_f(ga + p.in[13][l * 4 + h]);
                GV[64 + tid] = sigmoid_f(gb);
#pragma unroll
                for (int off = 1; off < 64; off <<= 1) { const float o = __shfl_up(g, off); g += (tid >= off) ? o : 0.f; }
                GV[tid] = g;
            }
            __syncthreads();
        }
#pragma unroll
        for (int pi = 0; pi < 3; ++pi) {
            const int ps = pb * 3 + pi;
            const int kind = ps >> 1, t = (ps & 1) * 32 + wave * 4 + fq, cgp = fr;
            const int ch0 = kind * 512 + h * 128 + cgp * 8;
            float y[8];
#pragma unroll
            for (int e = 0; e < 8; ++e) y[e] = 0.f;
#pragma unroll
            for (int j = 0; j < 4; ++j) {
                const int tt = t - 3 + j;
                float x[8];
                if (tt >= 0 || !first) {
                    unpack8(rawc[pi][j], x);
                } else if (!prompt) {
                    const float* cs = conv_state + ((size_t)(l * 8 + sb) * 3 + (tt + 3)) * 1536 + ch0;
                    const f32x4 a = *(const f32x4*)cs, b = *(const f32x4*)(cs + 4);
                    x[0] = a.x; x[1] = a.y; x[2] = a.z; x[3] = a.w; x[4] = b.x; x[5] = b.y; x[6] = b.z; x[7] = b.w;
                } else {
#pragma unroll
                    for (int e = 0; e < 8; ++e) x[e] = 0.f;
                }
                const f32x4 w0 = *(const f32x4*)(convw + j * 1536 + ch0), w1 = *(const f32x4*)(convw + j * 1536 + ch0 + 4);
                y[0] += x[0] * w0.x; y[1] += x[1] * w0.y; y[2] += x[2] * w0.z; y[3] += x[3] * w0.w;
                y[4] += x[4] * w1.x; y[5] += x[5] * w1.y; y[6] += x[6] * w1.z; y[7] += x[7] * w1.w;
            }
            float ss = 0.f;
#pragma unroll
            for (int e = 0; e < 8; ++e) { y[e] = silu_f(y[e]); ss += y[e] * y[e]; }
            const float gt = GV[t], bt = GV[64 + t];
            if (kind == 0) {
                ss = red16(ss);
                const float rn = rsqrtf(ss + 1e-6f) * 0.08838834764831845f;
                float q[8], qd[8]; const float eg = __expf(gt);
#pragma unroll
                for (int e = 0; e < 8; ++e) { q[e] = y[e] * rn; qd[e] = q[e] * eg; }
                *(u32x4*)(QN + t * 136 + cgp * 8) = pack8(q);
                *(u32x4*)(P + PO_QD + t * 128 + cgp * 8) = pack8(qd);
            } else if (kind == 1) {
                ss = red16(ss);
                const float rn = rsqrtf(ss + 1e-6f);
                float k[8]; const float sc2 = bt * __expf(gt);
#pragma unroll
                for (int e = 0; e < 8; ++e) { k[e] = y[e] * rn; KBG[swz_el(cgp * 8 + e, t)] = f2bf(k[e] * sc2); }
                *(u32x4*)(KN + t * 136 + cgp * 8) = pack8(k);
            } else {
#pragma unroll
                for (int e = 0; e < 8; ++e) VB[swz_el(cgp * 8 + e, t)] = f2bf(y[e] * bt);
            }
        }
        }
        __syncthreads();
        const float g_last = GV[63];
        if (h == 0 && (!prompt || (c & 31) == 31)) {
            float* co = p.out + (prompt ? O_PCONV + (size_t)(l * 16 + (c >> 5)) * 4608 : O_SCONV + (size_t)(l * 8 + sb) * 4608);
            for (int i = tid; i < 4608; i += 512) { const int r = i / 1536, ch = i % 1536; co[i] = bf2f(PROJ[(size_t)(t0 + 61 + r) * PJ + ch]); }
        }
        {
            const int d = tid >> 2, tq = tid & 3;
            float v[16];
#pragma unroll
            for (int i = 0; i < 16; ++i) { const int t = tq * 16 + i; v[i] = bf2f(KN[t * 136 + d]) * __expf(g_last - GV[t]); }
            *(u32x4*)(P + PO_KDT + d * 64 + tq * 16) = pack8(v);
            *(u32x4*)(P + PO_KDT + d * 64 + tq * 16 + 8) = pack8(v + 8);
        }
#pragma unroll
        for (int q = 0; q < 2; ++q) {
            const int tile = wave * 2 + q, tm = tile >> 2, tn = tile & 3;
            f32x4 akk = {0.f, 0.f, 0.f, 0.f}, aqk = {0.f, 0.f, 0.f, 0.f};
#pragma unroll
            for (int kk = 0; kk < 4; ++kk) {
                const bf16x8 ka = *(const bf16x8*)(KN + (tm * 16 + fr) * 136 + kk * 32 + fq * 8);
                const bf16x8 kb = *(const bf16x8*)(KN + (tn * 16 + fr) * 136 + kk * 32 + fq * 8);
                const bf16x8 qb = *(const bf16x8*)(QN + (tn * 16 + fr) * 136 + kk * 32 + fq * 8);
                akk = __builtin_amdgcn_mfma_f32_16x16x32_bf16(ka, kb, akk, 0, 0, 0);
                aqk = __builtin_amdgcn_mfma_f32_16x16x32_bf16(ka, qb, aqk, 0, 0, 0);
            }
            {
                const int i = tn * 16 + fr; const float gi = GV[i];
#pragma unroll
                for (int j = 0; j < 4; ++j) { const int t = tm * 16 + fq * 4 + j; AM[t * 68 + i] = (t > i) ? GV[64 + t] * akk[j] * __expf(GV[t] - gi) : 0.f; }
            }
            {
                const int t = tn * 16 + fr; const float gtt = GV[t]; float o[4];
#pragma unroll
                for (int j = 0; j < 4; ++j) { const int i = tm * 16 + fq * 4 + j; o[j] = (t >= i) ? aqk[j] * __expf(gtt - GV[i]) : 0.f; }
                u32x2 w; w.x = cvt_pk_bf16(o[0], o[1]); w.y = cvt_pk_bf16(o[2], o[3]);
                *(u32x2*)(P + PO_QK + t * 64 + tm * 16 + fq * 4) = w;
            }
        }
        __syncthreads();
        tri_inv64(AM, TF, WSB, tid);
        __syncthreads();
        for (int e = tid; e < 4096; e += 512) {
            const int i = e >> 6, cc = e & 63;
            TM[i * 72 + cc] = ((cc >> 4) <= (i >> 4)) ? f2bf(TF[i * 68 + cc]) : (bf16_t)0;
        }
        if (tid == 64) DL[u] = __expf(g_last);
        __syncthreads();
        {
            const int tm = wave & 3, vh = wave >> 2;
            bf16x8 ta[2];
#pragma unroll
            for (int kk = 0; kk < 2; ++kk) ta[kk] = *(const bf16x8*)(TM + (tm * 16 + fr) * 72 + kk * 32 + fq * 8);
#pragma unroll
            for (int n = 0; n < 4; ++n) {
                const int v = (vh * 4 + n) * 16 + fr;
                f32x4 a = {0.f, 0.f, 0.f, 0.f};
#pragma unroll
                for (int kk = 0; kk < 2; ++kk) a = __builtin_amdgcn_mfma_f32_16x16x32_bf16(ta[kk], *(const bf16x8*)(VB + swz_ch(v, kk * 4 + fq)), a, 0, 0, 0);
                u32x2 w; w.x = cvt_pk_bf16(a[0], a[1]); w.y = cvt_pk_bf16(a[2], a[3]);
                *(u32x2*)(P + PO_U0T + v * 64 + tm * 16 + fq * 4) = w;
            }
            bf16x8 ka[2];
#pragma unroll
            for (int kk = 0; kk < 2; ++kk) ka[kk] = *(const bf16x8*)(KBG + swz_ch(wave * 16 + fr, kk * 4 + fq));
#pragma unroll
            for (int tn = 0; tn < 4; ++tn) {
                f32x4 a = {0.f, 0.f, 0.f, 0.f};
#pragma unroll
                for (int kk = 0; kk < 2; ++kk) a = __builtin_amdgcn_mfma_f32_16x16x32_bf16(ka[kk], *(const bf16x8*)(TM + (tn * 16 + fr) * 72 + kk * 32 + fq * 8), a, 0, 0, 0);
                u32x2 w; w.x = cvt_pk_bf16(-a[0], -a[1]); w.y = cvt_pk_bf16(-a[2], -a[3]);
                *(u32x2*)(P + PO_WKN + (tn * 16 + fr) * 128 + wave * 16 + fq * 4) = w;
            }
        }
        __syncthreads();
    }
}

__device__ __forceinline__ void gdn_scan_unit(const Ctx& cx, const Params& p, int l, int seq, int h) {
    const int tid = cx.tid, lane = tid & 63, wave = tid >> 6, fr = lane & 15, fq = lane >> 4;
    bf16_t* ST = (bf16_t*)(smem);
    bf16_t* UT = (bf16_t*)(smem + 34816);
    float* OB = (float*)(smem + 53248);
    const bf16_t* PROJ = (const bf16_t*)(p.ws + WS_R1);
    const bf16_t* PREP = (const bf16_t*)(p.ws + WS_PREP);
    const float* DL = (const float*)(p.ws + WS_DL);
    bf16_t* YIN = (bf16_t*)(p.ws + WS_H);
    const bool prompt = seq < 16;
    const int b = prompt ? seq : seq - 16;
    const int nch = prompt ? 32 : 1;
    const float* nw = p.in[14] + l * 128;
    f32x4 S[8];
    if (prompt) {
#pragma unroll
        for (int n = 0; n < 8; ++n) S[n] = (f32x4){0.f, 0.f, 0.f, 0.f};
    } else {
        const float* s0 = p.in[4] + ((size_t)(l * 8 + b) * 4 + h) * 16384;
#pragma unroll
        for (int n = 0; n < 8; ++n)
#pragma unroll
            for (int j = 0; j < 4; ++j) S[n][j] = s0[(wave * 16 + fq * 4 + j) * 128 + n * 16 + fr];
    }
#pragma unroll
    for (int n = 0; n < 8; ++n) { u32x2 w; w.x = cvt_pk_bf16(S[n][0], S[n][1]); w.y = cvt_pk_bf16(S[n][2], S[n][3]); *(u32x2*)(ST + (n * 16 + fr) * 136 + wave * 16 + fq * 4) = w; }
    __syncthreads();
    const int tm = wave & 3, vh = wave >> 2;
#pragma unroll 1
    for (int ci = 0; ci < nch; ++ci) {
        const int c = prompt ? seq * 32 + ci : 512 + b;
        const int u = c * 4 + h, t0 = c * 64;
        const bf16_t* P = PREP + (size_t)u * PREP_STRIDE;
        bf16x8 wkn[4], qd[4], qk[2], kdt[2];
#pragma unroll
        for (int kk = 0; kk < 4; ++kk) { wkn[kk] = *(const bf16x8*)(P + PO_WKN + (tm * 16 + fr) * 128 + kk * 32 + fq * 8); qd[kk] = *(const bf16x8*)(P + PO_QD + (tm * 16 + fr) * 128 + kk * 32 + fq * 8); }
#pragma unroll
        for (int kk = 0; kk < 2; ++kk) { qk[kk] = *(const bf16x8*)(P + PO_QK + (tm * 16 + fr) * 64 + kk * 32 + fq * 8); kdt[kk] = *(const bf16x8*)(P + PO_KDT + (wave * 16 + fr) * 64 + kk * 32 + fq * 8); }
        f32x4 U[4], O[4];
#pragma unroll
        for (int n = 0; n < 4; ++n) {
            const u32x2 w = *(const u32x2*)(P + PO_U0T + ((vh * 4 + n) * 16 + fr) * 64 + tm * 16 + fq * 4);
            U[n] = (f32x4){bflo(w.x), bfhi(w.x), bflo(w.y), bfhi(w.y)};
            O[n] = (f32x4){0.f, 0.f, 0.f, 0.f};
        }
        const float dl = DL[u];
#pragma unroll
        for (int kk = 0; kk < 4; ++kk)
#pragma unroll
            for (int n = 0; n < 4; ++n) {
                const bf16x8 sf = *(const bf16x8*)(ST + ((vh * 4 + n) * 16 + fr) * 136 + kk * 32 + fq * 8);
                U[n] = __builtin_amdgcn_mfma_f32_16x16x32_bf16(wkn[kk], sf, U[n], 0, 0, 0);
                O[n] = __builtin_amdgcn_mfma_f32_16x16x32_bf16(qd[kk], sf, O[n], 0, 0, 0);
            }
#pragma unroll
        for (int n = 0; n < 4; ++n) { u32x2 w; w.x = cvt_pk_bf16(U[n][0], U[n][1]); w.y = cvt_pk_bf16(U[n][2], U[n][3]); *(u32x2*)(UT + ((vh * 4 + n) * 16 + fr) * 72 + tm * 16 + fq * 4) = w; }
        __syncthreads();
#pragma unroll
        for (int kk = 0; kk < 2; ++kk)
#pragma unroll
            for (int n = 0; n < 4; ++n) O[n] = __builtin_amdgcn_mfma_f32_16x16x32_bf16(qk[kk], *(const bf16x8*)(UT + ((vh * 4 + n) * 16 + fr) * 72 + kk * 32 + fq * 8), O[n], 0, 0, 0);
#pragma unroll
        for (int n = 0; n < 8; ++n) {
            S[n] = S[n] * dl;
#pragma unroll
            for (int kk = 0; kk < 2; ++kk) S[n] = __builtin_amdgcn_mfma_f32_16x16x32_bf16(kdt[kk], *(const bf16x8*)(UT + (n * 16 + fr) * 72 + kk * 32 + fq * 8), S[n], 0, 0, 0);
        }
        __syncthreads();
#pragma unroll
        for (int n = 0; n < 8; ++n) { u32x2 w; w.x = cvt_pk_bf16(S[n][0], S[n][1]); w.y = cvt_pk_bf16(S[n][2], S[n][3]); *(u32x2*)(ST + (n * 16 + fr) * 136 + wave * 16 + fq * 4) = w; }
#pragma unroll
        for (int n = 0; n < 4; ++n)
#pragma unroll
            for (int j = 0; j < 4; ++j) OB[(tm * 16 + fq * 4 + j) * 132 + (vh * 4 + n) * 16 + fr] = O[n][j];
        __syncthreads();
        {
            const int t = tid >> 3, part = tid & 7;
            float o[16]; float ss = 0.f;
#pragma unroll
            for (int q = 0; q < 4; ++q) { const f32x4 v = *(const f32x4*)(OB + t * 132 + part * 16 + q * 4); o[4 * q] = v.x; o[4 * q + 1] = v.y; o[4 * q + 2] = v.z; o[4 * q + 3] = v.w; ss += v.x * v.x + v.y * v.y + v.z * v.z + v.w * v.w; }
            ss = red8(ss);
            const float rstd = rsqrtf(ss * (1.f / 128.f) + 1e-6f);
            const bf16_t* zp = PROJ + (size_t)(t0 + t) * PJ + C_Z + h * 128 + part * 16;
            float z[16]; unpack8(*(const u32x4*)zp, z); unpack8(*(const u32x4*)(zp + 8), z + 8);
#pragma unroll
            for (int e = 0; e < 16; ++e) o[e] = o[e] * rstd * nw[part * 16 + e] * silu_f(z[e]);
            bf16_t* yp = YIN + (size_t)(t0 + t) * 1024 + h * 128 + part * 16;
            *(u32x4*)yp = pack8(o); *(u32x4*)(yp + 8) = pack8(o + 8);
        }
    }
    {
        float* so = p.out + (prompt ? O_PGDN + ((size_t)(l * 16 + b) * 4 + h) * 16384 : O_SGDN + ((size_t)(l * 8 + b) * 4 + h) * 16384);
#pragma unroll
        for (int n = 0; n < 8; ++n)
#pragma unroll
            for (int j = 0; j < 4; ++j) so[(wave * 16 + fq * 4 + j) * 128 + n * 16 + fr] = S[n][j];
    }
    __syncthreads();
}

__device__ __forceinline__ void phase_rwkv_prep(const Ctx& cx, const Params& p, int l) {
    const int tid = cx.tid, lane = tid & 63, wave = tid >> 6, fr = lane & 15, fq = lane >> 4;
    bf16_t* XW = (bf16_t*)(smem);
    bf16_t* XA = (bf16_t*)(smem + 9216);
    bf16_t* XG = (bf16_t*)(smem + 18432);
    bf16_t* PROJ = (bf16_t*)(p.ws + WS_R1);
    const bf16_t* LW2 = (const bf16_t*)(p.ws + WS_LW2); const bf16_t* LA2 = (const bf16_t*)(p.ws + WS_LA2); const bf16_t* LG2 = (const bf16_t*)(p.ws + WS_LG2);
    const float* mu = p.in[15] + l * RWP;
#ifndef REP_RP
#define REP_RP 1
#endif
    for (int rep = 0; rep < REP_RP; ++rep)
    for (int c = cx.bid; c < 520; c += cx.nb) {
        const int t0 = c * 64;
        const bool prompt = c < 512;
        const bool first = prompt ? ((c & 31) == 0) : true;
        const float* shift_state = p.in[7] + (size_t)(l * 8 + (prompt ? 0 : c - 512)) * RWP;
        {
            const int t = tid >> 3, part = tid & 7;
#pragma unroll
            for (int q = 0; q < 4; ++q) {
                const int cl = part * 32 + q * 8;
                const int idx0 = 1536 + cl;
                float cur[8], prv[8], o[8];
                unpack8(*(const u32x4*)(PROJ + (size_t)(t0 + t) * PJ + C_RW + idx0), cur);
                if (t > 0 || !first) unpack8(*(const u32x4*)(PROJ + (size_t)(t0 + t - 1) * PJ + C_RW + idx0), prv);
                else if (!prompt) {
#pragma unroll
                    for (int e = 0; e < 8; ++e) prv[e] = shift_state[idx0 + e];
                } else {
#pragma unroll
                    for (int e = 0; e < 8; ++e) prv[e] = 0.f;
                }
#pragma unroll
                for (int e = 0; e < 8; ++e) {
                    const float x = cur[e] + (prv[e] - cur[e]) * mu[idx0 + e];
                    o[e] = cl < 64 ? tanh_f(x) : (cl < 128 ? x : sigmoid_f(x));
                }
                bf16_t* dst = cl < 64 ? XW + t * 72 + cl : (cl < 128 ? XA + t * 72 + (cl - 64) : XG + t * 136 + (cl - 128));
                *(u32x4*)dst = pack8(o);
            }
        }
        __syncthreads();
#pragma unroll 1
        for (int cp = 0; cp < 2; ++cp) {
            const int cb = wave * 64 + cp * 32;
            bf16x8 bw[2][2], ba[2][2], bg[2][4];
#pragma unroll
            for (int n = 0; n < 2; ++n) {
                const int nrow = cb + 8 * (fr >> 2) + 4 * n + (fr & 3);
#pragma unroll
                for (int kk = 0; kk < 2; ++kk) { bw[n][kk] = *(const bf16x8*)(LW2 + nrow * 64 + kk * 32 + fq * 8); ba[n][kk] = *(const bf16x8*)(LA2 + nrow * 64 + kk * 32 + fq * 8); }
#pragma unroll
                for (int kk = 0; kk < 4; ++kk) bg[n][kk] = *(const bf16x8*)(LG2 + nrow * 128 + kk * 32 + fq * 8);
            }
            const int ch = cb + 8 * fq;
            f32x4 w0[2], a0[2];
#pragma unroll
            for (int n = 0; n < 2; ++n) { w0[n] = *(const f32x4*)(p.in[16] + l * 512 + ch + 4 * n); a0[n] = *(const f32x4*)(p.in[18] + l * 512 + ch + 4 * n); }
#pragma unroll 1
            for (int tm = 0; tm < 4; ++tm) {
                f32x4 dw[2], da[2], dg[2];
#pragma unroll
                for (int n = 0; n < 2; ++n) { dw[n] = (f32x4){0.f, 0.f, 0.f, 0.f}; da[n] = dw[n]; dg[n] = dw[n]; }
#pragma unroll
                for (int kk = 0; kk < 2; ++kk) {
                    const bf16x8 xw = *(const bf16x8*)(XW + (tm * 16 + fr) * 72 + kk * 32 + fq * 8), xa = *(const bf16x8*)(XA + (tm * 16 + fr) * 72 + kk * 32 + fq * 8);
#pragma unroll
                    for (int n = 0; n < 2; ++n) { dw[n] = __builtin_amdgcn_mfma_f32_16x16x32_bf16(bw[n][kk], xw, dw[n], 0, 0, 0); da[n] = __builtin_amdgcn_mfma_f32_16x16x32_bf16(ba[n][kk], xa, da[n], 0, 0, 0); }
                }
#pragma unroll
                for (int kk = 0; kk < 4; ++kk) {
                    const bf16x8 xg = *(const bf16x8*)(XG + (tm * 16 + fr) * 136 + kk * 32 + fq * 8);
#pragma unroll
                    for (int n = 0; n < 2; ++n) dg[n] = __builtin_amdgcn_mfma_f32_16x16x32_bf16(bg[n][kk], xg, dg[n], 0, 0, 0);
                }
                float dv[8], av[8];
#pragma unroll
                for (int n = 0; n < 2; ++n)
#pragma unroll
                    for (int j = 0; j < 4; ++j) {
                        dv[4 * n + j] = __expf(-softplus_f(-(w0[n][j] + dw[n][j])) - 0.5f);
                        av[4 * n + j] = sigmoid_f(a0[n][j] + da[n][j]);
                    }
                bf16_t* orow = PROJ + (size_t)(t0 + tm * 16 + fr) * PJ + ch;
                *(u32x4*)(orow) = pack8(dv);
                *(u32x4*)(orow + 512) = pack8(av);
                u32x4 og; og.x = cvt_pk_bf16(dg[0][0], dg[0][1]); og.y = cvt_pk_bf16(dg[0][2], dg[0][3]); og.z = cvt_pk_bf16(dg[1][0], dg[1][1]); og.w = cvt_pk_bf16(dg[1][2], dg[1][3]);
                *(u32x4*)(orow + 1024) = og;
            }
        }
        __syncthreads();
    }
}

__device__ __forceinline__ void rwkv_scan_unit(const Ctx& cx, const Params& p, int l, int seq, int h) {
    const int tid = cx.tid, lane = tid & 63, wave = tid >> 6, fr = lane & 15, fq = lane >> 4;
    float* B0 = (float*)(smem);
    float* B1 = (float*)(smem + 16384);
    float* B2 = (float*)(smem + 32768);
    float* B3 = (float*)(smem + 49152);
    float* B4 = (float*)(smem + 65536);
    float* B5 = (float*)(smem + 81920);
    float* B6 = (float*)(smem + 98304);
    float* B7 = (float*)(smem + 114688);
    float* SCL = (float*)(smem + 131072);
    const bf16_t* PROJ = (const bf16_t*)(p.ws + WS_R1);
    bf16_t* YIN = (bf16_t*)(p.ws + WS_H);
    const bool prompt = seq < 16;
    const int b = prompt ? seq : seq - 16;
    const int nch = prompt ? 32 : 1;
    const float* mu = p.in[15] + l * RWP;
    const float* shift_state = p.in[7] + (size_t)(l * 8 + b) * RWP;
    const int row = tid >> 3, sub = tid & 7;
    const int r0 = tid >> 4, l16 = tid & 15;
    f32x2 S0[2], S1[2];
    if (prompt) {
#pragma unroll
        for (int q = 0; q < 2; ++q) { S0[q] = (f32x2){0.f, 0.f}; S1[q] = (f32x2){0.f, 0.f}; }
    } else {
        const float* s0 = p.in[6] + ((size_t)(l * 8 + b) * 8 + h) * 4096 + l16 * 4;
#pragma unroll
        for (int q = 0; q < 2; ++q) { S0[q] = *(const f32x2*)(s0 + r0 * 64 + 2 * q); S1[q] = *(const f32x2*)(s0 + (r0 + 32) * 64 + 2 * q); }
    }
#pragma unroll 1
    for (int ci = 0; ci < nch; ++ci) {
        const int t0 = prompt ? (seq * 32 + ci) * 64 : NTP + b * 64;
        const bool first = (ci == 0);
        {
            const int t = row, c0 = h * 64 + sub * 8, ch0 = l * 512 + c0;
            const bf16_t* prow = PROJ + (size_t)(t0 + t) * PJ;
            float r[8], k[8], v[8], dd[8], a[8], g[8];
            {
                float cur[8], prv[8];
#pragma unroll
                for (int kind = 0; kind < 3; ++kind) {
                    const int idx0 = kind * 512 + c0;
                    unpack8(*(const u32x4*)(prow + C_RW + idx0), cur);
                    if (t > 0 || !first) unpack8(*(const u32x4*)(prow - PJ + C_RW + idx0), prv);
                    else if (!prompt) {
#pragma unroll
                        for (int e = 0; e < 8; ++e) prv[e] = shift_state[idx0 + e];
                    } else {
#pragma unroll
                        for (int e = 0; e < 8; ++e) prv[e] = 0.f;
                    }
                    float* dst = kind == 0 ? r : (kind == 1 ? k : v);
#pragma unroll
                    for (int e = 0; e < 8; ++e) dst[e] = cur[e] + (prv[e] - cur[e]) * mu[idx0 + e];
                }
            }
            unpack8(*(const u32x4*)(prow + c0), dd); unpack8(*(const u32x4*)(prow + 512 + c0), a); unpack8(*(const u32x4*)(prow + 1024 + c0), g);
            float ss = 0.f, c1 = 0.f, c2 = 0.f, bn = 0.f;
            float kkv[8];
#pragma unroll
            for (int e = 0; e < 8; ++e) { kkv[e] = k[e] * p.in[21][ch0 + e]; ss += kkv[e] * kkv[e]; }
            ss = red8(ss);
            const float rn = rsqrtf(ss + 1e-6f);
#pragma unroll
            for (int e = 0; e < 8; ++e) {
                const float w = __expf(-dd[e]);
                const float kkn = kkv[e] * rn, ka = kkn * a[e];
                const float k2 = k[e] * (1.f + (a[e] - 1.f) * p.in[22][ch0 + e]);
                B6[t * 64 + sub * 8 + e] = kkn; B7[t * 64 + sub * 8 + e] = ka; B1[t * 64 + sub * 8 + e] = k2; B0[t * 64 + sub * 8 + e] = w * r[e];
                B3[t * 64 + sub * 8 + e] = w; B2[t * 64 + sub * 8 + e] = v[e]; B5[t * 64 + sub * 8 + e] = g[e];
                c1 += ka * r[e]; c2 += k2 * r[e]; bn += r[e] * k2 * p.in[23][ch0 + e];
            }
            c1 = red8(c1); c2 = red8(c2); bn = red8(bn);
            if (sub == 0) { SCL[t] = c1; SCL[64 + t] = c2; SCL[128 + t] = bn; }
        }
        __syncthreads();
        {
            const f32x4* KKp = (const f32x4*)(B6 + l16 * 4); const f32x4* WRp = (const f32x4*)(B0 + l16 * 4); const f32x4* Wp = (const f32x4*)(B3 + l16 * 4);
            const f32x4* KAp = (const f32x4*)(B7 + l16 * 4); const f32x4* K2p = (const f32x4*)(B1 + l16 * 4);
#pragma unroll 2
            for (int t = 0; t < 64; ++t) {
                const f32x4 kk4 = KKp[t * 16], wr4 = WRp[t * 16], w4 = Wp[t * 16], ka4 = KAp[t * 16], k24 = K2p[t * 16];
                const f32x2 kk[2] = {{kk4.x, kk4.y}, {kk4.z, kk4.w}}, wrr[2] = {{wr4.x, wr4.y}, {wr4.z, wr4.w}}, ww[2] = {{w4.x, w4.y}, {w4.z, w4.w}};
                const f32x2 ka[2] = {{ka4.x, ka4.y}, {ka4.z, ka4.w}}, k2[2] = {{k24.x, k24.y}, {k24.z, k24.w}};
                const float v0 = B2[t * 64 + r0], v1 = B2[t * 64 + r0 + 32], c1 = SCL[t], c2 = SCL[64 + t];
                f32x2 a0 = S0[0] * kk[0], b0 = S0[0] * wrr[0], a1 = S1[0] * kk[0], b1 = S1[0] * wrr[0];
                a0 = __builtin_elementwise_fma(S0[1], kk[1], a0); b0 = __builtin_elementwise_fma(S0[1], wrr[1], b0);
                a1 = __builtin_elementwise_fma(S1[1], kk[1], a1); b1 = __builtin_elementwise_fma(S1[1], wrr[1], b1);
                float d10 = a0.x + a0.y, d20 = b0.x + b0.y, d11 = a1.x + a1.y, d21 = b1.x + b1.y;
                d10 += dpp_x1(d10); d11 += dpp_x1(d11); d20 += dpp_x1(d20); d21 += dpp_x1(d21);
                d10 += dpp_x2(d10); d11 += dpp_x2(d11); d20 += dpp_x2(d20); d21 += dpp_x2(d21);
                d10 += dpp_hm(d10); d11 += dpp_hm(d11); d20 += dpp_hm(d20); d21 += dpp_hm(d21);
                d10 += dpp_rm(d10); d11 += dpp_rm(d11); d20 += dpp_rm(d20); d21 += dpp_rm(d21);
                const float sa0 = -d10, sa1 = -d11;
                const f32x2 sa02 = {sa0, sa0}, sa12 = {sa1, sa1}, v02 = {v0, v0}, v12 = {v1, v1};
#pragma unroll
                for (int q = 0; q < 2; ++q) {
                    S0[q] = __builtin_elementwise_fma(S0[q], ww[q], __builtin_elementwise_fma(sa02, ka[q], v02 * k2[q]));
                    S1[q] = __builtin_elementwise_fma(S1[q], ww[q], __builtin_elementwise_fma(sa12, ka[q], v12 * k2[q]));
                }
                if (l16 == 0) { B4[t * 64 + r0] = d20 + sa0 * c1 + v0 * c2; B4[t * 64 + r0 + 32] = d21 + sa1 * c1 + v1 * c2; }
            }
        }
        __syncthreads();
        {
            const int t = row, ch0 = l * 512 + h * 64 + sub * 8;
            float o[8]; float s = 0.f;
#pragma unroll
            for (int e = 0; e < 8; ++e) { o[e] = B4[t * 64 + sub * 8 + e]; s += o[e]; }
            const float mean = red8(s) * (1.f / 64.f); float s2 = 0.f;
#pragma unroll
            for (int e = 0; e < 8; ++e) { o[e] -= mean; s2 += o[e] * o[e]; }
            const float rstd = rsqrtf(red8(s2) * (1.f / 64.f) + 64e-5f);
            const float bn = SCL[128 + t];
#pragma unroll
            for (int e = 0; e < 8; ++e) o[e] = (o[e] * rstd * p.in[24][ch0 + e] + p.in[25][ch0 + e] + bn * B2[t * 64 + sub * 8 + e]) * B5[t * 64 + sub * 8 + e];
            *(u32x4*)(YIN + (size_t)(t0 + t) * 1024 + 512 + h * 64 + sub * 8) = pack8(o);
        }
        __syncthreads();
    }
    {
        float* so = p.out + (prompt ? O_PRW + ((size_t)(l * 16 + b) * 8 + h) * 4096 : O_SRW + ((size_t)(l * 8 + b) * 8 + h) * 4096) + l16 * 4;
#pragma unroll
        for (int q = 0; q < 2; ++q) { *(f32x2*)(so + r0 * 64 + 2 * q) = S0[q]; *(f32x2*)(so + (r0 + 32) * 64 + 2 * q) = S1[q]; }
        if (h == 0) {
            const int tlast = prompt ? (seq + 1) * 2048 - 1 : NTP + (b + 1) * 64 - 1;
            float* sh = p.out + (prompt ? O_PSHIFT + (size_t)(l * 16 + b) * RWP : O_SSHIFT + (size_t)(l * 8 + b) * RWP);
            for (int i = tid; i < RWP; i += 512) sh[i] = bf2f(PROJ[(size_t)tlast * PJ + C_RW + i]);
        }
    }
    __syncthreads();
}

__device__ __forceinline__ void rwkv_chunk_unit(const Ctx& cx, const Params& p, int l, int seq, int h) {
    const int tid = cx.tid, lane = tid & 63, wave = tid >> 6, fr = lane & 15, fq = lane >> 4;
    constexpr int MS = 72;
    bf16_t* R0 = (bf16_t*)(smem);
    bf16_t* R2 = (bf16_t*)(smem + 9216);
    bf16_t* R3 = (bf16_t*)(smem + 18432);
    bf16_t* R1 = (bf16_t*)(smem + 27648);
    bf16_t* R4 = (bf16_t*)(smem + 36864);
    bf16_t* R5 = (bf16_t*)(smem + 46080);
    bf16_t* R6 = (bf16_t*)(smem + 55296);
    bf16_t* R7 = (bf16_t*)(smem + 64512);
    bf16_t* R8 = (bf16_t*)(smem + 73728);
    bf16_t* R9 = (bf16_t*)(smem + 82944);
    bf16_t* R10 = (bf16_t*)(smem + 92160);
    bf16_t* PT = (bf16_t*)(smem + 101376);
    float* GA = (float*)(smem + 110592);
    float* OW = (float*)(smem + 128000);
    float* GC = (float*)(smem + 145408);
    float* PRM = (float*)(smem + 145664);
    float* TF = (float*)(smem);
    const bf16_t* PROJ = (const bf16_t*)(p.ws + WS_R1);
    bf16_t* YIN = (bf16_t*)(p.ws + WS_H);
    const bool prompt = seq < 16;
    const int b = prompt ? seq : seq - 16;
    const int nch = prompt ? 32 : 1;
    const float* mu = p.in[15] + l * RWP;
    const float* shift_state = p.in[7] + (size_t)(l * 8 + b) * RWP;
    const int row = tid >> 3, sub = tid & 7;
    const int tm = wave & 3, ih = (wave >> 2) * 2;
    f32x4 Pacc[2];
#pragma unroll
    for (int q = 0; q < 2; ++q) Pacc[q] = (f32x4){0.f, 0.f, 0.f, 0.f};
    if (!prompt) {
        const float* s0 = p.in[6] + ((size_t)(l * 8 + b) * 8 + h) * 4096;
#pragma unroll
        for (int q = 0; q < 2; ++q)
#pragma unroll
            for (int jj = 0; jj < 4; ++jj) Pacc[q][jj] = s0[((ih + q) * 16 + fr) * 64 + tm * 16 + fq * 4 + jj];
    }
#pragma unroll
    for (int q = 0; q < 2; ++q) { u32x2 w; w.x = cvt_pk_bf16(Pacc[q][0], Pacc[q][1]); w.y = cvt_pk_bf16(Pacc[q][2], Pacc[q][3]); *(u32x2*)(PT + ((ih + q) * 16 + fr) * MS + tm * 16 + fq * 4) = w; }
    {
        const int pk = tid >> 6, pc = tid & 63;
        const float* s21 = p.in[21]; const float* s22 = p.in[22]; const float* s23 = p.in[23]; const float* s24 = p.in[24]; const float* s25 = p.in[25];
        const float* src = pk < 3 ? mu + pk * 512 + h * 64 : (pk == 3 ? s21 : (pk == 4 ? s22 : (pk == 5 ? s23 : (pk == 6 ? s24 : s25)))) + l * 512 + h * 64;
        PRM[pk * 64 + pc] = src[pc];
    }
    __syncthreads();
    u32x4 nx[9];
    {
        const int t_ = cx.tid >> 3, c_ = (cx.tid & 7) * 8;
        const int t0_ = prompt ? (seq * 32) * 64 : NTP + b * 64;
        const bf16_t* pr = PROJ + (size_t)(t0_ + t_) * PJ + h * 64 + c_;
        const bf16_t* pp = t_ > 0 ? pr - PJ : pr;
#pragma unroll
        for (int q = 0; q < 3; ++q) { nx[q] = *(const u32x4*)(pr + C_RW + q * 512); nx[3 + q] = *(const u32x4*)(pp + C_RW + q * 512); nx[6 + q] = *(const u32x4*)(pr + q * 512); }
    }
#pragma unroll 1
    for (int ci = 0; ci < nch; ++ci) {
        const int t0 = prompt ? (seq * 32 + ci) * 64 : NTP + b * 64;
        const bool first = (ci == 0);
        int tq = cx.tid; asm volatile("" : "+v"(tq));
        const int tid = tq, lane = tid & 63, wave = tid >> 6, fr = lane & 15, fq = lane >> 4, row = tid >> 3, sub = tid & 7, tm = wave & 3, ih = (wave >> 2) * 2;
        const int t = row, c0 = sub * 8, ch0 = l * 512 + h * 64 + c0;
        float v[8], g[8], bn;
        {
            float r[8], k[8], dd[8], a[8], kkn[8], be[8], k2[8];
            u32x4 raw[9];
#pragma unroll
            for (int q = 0; q < 9; ++q) raw[q] = nx[q];
            if (ci + 1 < nch) {
                const bf16_t* pr = PROJ + (size_t)(t0 + 64 + t) * PJ + h * 64 + c0;
#pragma unroll
                for (int q = 0; q < 3; ++q) { nx[q] = *(const u32x4*)(pr + C_RW + q * 512); nx[3 + q] = *(const u32x4*)(pr - PJ + C_RW + q * 512); nx[6 + q] = *(const u32x4*)(pr + q * 512); }
            }
            {
                float cur[8], prv[8];
#pragma unroll
                for (int kind = 0; kind < 3; ++kind) {
                    const int idx0 = kind * 512 + h * 64 + c0;
                    unpack8(raw[kind], cur);
                    if (t > 0 || !first) unpack8(raw[3 + kind], prv);
                    else if (!prompt) {
#pragma unroll
                        for (int e = 0; e < 8; ++e) prv[e] = shift_state[idx0 + e];
                    } else {
#pragma unroll
                        for (int e = 0; e < 8; ++e) prv[e] = 0.f;
                    }
                    float* dst = kind == 0 ? r : (kind == 1 ? k : v);
#pragma unroll
                    for (int e = 0; e < 8; ++e) dst[e] = cur[e] + (prv[e] - cur[e]) * PRM[kind * 64 + c0 + e];
                }
            }
            unpack8(raw[6], dd); unpack8(raw[7], a); unpack8(raw[8], g);
            float ss = 0.f; bn = 0.f;
#pragma unroll
            for (int e = 0; e < 8; ++e) { kkn[e] = k[e] * PRM[192 + c0 + e]; ss += kkn[e] * kkn[e]; }
            ss = red8(ss);
            const float rn = rsqrtf(ss + 1e-6f);
#pragma unroll
            for (int e = 0; e < 8; ++e) {
                kkn[e] *= rn; be[e] = kkn[e] * a[e];
                k2[e] = k[e] * (1.f + (a[e] - 1.f) * PRM[256 + c0 + e]);
                bn += r[e] * k2[e] * PRM[320 + c0 + e];
                R8[swz_el(c0 + e, t)] = f2bf(dd[e]);
            }
            bn = red8(bn);
            __syncthreads();
#pragma unroll
            for (int q = 0; q < 2; ++q) {
                const int jt = ih + q;
                f32x4 gacc = {0.f, 0.f, 0.f, 0.f};
#pragma unroll
                for (int kk = 0; kk < 2; ++kk) {
                    bf16x8 lt;
#pragma unroll
                    for (int e = 0; e < 8; ++e) lt[e] = (kk * 32 + fq * 8 + e <= tm * 16 + fr) ? (short)0x3F80 : (short)0;
                    gacc = __builtin_amdgcn_mfma_f32_16x16x32_bf16(lt, *(const bf16x8*)(R8 + swz_ch(jt * 16 + fr, kk * 4 + fq)), gacc, 0, 0, 0);
                }
#pragma unroll
                for (int jj = 0; jj < 4; ++jj) GA[(tm * 16 + fq * 4 + jj) * 64 + jt * 16 + fr] = gacc[jj];
            }
            __syncthreads();
            {
                float at[8], bt[8], kt[8], rt[8];
#pragma unroll
                for (int e = 0; e < 8; ++e) {
                    const int j = c0 + e;
                    const float Gt = GA[t * 64 + j], Gp = t > 0 ? GA[(t - 1) * 64 + j] : 0.f, Gc = GA[63 * 64 + j];
                    const float em = __expf(-Gp), ep = __expf(Gt), en = __expf(-Gt), ec = __expf(Gt - Gc);
                    at[e] = -kkn[e] * em; bt[e] = be[e] * ep; kt[e] = k2[e] * ep; rt[e] = r[e] * en;
                    const int so = swz_el(j, t);
                    R5[so] = f2bf(be[e] * ec); R6[so] = f2bf(k2[e] * ec); R7[so] = f2bf(v[e]);
                    if (t == 63) GC[j] = __expf(-Gc);
                }
                *(u32x4*)(R0 + t * MS + c0) = pack8(at); *(u32x4*)(R2 + t * MS + c0) = pack8(bt); *(u32x4*)(R3 + t * MS + c0) = pack8(kt); *(u32x4*)(R4 + t * MS + c0) = pack8(rt);
            }
        }
        __syncthreads();
#pragma unroll
        for (int q = 0; q < 2; ++q) {
            const int tile = wave * 2 + q, sm = tile >> 2, tn = tile & 3;
            f32x4 lb = {0.f, 0.f, 0.f, 0.f}, lk = lb, mb = lb, mk = lb;
#pragma unroll
            for (int kk = 0; kk < 2; ++kk) {
                const bf16x8 yb = *(const bf16x8*)(R2 + (sm * 16 + fr) * MS + kk * 32 + fq * 8), yk = *(const bf16x8*)(R3 + (sm * 16 + fr) * MS + kk * 32 + fq * 8);
                const bf16x8 xa = *(const bf16x8*)(R0 + (tn * 16 + fr) * MS + kk * 32 + fq * 8), xr = *(const bf16x8*)(R4 + (tn * 16 + fr) * MS + kk * 32 + fq * 8);
                lb = __builtin_amdgcn_mfma_f32_16x16x32_bf16(yb, xa, lb, 0, 0, 0); lk = __builtin_amdgcn_mfma_f32_16x16x32_bf16(yk, xa, lk, 0, 0, 0);
                mb = __builtin_amdgcn_mfma_f32_16x16x32_bf16(yb, xr, mb, 0, 0, 0); mk = __builtin_amdgcn_mfma_f32_16x16x32_bf16(yk, xr, mk, 0, 0, 0);
            }
            const int tt = tn * 16 + fr, s0i = sm * 16 + fq * 4;
            float olk[4], omb[4], omk[4];
#pragma unroll
            for (int jj = 0; jj < 4; ++jj) {
                const int si = s0i + jj;
                olk[jj] = (si < tt) ? lk[jj] : 0.f; omb[jj] = (si <= tt) ? mb[jj] : 0.f; omk[jj] = (si <= tt) ? mk[jj] : 0.f;
            }
            u32x2 w;
            w.x = cvt_pk_bf16(olk[0], olk[1]); w.y = cvt_pk_bf16(olk[2], olk[3]); *(u32x2*)(R8 + tt * MS + s0i) = w;
            w.x = cvt_pk_bf16(omb[0], omb[1]); w.y = cvt_pk_bf16(omb[2], omb[3]); *(u32x2*)(R9 + tt * MS + s0i) = w;
            w.x = cvt_pk_bf16(omk[0], omk[1]); w.y = cvt_pk_bf16(omk[2], omk[3]); *(u32x2*)(R10 + tt * MS + s0i) = w;
#pragma unroll
            for (int jj = 0; jj < 4; ++jj) { const int si = s0i + jj; GA[tt * 68 + si] = (si < tt) ? -lb[jj] : 0.f; }
        }
        __syncthreads();
#pragma unroll
        for (int q = 0; q < 2; ++q) {
            f32x4 y = {0.f, 0.f, 0.f, 0.f};
#pragma unroll
            for (int kk = 0; kk < 2; ++kk) {
                y = __builtin_amdgcn_mfma_f32_16x16x32_bf16(*(const bf16x8*)(R8 + (tm * 16 + fr) * MS + kk * 32 + fq * 8), *(const bf16x8*)(R7 + swz_ch((ih + q) * 16 + fr, kk * 4 + fq)), y, 0, 0, 0);
                y = __builtin_amdgcn_mfma_f32_16x16x32_bf16(*(const bf16x8*)(R0 + (tm * 16 + fr) * MS + kk * 32 + fq * 8), *(const bf16x8*)(PT + ((ih + q) * 16 + fr) * MS + kk * 32 + fq * 8), y, 0, 0, 0);
            }
            u32x2 w; w.x = cvt_pk_bf16(y[0], y[1]); w.y = cvt_pk_bf16(y[2], y[3]); *(u32x2*)(R1 + ((ih + q) * 16 + fr) * MS + tm * 16 + fq * 4) = w;
        }
        __syncthreads();
        {
            bf16_t* TM = R3;
            tri_inv64(GA, TF, OW, tid);
            __syncthreads();
#pragma unroll
            for (int q = 0; q < 8; ++q) { const int e = tid + q * 512, i = e >> 6, cc = e & 63; TM[i * MS + cc] = ((cc >> 4) <= (i >> 4)) ? f2bf(TF[i * 68 + cc]) : (bf16_t)0; }
        }
        __syncthreads();
#pragma unroll
        for (int q = 0; q < 2; ++q) {
            f32x4 uacc = {0.f, 0.f, 0.f, 0.f};
#pragma unroll
            for (int kk = 0; kk < 2; ++kk)
                uacc = __builtin_amdgcn_mfma_f32_16x16x32_bf16(*(const bf16x8*)(R3 + (tm * 16 + fr) * MS + kk * 32 + fq * 8), *(const bf16x8*)(R1 + ((ih + q) * 16 + fr) * MS + kk * 32 + fq * 8), uacc, 0, 0, 0);
            u32x2 w; w.x = cvt_pk_bf16(uacc[0], uacc[1]); w.y = cvt_pk_bf16(uacc[2], uacc[3]); *(u32x2*)(R2 + ((ih + q) * 16 + fr) * MS + tm * 16 + fq * 4) = w;
        }
        __syncthreads();
#pragma unroll
        for (int q = 0; q < 2; ++q) {
            f32x4 o = {0.f, 0.f, 0.f, 0.f};
            const f32x4 gc = *(const f32x4*)(GC + tm * 16 + fq * 4);
            Pacc[q] = Pacc[q] * gc;
#pragma unroll
            for (int kk = 0; kk < 2; ++kk) {
                const bf16x8 vt = *(const bf16x8*)(R7 + swz_ch((ih + q) * 16 + fr, kk * 4 + fq)), ut = *(const bf16x8*)(R2 + ((ih + q) * 16 + fr) * MS + kk * 32 + fq * 8);
                const bf16x8 pt = *(const bf16x8*)(PT + ((ih + q) * 16 + fr) * MS + kk * 32 + fq * 8);
                o = __builtin_amdgcn_mfma_f32_16x16x32_bf16(*(const bf16x8*)(R10 + (tm * 16 + fr) * MS + kk * 32 + fq * 8), vt, o, 0, 0, 0);
                o = __builtin_amdgcn_mfma_f32_16x16x32_bf16(*(const bf16x8*)(R4 + (tm * 16 + fr) * MS + kk * 32 + fq * 8), pt, o, 0, 0, 0);
                o = __builtin_amdgcn_mfma_f32_16x16x32_bf16(*(const bf16x8*)(R9 + (tm * 16 + fr) * MS + kk * 32 + fq * 8), ut, o, 0, 0, 0);
                Pacc[q] = __builtin_amdgcn_mfma_f32_16x16x32_bf16(*(const bf16x8*)(R5 + swz_ch(tm * 16 + fr, kk * 4 + fq)), ut, Pacc[q], 0, 0, 0);
                Pacc[q] = __builtin_amdgcn_mfma_f32_16x16x32_bf16(*(const bf16x8*)(R6 + swz_ch(tm * 16 + fr, kk * 4 + fq)), vt, Pacc[q], 0, 0, 0);
            }
#pragma unroll
            for (int jj = 0; jj < 4; ++jj) OW[(tm * 16 + fq * 4 + jj) * 68 + (ih + q) * 16 + fr] = o[jj];
        }
        __syncthreads();
#pragma unroll
        for (int q = 0; q < 2; ++q) { u32x2 w; w.x = cvt_pk_bf16(Pacc[q][0], Pacc[q][1]); w.y = cvt_pk_bf16(Pacc[q][2], Pacc[q][3]); *(u32x2*)(PT + ((ih + q) * 16 + fr) * MS + tm * 16 + fq * 4) = w; }
        {
            float o[8]; float sm = 0.f;
#pragma unroll
            for (int e = 0; e < 8; ++e) { o[e] = OW[t * 68 + c0 + e]; sm += o[e]; }
            const float mean = red8(sm) * (1.f / 64.f); float s2 = 0.f;
#pragma unroll
            for (int e = 0; e < 8; ++e) { o[e] -= mean; s2 += o[e] * o[e]; }
            const float rstd = rsqrtf(red8(s2) * (1.f / 64.f) + 64e-5f);
#pragma unroll
            for (int e = 0; e < 8; ++e) o[e] = (o[e] * rstd * PRM[384 + c0 + e] + PRM[448 + c0 + e] + bn * v[e]) * g[e];
            *(u32x4*)(YIN + (size_t)(t0 + t) * 1024 + 512 + h * 64 + c0) = pack8(o);
        }
        __syncthreads();
    }
    {
        float* so = p.out + (prompt ? O_PRW + ((size_t)(l * 16 + b) * 8 + h) * 4096 : O_SRW + ((size_t)(l * 8 + b) * 8 + h) * 4096);
#pragma unroll
        for (int q = 0; q < 2; ++q)
#pragma unroll
            for (int jj = 0; jj < 4; ++jj) so[((ih + q) * 16 + fr) * 64 + tm * 16 + fq * 4 + jj] = Pacc[q][jj];
        if (h == 0) {
            const int tlast = prompt ? (seq + 1) * 2048 - 1 : NTP + (b + 1) * 64 - 1;
            float* sh = p.out + (prompt ? O_PSHIFT + (size_t)(l * 16 + b) * RWP : O_SSHIFT + (size_t)(l * 8 + b) * RWP);
            for (int i = tid; i < RWP; i += 512) sh[i] = bf2f(PROJ[(size_t)tlast * PJ + C_RW + i]);
        }
    }
    __syncthreads();
}

__device__ __forceinline__ void phase_scan(const Ctx& cx, const Params& p, int l) {
#ifndef REP_SCAN
#define REP_SCAN 1
#endif
    for (int rep = 0; rep < REP_SCAN; ++rep)
    for (int w = cx.bid; w < 288; w += cx.nb) {
        bool isr; int seq, h;
        if (w < 128) { isr = true; seq = w >> 3; h = w & 7; }
        else if (w < 192) { isr = false; seq = (w - 128) >> 2; h = (w - 128) & 3; }
        else if (w < 224) { isr = false; seq = 16 + ((w - 192) >> 2); h = (w - 192) & 3; }
        else { isr = true; seq = 16 + ((w - 224) >> 3); h = (w - 224) & 7; }
#ifndef SCANM
#define SCANM 3
#endif
#ifndef REP_R
#define REP_R 1
#endif
#ifndef REP_GD
#define REP_GD 1
#endif
        if (isr) { if (SCANM & 1) for (int rr = 0; rr < REP_R; ++rr) rwkv_chunk_unit(cx, p, l, seq, h); }
        else { if (SCANM & 2) for (int rr = 0; rr < REP_GD; ++rr) gdn_scan_unit(cx, p, l, seq, h); }
    }
}

#define XB_TMO      128
#define XB_XCNT(j)  (256  + 64 * (j))
#define XB_XSUB(j)  (1280 + 64 * (j))
#define XB_XGEN(j)  (2304 + 64 * (j))
#define XB_TOP      3328
#define XB_TOPGEN   3392
#define XCD_BAR_WORDS 3456
#define XB_SPIN_CAP (1u << 18)
#define XLAS __attribute__((address_space(3)))
__device__ __forceinline__ unsigned xb_ld(unsigned* p)              { return __hip_atomic_load(p, __ATOMIC_RELAXED, __HIP_MEMORY_SCOPE_AGENT); }
__device__ __forceinline__ unsigned xb_add(unsigned* p, unsigned v) { return __hip_atomic_fetch_add(p, v, __ATOMIC_RELAXED, __HIP_MEMORY_SCOPE_AGENT); }
__device__ __forceinline__ unsigned xb_xcc_id() { return (unsigned)__builtin_amdgcn_s_getreg((3 << 11) | 20) & 0xFu; }
#define XB_SPIN(cond, bar) do { unsigned _sp = 0; while (cond) { __builtin_amdgcn_s_sleep(1); \
    if ((++_sp & 255u) == 0u) { if (xb_ld(&(bar)[XB_TMO])) break; if (_sp > XB_SPIN_CAP) { atomicAdd(&(bar)[XB_TMO], 1u); break; } } } } while (0)
struct XcdBarrier { unsigned* bar; unsigned x; volatile XLAS unsigned* st; };
__device__ __forceinline__ XcdBarrier xcd_barrier_post(unsigned* bar, volatile XLAS unsigned* st) {
    XcdBarrier b; b.bar = bar; b.x = xb_xcc_id(); b.st = st;
    if (threadIdx.x == 0) (void)xb_add(&bar[XB_XCNT(b.x)], 1u);
    return b;
}
__device__ __forceinline__ void xcd_barrier_complete(unsigned* bar, unsigned x, unsigned& nloc, unsigned& nx) {
    const unsigned G = gridDim.x * gridDim.y * gridDim.z;
    unsigned sum, cnt, mine, sp = 0u;
    for (;;) {
        sum = 0u; cnt = 0u; mine = 0u;
#pragma unroll
        for (unsigned j = 0; j < 16; ++j) { const unsigned c = xb_ld(&bar[XB_XCNT(j)]); sum += c; cnt += (c > 0u) ? 1u : 0u; mine = (j == x) ? c : mine; }
        if (sum == G) break;
        __builtin_amdgcn_s_sleep(1);
        if ((++sp & 255u) == 0u) { if (xb_ld(&bar[XB_TMO])) break; if (sp > XB_SPIN_CAP) { atomicAdd(&bar[XB_TMO], 1u); break; } }
    }
    nloc = mine > 0u ? mine : 1u; nx = cnt > 0u ? cnt : 1u;
}
__device__ __forceinline__ void xcd_barrier(const XcdBarrier& b) {
    asm volatile("s_waitcnt vmcnt(0)" ::: "memory");
    __syncthreads();
    if (threadIdx.x == 0) {
        unsigned* bar = b.bar;
        __builtin_amdgcn_s_waitcnt(0);
        unsigned nloc = b.st[0], nx = b.st[1];
        if (nloc == 0u) { xcd_barrier_complete(bar, b.x, nloc, nx); b.st[0] = nloc; b.st[1] = nx; }
        const unsigned old = xb_add(&bar[XB_XSUB(b.x)], 1u);
        const unsigned gen = old / nloc;
        if (old + 1u == (gen + 1u) * nloc) {
            __builtin_amdgcn_fence(__ATOMIC_RELEASE, "agent");
            asm volatile("s_waitcnt vmcnt(0)" ::: "memory");
            const unsigned og = xb_add(&bar[XB_TOP], 1u);
            const unsigned tg = og / nx;
            if (og + 1u == (tg + 1u) * nx) xb_add(&bar[XB_TOPGEN], 1u);
            else XB_SPIN(xb_ld(&bar[XB_TOPGEN]) == tg, bar);
            __builtin_amdgcn_fence(__ATOMIC_ACQUIRE, "agent");
            xb_add(&bar[XB_XGEN(b.x)], 1u);
            asm volatile("s_waitcnt vmcnt(0)" ::: "memory");
        } else {
            XB_SPIN(xb_ld(&bar[XB_XGEN(b.x)]) == gen, bar);
            __builtin_amdgcn_fence(__ATOMIC_ACQUIRE, "agent");
            asm volatile("s_waitcnt vmcnt(0)" ::: "memory");
        }
    }
    __syncthreads();
}

__device__ __forceinline__ void run_phase(const Ctx& cx, const Params& p, int ph) {
    unsigned char* ws = p.ws;
    const float* MOD = (const float*)(ws + WS_MOD);
#ifndef PHM
#define PHM 0xFFFF
#endif
    if (ph == 0) { if (PHM & 1) phase_mod(cx, p); __syncthreads(); if (PHM & 2) phase_weights(cx, p, 0); return; }
    if (ph == 1) { if (PHM & 4) phase_mod0(cx, p); return; }
    const int l = (ph - 2) / 9, s = (ph - 2) % 9;
    const float* modl = MOD + (size_t)l * 24 * 6144;
    gm::Epi E{};
    const bf16_t* gA = (const bf16_t*)(ws + WS_H); const bf16_t* gB = nullptr; int gN = 0, gK = 1024;
    switch (s) {
    case 0: E.kind = 1; E.O = (bf16_t*)(ws + WS_R1); E.ldo = PJ; gB = (const bf16_t*)(ws + WS_WIN); gN = PJ; break;
    case 1: if (PHM & 16) phase_gdn_prep(cx, p, l); break;
    case 2: if (PHM & 128) phase_rwkv_prep(cx, p, l); break;
    case 3: if (PHM & 32) phase_scan(cx, p, l); break;
    case 4: E.kind = 2; E.X = p.out; E.O = (bf16_t*)(ws + WS_PREP); E.gate = modl + 2048; gB = (const bf16_t*)(ws + WS_WOUT); gN = 1024;
        if (l == 0) { E.xp = p.in[0]; E.xs = p.in[1] - (size_t)NTP * 1024; E.xb = nullptr; } else { E.xp = p.out; E.xs = p.out; E.xb = (const bf16_t*)p.out; }
        break;
    case 5: if (PHM & 64) phase_ln(cx, p, p.in[27] + l * 1024, p.in[28] + l * 1024, modl, 3072, 4096, false); break;
    case 6: E.kind = 3; E.O = (bf16_t*)(ws + WS_R1); E.ldo = DFF; gB = (const bf16_t*)(ws + WS_W1); gN = DFF; break;
    case 7: E.kind = 2; E.X = p.out; E.O = (bf16_t*)(ws + WS_PREP); E.gate = modl + 5120; E.xp = p.out; E.xs = p.out; E.xb = (const bf16_t*)p.out;
        gA = (const bf16_t*)(ws + WS_R1); gB = (const bf16_t*)(ws + WS_W2); gN = 1024; gK = DFF; break;
    default:
        if (PHM & 64) phase_ln(cx, p, p.in[31] + l * 1024, p.in[32] + l * 1024, l < NLAYER - 1 ? modl + 24 * 6144 : nullptr, 0, 1024, l == NLAYER - 1);
        if ((PHM & 2) && l < NLAYER - 1) { __syncthreads(); phase_weights(cx, p, l + 1); }
        break;
    }
#ifndef REP_G
#define REP_G 1
#endif
#ifndef REP_G2
#define REP_G2 0
#endif
    if ((PHM & 8) && gB) {
        const int reps = (E.kind == 2) ? 1 + REP_G2 : REP_G;
        for (int r = 0; r < reps; ++r) { gm::Epi E2 = E; if (E.kind == 2 && r + 1 < reps) E2.kind = 0; gemm_phase(cx, gA, gB, NTOK, gN, gK, E2); }
    }
}

#ifndef DBG_STOP
#define DBG_STOP 0
#endif
#ifndef DBG_OFF
#define DBG_OFF WS_PREP
#endif
#ifndef DBG_MOD
#define DBG_MOD 76677120
#endif
#ifndef DBG_SZ
#define DBG_SZ 20480
#define DBG_POFF 16384
#endif
#ifndef DBG_STRIDE
#define DBG_STRIDE 5
#endif
__global__ void __launch_bounds__(512) mk_fwd(Params p) {
    cg::grid_group grid = cg::this_grid();
    if (p.ph_lo == 1000) {
        const bf16_t* src = (const bf16_t*)(p.ws + DBG_OFF);
        for (size_t i = (size_t)blockIdx.x * 512 + threadIdx.x; i < 44130304; i += (size_t)gridDim.x * 512) p.out[i] = bf2f(src[((i / DBG_SZ) % 2080) * 36864 + DBG_POFF + (i % DBG_SZ)]);
        return;
    }
    volatile XLAS unsigned* xst = (volatile XLAS unsigned*)((XLAS unsigned char*)smem + (LDS_BYTES - 16));
    if (threadIdx.x == 0) { xst[0] = 0u; xst[1] = 0u; xst[2] = 0u; xst[3] = 0u; }
    __syncthreads();
    const XcdBarrier xb = xcd_barrier_post((unsigned*)(p.ws + WS_BAR), xst);
    for (int ph = p.ph_lo; ph < p.ph_hi; ++ph) {
        if (ph > p.ph_lo) { if (p.ph_hi == 0x7fffffff) grid.sync(); else xcd_barrier(xb); }
        Ctx cx; cx.tid = threadIdx.x; cx.bid = blockIdx.x; cx.nb = gridDim.x;
        asm volatile("" : "+v"(cx.tid)); asm volatile("" : "+s"(cx.bid)); asm volatile("" : "+s"(cx.nb));
        run_phase(cx, p, ph);
        __syncthreads();
    }
}

extern "C" void kernel_launch(void* const* d_in, const int* in_sizes, int n_in, void* d_out, int out_size, void* d_ws, size_t ws_size, hipStream_t stream) {
    static int grid = 0;
    if (grid == 0) {
        if (n_in != 33 || ws_size < WS_END) { fprintf(stderr, "kernel_launch: unexpected n_in %d / ws %zu (need %zu)\n", n_in, ws_size, (size_t)WS_END); grid = -1; return; }
        int dev = 0, cus = 0, per_cu = 0;
        hipGetDevice(&dev);
        hipDeviceGetAttribute(&cus, hipDeviceAttributeMultiprocessorCount, dev);
        if (hipFuncSetAttribute((const void*)mk_fwd, hipFuncAttributeMaxDynamicSharedMemorySize, LDS_BYTES) != hipSuccess) { fprintf(stderr, "kernel_launch: hipFuncSetAttribute failed\n"); grid = -1; return; }
        if (hipOccupancyMaxActiveBlocksPerMultiprocessor(&per_cu, (const void*)mk_fwd, 512, LDS_BYTES) != hipSuccess || per_cu < 1) { fprintf(stderr, "kernel_launch: occupancy query says %d\n", per_cu); per_cu = 1; }
        (void)hipGetLastError();
        grid = cus;
    }
    if (grid < 0) return;
    if (hipMemsetAsync((char*)d_ws + WS_BAR, 0, 16384, stream) != hipSuccess) { fprintf(stderr, "kernel_launch: memset of the barrier words failed\n"); return; }
    Params p{};
    for (int i = 0; i < 33; ++i) p.in[i] = (const float*)d_in[i];
    p.out = (float*)d_out; p.ws = (unsigned char*)d_ws;
#if MK_ONE_LAUNCH
    p.ph_lo = 0; p.ph_hi = NPHASE;
    void* args[] = {&p};
    hipError_t e = hipLaunchCooperativeKernel((const void*)mk_fwd, dim3(grid), dim3(512), args, LDS_BYTES, stream);
    if (e != hipSuccess) fprintf(stderr, "cooperative launch failed: %s (grid %d)\n", hipGetErrorString(e), grid);
#else
    for (int ph = 0; ph < (DBG_STOP ? DBG_STOP + 1 : NPHASE); ++ph) {
        p.ph_lo = ph; p.ph_hi = ph + 1;
        if (DBG_STOP && ph == DBG_STOP) { p.ph_lo = 1000; p.ph_hi = 1000; }
        void* args[] = {&p};
        hipError_t e = hipLaunchCooperativeKernel((const void*)mk_fwd, dim3(grid), dim3(512), args, LDS_BYTES, stream);
        if (e != hipSuccess) { fprintf(stderr, "launch %d failed: %s\n", ph, hipGetErrorString(e)); break; }
    }
#endif
}
```

```cpp
#include <hip/hip_runtime.h>
#include <hip/hip_cooperative_groups.h>
#include <cstdio>
#include <cstdint>
namespace cg = cooperative_groups;

#ifndef MK_ONE_LAUNCH
#define MK_ONE_LAUNCH 1
#define DBL_MASK 0x6
#endif

typedef unsigned short bf16_t;
typedef short bf16x8 __attribute__((ext_vector_type(8)));
typedef float f32x4 __attribute__((ext_vector_type(4)));
typedef float f32x2 __attribute__((ext_vector_type(2)));
typedef unsigned u32x4 __attribute__((ext_vector_type(4)));
typedef unsigned u32x2 __attribute__((ext_vector_type(2)));

constexpr int DM = 1024, NTOK = 33280, NTP = 32768, NSEQ = 24, NLAYER = 4;
constexpr int PJ = 4096;
constexpr int PTOT = 3848;
constexpr int C_Z = 1536, C_RW = 2048, C_GA = 3840, C_GB = 3844;
constexpr int DFF = 4096;
constexpr int RWP = 1792;
constexpr float DN_ALPHA = 1.681792830507429f;
constexpr int LDS_BYTES = 151552;
constexpr int NPHASE = 2 + 9 * NLAYER;

constexpr size_t WS_MOD = 0;
constexpr size_t WS_WIN = 2359296;
constexpr size_t WS_WOUT = WS_WIN + 8388608;
constexpr size_t WS_W1 = WS_WOUT + 2097152;
constexpr size_t WS_W2 = WS_W1 + 8388608;
constexpr size_t WS_LW2 = WS_W2 + 8388608;
constexpr size_t WS_LA2 = WS_LW2 + 65536;
constexpr size_t WS_LG2 = WS_LA2 + 65536;
constexpr size_t WS_DL = WS_LG2 + 131072;
constexpr size_t WS_H = WS_DL + 16384;
constexpr size_t WS_R1 = WS_H + 68157440;
constexpr size_t WS_PREP = WS_R1 + 272629760;
constexpr size_t WS_BAR = WS_PREP + 153354240;
constexpr size_t WS_GATE = WS_BAR + 16384;
constexpr size_t WS_END = WS_GATE + 1064960;
constexpr int PREP_STRIDE = 36864;
constexpr int PO_U0T = 0, PO_WKN = 8192, PO_QD = 16384, PO_KDT = 24576, PO_QK = 32768;

constexpr size_t O_PGDN = 34078720, O_PCONV = 38273024, O_PRW = 38567936, O_PSHIFT = 40665088;
constexpr size_t O_SGDN = 40779776, O_SCONV = 42876928, O_SRW = 43024384, O_SSHIFT = 44072960;

struct Ctx { int tid, bid, nb; };
struct Params {
    const float* in[33];
    float* out;
    unsigned char* ws;
    int ph_lo, ph_hi;
};

extern __shared__ __attribute__((aligned(16))) unsigned char smem[];

typedef __bf16 bf16x2_t __attribute__((ext_vector_type(2)));
__device__ __forceinline__ unsigned cvt_pk_bf16(float lo, float hi) { f32x2 f = {lo, hi}; bf16x2_t v = __builtin_convertvector(f, bf16x2_t); return __builtin_bit_cast(unsigned, v); }
__device__ __forceinline__ bf16_t f2bf(float f) { return (bf16_t)(cvt_pk_bf16(f, 0.f) & 0xffffu); }
__device__ __forceinline__ float bf2f(bf16_t b) { return __uint_as_float(((unsigned)b) << 16); }
__device__ __forceinline__ float bflo(unsigned w) { return __uint_as_float(w << 16); }
__device__ __forceinline__ float bfhi(unsigned w) { return __uint_as_float(w & 0xffff0000u); }
__device__ __forceinline__ void unpack8(u32x4 w, float* f) {
    f[0] = bflo(w.x); f[1] = bfhi(w.x); f[2] = bflo(w.y); f[3] = bfhi(w.y);
    f[4] = bflo(w.z); f[5] = bfhi(w.z); f[6] = bflo(w.w); f[7] = bfhi(w.w);
}
__device__ __forceinline__ u32x4 pack8(const float* f) {
    u32x4 w; w.x = cvt_pk_bf16(f[0], f[1]); w.y = cvt_pk_bf16(f[2], f[3]); w.z = cvt_pk_bf16(f[4], f[5]); w.w = cvt_pk_bf16(f[6], f[7]); return w;
}
__device__ __forceinline__ float silu_f(float x) { return x / (1.f + __expf(-x)); }
__device__ __forceinline__ float sigmoid_f(float x) { return 1.f / (1.f + __expf(-x)); }
__device__ __forceinline__ float softplus_f(float x) { return fmaxf(x, 0.f) + __logf(1.f + __expf(-fabsf(x))); }
__device__ __forceinline__ float tanh_f(float x) { return 1.f - 2.f / (1.f + __expf(2.f * x)); }
__device__ __forceinline__ float dpp_x1(float x) { return __int_as_float(__builtin_amdgcn_mov_dpp(__float_as_int(x), 0xB1, 0xF, 0xF, true)); }
__device__ __forceinline__ float dpp_x2(float x) { return __int_as_float(__builtin_amdgcn_mov_dpp(__float_as_int(x), 0x4E, 0xF, 0xF, true)); }
__device__ __forceinline__ float dpp_hm(float x) { return __int_as_float(__builtin_amdgcn_mov_dpp(__float_as_int(x), 0x141, 0xF, 0xF, true)); }
__device__ __forceinline__ float dpp_rm(float x) { return __int_as_float(__builtin_amdgcn_mov_dpp(__float_as_int(x), 0x140, 0xF, 0xF, true)); }
__device__ __forceinline__ float red8(float x) { x += dpp_x1(x); x += dpp_x2(x); x += dpp_hm(x); return x; }
__device__ __forceinline__ float red16(float x) { x = red8(x); x += dpp_rm(x); return x; }
__device__ __forceinline__ float wave_sum(float v) {
#pragma unroll
    for (int o = 1; o < 64; o <<= 1) v += __shfl_xor(v, o);
    return v;
}
__device__ __forceinline__ int seq_of_row(int row) { return row < NTP ? (row >> 11) : 16 + ((row - NTP) >> 6); }
#define LDS_WAIT() asm volatile("s_waitcnt lgkmcnt(0)" ::: "memory")

__device__ __forceinline__ void phase_mod(const Ctx& cx, const Params& p) {
    float* sc = (float*)smem;
    const int tid = cx.tid;
    const float* c_p = p.in[2]; const float* c_s = p.in[3];
    const float* w_ada = p.in[8]; const float* b_ada = p.in[9];
    float* MOD = (float*)(p.ws + WS_MOD);
    for (int item = cx.bid; item < NLAYER * 96; item += cx.nb) {
        const int l = item / 96, cgp = item % 96;
        for (int idx = tid; idx < 24 * 1024; idx += 512) {
            const int s = idx >> 10, k = idx & 1023;
            const float c = s < 16 ? c_p[s * 1024 + k] : c_s[(s - 16) * 1024 + k];
            sc[k * 24 + s] = silu_f(c);
        }
        __syncthreads();
        const int kg = tid >> 6, col = tid & 63;
        float acc[24];
#pragma unroll
        for (int s = 0; s < 24; ++s) acc[s] = 0.f;
        const float* wp = w_ada + (size_t)l * 1024 * 6144 + (size_t)(kg * 128) * 6144 + cgp * 64 + col;
#pragma unroll 16
        for (int k = 0; k < 128; ++k) {
            const float w = wp[(size_t)k * 6144];
            const f32x4* sp = (const f32x4*)(sc + (kg * 128 + k) * 24);
#pragma unroll
            for (int q = 0; q < 6; ++q) { const f32x4 v = sp[q]; acc[4 * q] += v.x * w; acc[4 * q + 1] += v.y * w; acc[4 * q + 2] += v.z * w; acc[4 * q + 3] += v.w * w; }
        }
        __syncthreads();
#pragma unroll
        for (int s = 0; s < 24; ++s) sc[(kg * 24 + s) * 64 + col] = acc[s];
        __syncthreads();
        for (int o = tid; o < 24 * 64; o += 512) {
            const int s = o >> 6, c = o & 63;
            float sum = b_ada[l * 6144 + cgp * 64 + c];
#pragma unroll
            for (int g = 0; g < 8; ++g) sum += sc[(g * 24 + s) * 64 + c];
            MOD[(size_t)(l * 24 + s) * 6144 + cgp * 64 + c] = sum;
        }
        __syncthreads();
    }
}

__device__ __forceinline__ int win_map(int n) { return n < 2048 ? n : (n < 2056 ? n - 2048 + C_GA : n - 8); }
__device__ __forceinline__ void transpose_w(const Ctx& cx, const float* W, int K, int N, bf16_t* WT, int mode, int gw, int NGW, int rot) {
    const int lane = cx.tid & 63, wave = cx.tid >> 6;
    float* scr = (float*)(smem + wave * 8448);
    const int nblk = (N + 31) / 32, nitems = (K / 64) * nblk;
    int start = gw - rot; while (start < 0) start += NGW;
    for (int it = start; it < nitems; it += NGW) {
        const int kb = it / nblk, nb = it % nblk, k0 = 64 * kb, n0 = 32 * nb;
        const int nn = n0 + (lane & 31);
#pragma unroll
        for (int i = 0; i < 32; ++i) { const int kk = 2 * i + (lane >> 5); scr[kk * 33 + (lane & 31)] = nn < N ? W[(size_t)(k0 + kk) * N + nn] : 0.f; }
        LDS_WAIT();
        const int c = lane & 7;
#pragma unroll
        for (int j = 0; j < 4; ++j) {
            const int nl = (lane >> 3) + 8 * j, n = n0 + nl;
            const float* s = scr + (8 * c) * 33 + nl;
            u32x4 o; o.x = cvt_pk_bf16(s[0], s[33]); o.y = cvt_pk_bf16(s[66], s[99]); o.z = cvt_pk_bf16(s[132], s[165]); o.w = cvt_pk_bf16(s[198], s[231]);
            if (n < N) { const int row = mode ? win_map(n) : n; *(u32x4*)(WT + (size_t)row * K + k0 + 8 * c) = o; }
        }
        LDS_WAIT();
    }
}
__device__ __forceinline__ void phase_weights(const Ctx& cx, const Params& p, int l) {
    const int gw = cx.bid * 8 + (cx.tid >> 6), NGW = cx.nb * 8;
    unsigned char* ws = p.ws;
    transpose_w(cx, p.in[10] + (size_t)l * 1024 * PTOT, 1024, PTOT, (bf16_t*)(ws + WS_WIN), 1, gw, NGW, 0);
    transpose_w(cx, p.in[26] + (size_t)l * 1024 * 1024, 1024, 1024, (bf16_t*)(ws + WS_WOUT), 0, gw, NGW, 1936 % NGW);
    transpose_w(cx, p.in[29] + (size_t)l * 1024 * 4096, 1024, 4096, (bf16_t*)(ws + WS_W1), 0, gw, NGW, (1936 + 512) % NGW);
    transpose_w(cx, p.in[30] + (size_t)l * 4096 * 1024, 4096, 1024, (bf16_t*)(ws + WS_W2), 0, gw, NGW, (1936 + 512 + 2048) % NGW);
    transpose_w(cx, p.in[17] + (size_t)l * 64 * 512, 64, 512, (bf16_t*)(ws + WS_LW2), 0, gw, NGW, (1936 + 512 + 4096) % NGW);
    transpose_w(cx, p.in[19] + (size_t)l * 64 * 512, 64, 512, (bf16_t*)(ws + WS_LA2), 0, gw, NGW, (1936 + 512 + 4096 + 16) % NGW);
    transpose_w(cx, p.in[20] + (size_t)l * 128 * 512, 128, 512, (bf16_t*)(ws + WS_LG2), 0, gw, NGW, (1936 + 512 + 4096 + 32) % NGW);
    u32x4* z = (u32x4*)(ws + WS_WIN + (size_t)PTOT * 1024 * 2);
    const u32x4 zero = {0u, 0u, 0u, 0u};
    for (int i = cx.bid * 512 + cx.tid; i < (PJ - PTOT) * 128; i += cx.nb * 512) z[i] = zero;
}

__device__ __forceinline__ void gate_weights(const float* win_l, int lane, unsigned (&wg)[64]) {
#pragma unroll
    for (int j = 0; j < 4; ++j)
#pragma unroll
        for (int pr = 0; pr < 2; ++pr) {
            const float* r0 = win_l + (size_t)(lane * 4 + 256 * j + 2 * pr) * PTOT + 2048;
            const f32x4 a0 = *(const f32x4*)r0, a1 = *(const f32x4*)(r0 + 4), b0 = *(const f32x4*)(r0 + PTOT), b1 = *(const f32x4*)(r0 + PTOT + 4);
            unsigned* w = wg + (j * 2 + pr) * 8;
            w[0] = cvt_pk_bf16(a0.x, b0.x); w[1] = cvt_pk_bf16(a0.y, b0.y); w[2] = cvt_pk_bf16(a0.z, b0.z); w[3] = cvt_pk_bf16(a0.w, b0.w);
            w[4] = cvt_pk_bf16(a1.x, b1.x); w[5] = cvt_pk_bf16(a1.y, b1.y); w[6] = cvt_pk_bf16(a1.z, b1.z); w[7] = cvt_pk_bf16(a1.w, b1.w);
        }
}
__device__ __forceinline__ void gate_row(const u32x2 (&o)[4], const unsigned (&wg)[64], float* gates_row, int lane) {
    float acc[8];
#pragma unroll
    for (int c = 0; c < 8; ++c) acc[c] = 0.f;
#pragma unroll
    for (int j = 0; j < 4; ++j)
#pragma unroll
        for (int pr = 0; pr < 2; ++pr) {
            const bf16x2_t hp = __builtin_bit_cast(bf16x2_t, pr == 0 ? o[j].x : o[j].y);
#pragma unroll
            for (int c = 0; c < 8; ++c) acc[c] = __builtin_amdgcn_fdot2_f32_bf16(hp, __builtin_bit_cast(bf16x2_t, wg[(j * 2 + pr) * 8 + c]), acc[c], false);
        }
#pragma unroll
    for (int c = 0; c < 8; ++c) acc[c] = wave_sum(acc[c]);
    if (lane == 0) { *(f32x4*)gates_row = (f32x4){acc[0], acc[1], acc[2], acc[3]}; *(f32x4*)(gates_row + 4) = (f32x4){acc[4], acc[5], acc[6], acc[7]}; }
}

__device__ __forceinline__ void phase_mod0(const Ctx& cx, const Params& p) {
    const int lane = cx.tid & 63;
    const int gw = cx.bid * 8 + (cx.tid >> 6), NGW = cx.nb * 8;
    const float* MOD = (const float*)(p.ws + WS_MOD);
    bf16_t* H = (bf16_t*)(p.ws + WS_H);
    float* GATES = (float*)(p.ws + WS_GATE);
    unsigned wg[64];
    gate_weights(p.in[10], lane, wg);
#pragma unroll 2
    for (int row = gw; row < NTOK; row += NGW) {
        const float* xr = row < NTP ? p.in[0] + (size_t)row * 1024 : p.in[1] + (size_t)(row - NTP) * 1024;
        const float* md = MOD + (size_t)seq_of_row(row) * 6144;
        u32x2 ov[4];
#pragma unroll
        for (int j = 0; j < 4; ++j) {
            const int col = lane * 4 + 256 * j;
            const f32x4 x = *(const f32x4*)(xr + col), sh = *(const f32x4*)(md + col), scv = *(const f32x4*)(md + 1024 + col);
            u32x2 o; o.x = cvt_pk_bf16(x.x * (1.f + scv.x) + sh.x, x.y * (1.f + scv.y) + sh.y); o.y = cvt_pk_bf16(x.z * (1.f + scv.z) + sh.z, x.w * (1.f + scv.w) + sh.w);
            *(u32x2*)(H + (size_t)row * 1024 + col) = o; ov[j] = o;
        }
        gate_row(ov, wg, GATES + (size_t)row * 8, lane);
    }
}

__device__ __forceinline__ void phase_ln(const Ctx& cx, const Params& p, const float* lw, const float* lb, const float* modl  , int sh_off, int sc_off, bool final_out, const float* wgl  ) {
    const int lane = cx.tid & 63;
    const int gw = cx.bid * 8 + (cx.tid >> 6), NGW = cx.nb * 8;
    float* X = p.out;
    bf16_t* H = (bf16_t*)(p.ws + WS_H);
    float* GATES = (float*)(p.ws + WS_GATE);
    unsigned wg[64];
    if (wgl) gate_weights(wgl, lane, wg);
#ifndef REP_LN
#define REP_LN 0
#endif
    const bf16_t* V16 = (const bf16_t*)(p.ws + WS_PREP);
    for (int rep = 0; rep <= REP_LN; ++rep) {
    u32x2 nv[4];
#pragma unroll
    for (int j = 0; j < 4; ++j) nv[j] = *(const u32x2*)(V16 + (size_t)(gw < NTOK ? gw : 0) * 1024 + lane * 4 + 256 * j);
    for (int row = gw; row < NTOK; row += NGW) {
        const bool dry = rep < REP_LN;
        float* xr = X + (size_t)row * 1024;
        u32x2 cv[4];
#pragma unroll
        for (int j = 0; j < 4; ++j) cv[j] = nv[j];
        if (row + NGW < NTOK) {
#pragma unroll
            for (int j = 0; j < 4; ++j) nv[j] = *(const u32x2*)(V16 + (size_t)(row + NGW) * 1024 + lane * 4 + 256 * j);
        }
        f32x4 v[4]; float s = 0.f;
#pragma unroll
        for (int j = 0; j < 4; ++j) { const u32x2 w = cv[j]; v[j] = (f32x4){bflo(w.x), bfhi(w.x), bflo(w.y), bfhi(w.y)}; s += (v[j].x + v[j].y) + (v[j].z + v[j].w); }
        const float mean = wave_sum(s) * (1.f / 1024.f); float s2 = 0.f;
#pragma unroll
        for (int j = 0; j < 4; ++j) { v[j] = v[j] - mean; s2 += (v[j].x * v[j].x + v[j].y * v[j].y) + (v[j].z * v[j].z + v[j].w * v[j].w); }
        const float rstd = rsqrtf(wave_sum(s2) * (1.f / 1024.f) + 1e-5f);
        if (dry && rstd != -1.f) continue;
        const float* md = modl ? modl + (size_t)seq_of_row(row) * 6144 : nullptr;
        u32x2 ov[4];
#pragma unroll
        for (int j = 0; j < 4; ++j) {
            ov[j] = (u32x2){0u, 0u};
            const int col = lane * 4 + 256 * j;
            const f32x4 w = *(const f32x4*)(lw + col), b = *(const f32x4*)(lb + col);
            const f32x4 x = v[j] * rstd * w + b;
            if (final_out) *(f32x4*)(xr + col) = x;
            else { u32x2 ox; ox.x = cvt_pk_bf16(x.x, x.y); ox.y = cvt_pk_bf16(x.z, x.w); *(u32x2*)((bf16_t*)X + (size_t)row * 1024 + col) = ox; }
            if (md) {
                const f32x4 sh = *(const f32x4*)(md + sh_off + col), scv = *(const f32x4*)(md + sc_off + col);
                u32x2 o; o.x = cvt_pk_bf16(x.x * (1.f + scv.x) + sh.x, x.y * (1.f + scv.y) + sh.y); o.y = cvt_pk_bf16(x.z * (1.f + scv.z) + sh.z, x.w * (1.f + scv.w) + sh.w);
                *(u32x2*)(H + (size_t)row * 1024 + col) = o; ov[j] = o;
            }
        }
        if (wgl) gate_row(ov, wg, GATES + (size_t)row * 8, lane);
    }
    }
}

#define LAS __attribute__((address_space(3)))
namespace gm {
constexpr int BM = 256, BK = 64, HALF = 128, HTB = HALF * BK * 2, NXCD = 8, WGM = 8;
__device__ __forceinline__ int lds_byte(int r, int c) { const int st = (r >> 4) * 2 + (c >> 5), rr = r & 15, cc = c & 31, ob = rr * 64 + cc * 2; return st * 1024 + (ob ^ (((ob >> 9) & 1) << 5)); }
__device__ __forceinline__ void stage_rc(int b, int& R, int& C) { const int st = b / 1024, sb = b % 1024, swz = sb ^ (((sb >> 9) & 1) << 5); R = (st >> 1) * 16 + swz / 64; C = (st & 1) * 32 + (swz % 64) / 2; }
__device__ __forceinline__ int perm32(int rho) { const int n = rho >> 4, i = rho & 15; return 8 * (i >> 2) + 4 * n + (i & 3); }
struct Unit { int pm, pn; };
struct Order {
    int nM, nN, nwg, G, c;
    __device__ __forceinline__ bool next(int i, Unit& u) const {
        const long L = (long)i * G + c; if (L >= nwg) return false;
        int wgid = (int)L; { const int q = nwg / NXCD, r = nwg % NXCD, xcd = wgid % NXCD, off = wgid / NXCD; wgid = (xcd < r ? xcd * (q + 1) : r * (q + 1) + (xcd - r) * q) + off; }
        const int nig = WGM * nN, gid = wgid / nig, fm = gid * WGM, gsz = (nM - fm) < WGM ? (nM - fm) : WGM;
        u.pm = fm + ((wgid % nig) % gsz); u.pn = (wgid % nig) / gsz; return true;
    }
};
struct Epi {
    int kind;
    bf16_t* O; int ldo;
    const float* xp; const float* xs; float* X; const float* gate;
    const bf16_t* xb;
};
__device__ __forceinline__ void epilogue(const Epi& E, const f32x4 (&acc)[2][2][4][2], const Unit& u, int wr, int wc, int fr, int fq) {
    const int brow = u.pm * BM, bcol = u.pn * BM;
    if (E.kind == 0) return;
    if (E.kind == 2) {
#pragma unroll
        for (int ai = 0; ai < 2; ++ai)
#pragma unroll
            for (int m = 0; m < 4; ++m) {
                const int row = brow + ai * HALF + wr * 64 + m * 16 + fr;
                const float* xsrc = (row < NTP ? E.xp : E.xs) + (size_t)row * 1024;
                const bf16_t* xb = E.xb + (size_t)row * 1024;
                const float* gt = E.gate + (size_t)seq_of_row(row) * 6144;
                bf16_t* xo = E.O + (size_t)row * 1024;
#pragma unroll
                for (int bj = 0; bj < 2; ++bj) {
                    const int col = bcol + bj * HALF + wc * 32 + fq * 8;
                    f32x4 x0, x1;
                    if (E.xb) { const u32x4 w = *(const u32x4*)(xb + col); x0 = (f32x4){bflo(w.x), bfhi(w.x), bflo(w.y), bfhi(w.y)}; x1 = (f32x4){bflo(w.z), bfhi(w.z), bflo(w.w), bfhi(w.w)}; }
                    else { x0 = *(const f32x4*)(xsrc + col); x1 = *(const f32x4*)(xsrc + col + 4); }
                    const f32x4 g0 = *(const f32x4*)(gt + col), g1 = *(const f32x4*)(gt + col + 4);
                    const f32x4 v0 = x0 * DN_ALPHA + g0 * acc[ai][bj][m][0], v1 = x1 * DN_ALPHA + g1 * acc[ai][bj][m][1];
                    u32x4 o; o.x = cvt_pk_bf16(v0.x, v0.y); o.y = cvt_pk_bf16(v0.z, v0.w); o.z = cvt_pk_bf16(v1.x, v1.y); o.w = cvt_pk_bf16(v1.z, v1.w);
                    *(u32x4*)(xo + col) = o;
                }
            }
    } else {
        const bool sq = (E.kind == 3);
#pragma unroll
        for (int ai = 0; ai < 2; ++ai)
#pragma unroll
            for (int m = 0; m < 4; ++m) {
                const int row = brow + ai * HALF + wr * 64 + m * 16 + fr;
                bf16_t* orow = E.O + (size_t)row * E.ldo;
#pragma unroll
                for (int bj = 0; bj < 2; ++bj) {
                    const int col = bcol + bj * HALF + wc * 32 + fq * 8;
                    f32x4 v0 = acc[ai][bj][m][0], v1 = acc[ai][bj][m][1];
                    if (sq) {
                        v0.x = fmaxf(v0.x, 0.f); v0.y = fmaxf(v0.y, 0.f); v0.z = fmaxf(v0.z, 0.f); v0.w = fmaxf(v0.w, 0.f); v0 = v0 * v0;
                        v1.x = fmaxf(v1.x, 0.f); v1.y = fmaxf(v1.y, 0.f); v1.z = fmaxf(v1.z, 0.f); v1.w = fmaxf(v1.w, 0.f); v1 = v1 * v1;
                    }
                    u32x4 o; o.x = cvt_pk_bf16(v0.x, v0.y); o.y = cvt_pk_bf16(v0.z, v0.w); o.z = cvt_pk_bf16(v1.x, v1.y); o.w = cvt_pk_bf16(v1.z, v1.w);
                    *(u32x4*)(orow + col) = o;
                }
            }
    }
}
}

__device__ __forceinline__ void gemm_phase(const Ctx& cx, const bf16_t* gA, const bf16_t* gBt, int M, int N, int K, const gm::Epi& E) {
    using namespace gm;
    LAS unsigned char* lds = (LAS unsigned char*)smem;
    Order S; S.nM = M / BM; S.nN = N / BM; S.nwg = S.nM * S.nN; S.G = cx.nb; S.c = cx.bid;
    const int tid = cx.tid, wid = __builtin_amdgcn_readfirstlane(tid >> 6), lane = tid & 63, wr = wid >> 2, wc = wid & 3, fr = lane & 15, fq = lane >> 4;
    const int nt = K / BK;
    unsigned voffA[2], voffB[2];
#pragma unroll
    for (int i = 0; i < 2; ++i) { int R, C; stage_rc(tid * 16 + i * 8192, R, C); const int Rb = (R & ~31) + perm32(R & 31);
        voffA[i] = (unsigned)(R * K + C) * 2u; voffB[i] = (unsigned)(Rb * K + C) * 2u; }
    const size_t kstep = (size_t)(BK * 2);
    const size_t hstep = (size_t)HALF * K * 2;
    const size_t tstep = 2 * hstep;
    const unsigned ldsw = (unsigned)wid * 1024u;
    const int aoff = lds_byte(wr * 64 + fr, fq * 8), boff = lds_byte(wc * 32 + fr, fq * 8);
#define PG8_SA(b, h) (((b) * 2 + (h)) * HTB)
#define PG8_SB(b, h) ((4 + (b) * 2 + (h)) * HTB)
#define PG8_STAGE(bufoff, gbase, voff) do { _Pragma("unroll") for (int _i = 0; _i < 2; ++_i) \
        __builtin_amdgcn_global_load_lds((const unsigned*)((const char*)(gbase) + (voff)[_i]), (LAS unsigned*)(lds + (bufoff) + ldsw + _i * 8192), 16, 0, 0); } while (0)
#define PG8_LDA(dst, b, h) do { _Pragma("unroll") for (int m = 0; m < 4; ++m) _Pragma("unroll") for (int k = 0; k < 2; ++k) dst[m][k] = *(const LAS bf16x8*)(lds + PG8_SA(b, h) + aoff + m * 2048 + k * 1024); } while (0)
#define PG8_LDB(dst, b, h) do { _Pragma("unroll") for (int n = 0; n < 2; ++n) _Pragma("unroll") for (int k = 0; k < 2; ++k) dst[n][k] = *(const LAS bf16x8*)(lds + PG8_SB(b, h) + boff + n * 2048 + k * 1024); } while (0)
#define PG8_MMA(ai, bj, At, Bt) do { __builtin_amdgcn_s_setprio(1); _Pragma("unroll") for (int m = 0; m < 4; ++m) _Pragma("unroll") for (int n = 0; n < 2; ++n) _Pragma("unroll") for (int k = 0; k < 2; ++k) \
        acc[ai][bj][m][n] = __builtin_amdgcn_mfma_f32_16x16x32_bf16(Bt[n][k], At[m][k], acc[ai][bj][m][n], 0, 0, 0); __builtin_amdgcn_s_setprio(0); } while (0)
#define PG8_WAIT_V(n) asm volatile("s_waitcnt vmcnt(" #n ")" ::: "memory")
#define PG8_WAIT_L(n) asm volatile("s_waitcnt lgkmcnt(" #n ")" ::: "memory")
#define PG8_BAR __builtin_amdgcn_s_barrier()
#define PG8_SCHED __builtin_amdgcn_sched_barrier(0)
    Unit cur, nxt; int ui = 0;
    if (S.next(0, cur)) {
    f32x4 acc[2][2][4][2];
#pragma unroll
    for (int a = 0; a < 2; ++a)
#pragma unroll
        for (int b = 0; b < 2; ++b)
#pragma unroll
            for (int m = 0; m < 4; ++m)
#pragma unroll
                for (int n = 0; n < 2; ++n) acc[a][b][m][n] = (f32x4){0.f, 0.f, 0.f, 0.f};
    bf16x8 At[4][2], B0[2][2], B1[2][2];
    const char* cA = (const char*)gA + (size_t)cur.pm * tstep; const char* cB = (const char*)gBt + (size_t)cur.pn * tstep;
    PG8_STAGE(PG8_SB(0, 0), cB, voffB); PG8_STAGE(PG8_SB(0, 1), cB + hstep, voffB); PG8_STAGE(PG8_SA(0, 0), cA, voffA); PG8_STAGE(PG8_SA(0, 1), cA + hstep, voffA);
    if (wr == 1) PG8_BAR;
    PG8_WAIT_V(2); PG8_BAR;
    PG8_STAGE(PG8_SB(1, 0), cB + kstep, voffB); PG8_STAGE(PG8_SA(1, 0), cA + kstep, voffA); PG8_STAGE(PG8_SB(1, 1), cB + hstep + kstep, voffB);
    PG8_WAIT_V(6); PG8_BAR;
    for (;;) {
        const bool has_next = S.next(ui + 1, nxt);
        const char* nA = has_next ? (const char*)gA + (size_t)nxt.pm * tstep : cA; const char* nB = has_next ? (const char*)gBt + (size_t)nxt.pn * tstep : cB;
        for (int t = 0; t < nt; t += 2) {
            const bool last = (t == nt - 2);
            const char* a1 = cA + (size_t)(t + 1) * kstep;
            const char* a2 = last ? nA : cA + (size_t)(t + 2) * kstep; const char* b2 = last ? nB : cB + (size_t)(t + 2) * kstep;
            const char* a3 = a2 + kstep; const char* b3 = b2 + kstep;
            PG8_LDB(B0, 0, 0); PG8_LDB(B1, 0, 1); PG8_SCHED; PG8_LDA(At, 0, 0); PG8_STAGE(PG8_SA(1, 1), a1 + hstep, voffA);
            PG8_WAIT_V(8); PG8_WAIT_L(0); PG8_BAR; PG8_MMA(0, 0, At, B0); PG8_MMA(0, 1, At, B1); PG8_BAR; PG8_SCHED;
            PG8_LDA(At, 0, 1); PG8_STAGE(PG8_SB(0, 0), b2, voffB); PG8_STAGE(PG8_SB(0, 1), b2 + hstep, voffB); PG8_STAGE(PG8_SA(0, 0), a2, voffA);
            PG8_WAIT_V(8); PG8_WAIT_L(0); PG8_BAR; PG8_MMA(1, 0, At, B0); PG8_MMA(1, 1, At, B1); PG8_BAR; PG8_SCHED;
            PG8_LDB(B0, 1, 0); PG8_LDB(B1, 1, 1); PG8_SCHED; PG8_LDA(At, 1, 0); PG8_STAGE(PG8_SA(0, 1), a2 + hstep, voffA);
            PG8_WAIT_V(8); PG8_WAIT_L(0); PG8_BAR; PG8_MMA(0, 0, At, B0); PG8_MMA(0, 1, At, B1); PG8_BAR; PG8_SCHED;
            PG8_LDA(At, 1, 1); PG8_STAGE(PG8_SB(1, 0), b3, voffB); PG8_STAGE(PG8_SB(1, 1), b3 + hstep, voffB); PG8_STAGE(PG8_SA(1, 0), a3, voffA);
            PG8_WAIT_V(8); PG8_WAIT_L(0); PG8_BAR; PG8_MMA(1, 0, At, B0); PG8_MMA(1, 1, At, B1); PG8_BAR; PG8_SCHED;
        }
        if (wr == 0) PG8_BAR;
        epilogue(E, acc, cur, wr, wc, fr, fq);
        if (!has_next) break;
#pragma unroll
        for (int a = 0; a < 2; ++a)
#pragma unroll
            for (int b = 0; b < 2; ++b)
#pragma unroll
                for (int m = 0; m < 4; ++m)
#pragma unroll
                    for (int n = 0; n < 2; ++n) acc[a][b][m][n] = (f32x4){0.f, 0.f, 0.f, 0.f};
        cur = nxt; cA = nA; cB = nB; ++ui;
        if (wr == 1) PG8_BAR;
    }
    PG8_WAIT_V(0);
    PG8_BAR;
    }
#undef PG8_SA
#undef PG8_SB
#undef PG8_STAGE
#undef PG8_LDA
#undef PG8_LDB
#undef PG8_MMA
}

__device__ __forceinline__ void tri_inv64(const float* AM, float* TF, float* WSB, int tid) {
    const int lane = tid & 63, wave = tid >> 6;
    if (wave == 0) {
        const int bb = lane >> 4, cc = lane & 15;
        const float* Ab = AM + (16 * bb) * 68 + 16 * bb;
        float x[16];
#pragma unroll
        for (int i = 0; i < 16; ++i) {
            float a = (i == cc) ? 1.f : 0.f;
#pragma unroll
            for (int j = 0; j < i; ++j) a -= Ab[i * 68 + j] * x[j];
            x[i] = a;
            TF[(16 * bb + i) * 68 + 16 * bb + cc] = a;
        }
    }
    __syncthreads();
    {
        const int g = tid >> 8, i = (tid >> 4) & 15, c = tid & 15, o = 32 * g;
        const float* ar = AM + (o + 16 + i) * 68 + o;
        float acc = 0.f;
#pragma unroll
        for (int k = 0; k < 16; ++k) acc += ar[k] * TF[(o + k) * 68 + o + c];
        WSB[(o + 16 + i) * 68 + o + c] = acc;
        __syncthreads();
        const float* dr = TF + (o + 16 + i) * 68 + o + 16;
        acc = 0.f;
#pragma unroll
        for (int k = 0; k < 16; ++k) acc += dr[k] * WSB[(o + 16 + k) * 68 + o + c];
        TF[(o + 16 + i) * 68 + o + c] = -acc;
    }
    __syncthreads();
    {
        const int i = tid >> 4, c = tid & 15;
        const float* ar = AM + (32 + i) * 68;
        float a0 = 0.f, a1 = 0.f;
#pragma unroll
        for (int k = 0; k < 16; ++k) a0 += ar[k] * TF[k * 68 + c];
#pragma unroll
        for (int k = 16; k < 32; ++k) { const float av = ar[k]; a0 += av * TF[k * 68 + c]; a1 += av * TF[k * 68 + 16 + c]; }
        WSB[(32 + i) * 68 + c] = a0; WSB[(32 + i) * 68 + 16 + c] = a1;
        __syncthreads();
        const float* dr = TF + (32 + i) * 68 + 32;
        a0 = 0.f; a1 = 0.f;
#pragma unroll
        for (int k = 0; k < 16; ++k) { const float dv = dr[k]; a0 += dv * WSB[(32 + k) * 68 + c]; a1 += dv * WSB[(32 + k) * 68 + 16 + c]; }
        if (i >= 16) {
#pragma unroll
            for (int k = 16; k < 32; ++k) { const float dv = dr[k]; a0 += dv * WSB[(32 + k) * 68 + c]; a1 += dv * WSB[(32 + k) * 68 + 16 + c]; }
        }
        TF[(32 + i) * 68 + c] = -a0; TF[(32 + i) * 68 + 16 + c] = -a1;
    }
}
__device__ __forceinline__ int swz_el(int row, int t) { return row * 72 + ((((t >> 3) ^ (row >> 3)) & 7) << 3) + (t & 7); }
__device__ __forceinline__ int swz_ch(int row, int c8) { return row * 72 + (((c8 ^ (row >> 3)) & 7) << 3); }

__device__ __forceinline__ void phase_gdn_prep(const Ctx& cx, const Params& p, int l) {
    const int tid = cx.tid, lane = tid & 63, wave = tid >> 6, fr = lane & 15, fq = lane >> 4;
    bf16_t* QN = (bf16_t*)(smem);
    bf16_t* KN = (bf16_t*)(smem + 17408);
    bf16_t* KBG = (bf16_t*)(smem + 34816);
    bf16_t* VB = (bf16_t*)(smem + 53248);
    float* AM = (float*)(smem + 71680);
    bf16_t* TM = (bf16_t*)(smem + 89088);
    float* GV = (float*)(smem + 98304);
    float* TF = (float*)(smem + 99328);
    float* WSB = (float*)(smem + 116736);
    const bf16_t* PROJ = (const bf16_t*)(p.ws + WS_R1);
    bf16_t* PREP = (bf16_t*)(p.ws + WS_PREP);
    float* DL = (float*)(p.ws + WS_DL);
    const float* convw = p.in[11] + (size_t)l * 4 * 1536;
    const float* conv_state = p.in[5];
#ifndef REP_PREP
#define REP_PREP 1
#endif
    for (int rep = 0; rep < REP_PREP; ++rep)
    for (int u = cx.bid; u < 2080; u += cx.nb) {
        const int c = u >> 2, h = u & 3, t0 = c * 64;
        const bool prompt = c < 512;
        const bool first = prompt ? ((c & 31) == 0) : true;
        const int sb = prompt ? 0 : (c - 512);
        bf16_t* P = PREP + (size_t)u * PREP_STRIDE;
#pragma unroll 1
        for (int pb = 0; pb < 2; ++pb) {
        u32x4 rawc[3][4];
#pragma unroll
        for (int pi = 0; pi < 3; ++pi) {
            const int ps = pb * 3 + pi;
            const int t = (ps & 1) * 32 + wave * 4 + fq, ch0 = (ps >> 1) * 512 + h * 128 + fr * 8;
#pragma unroll
            for (int j = 0; j < 4; ++j) { const int tt = t - 3 + j; rawc[pi][j] = *(const u32x4*)(PROJ + (size_t)(t0 + ((tt >= 0 || !first) ? tt : 0)) * PJ + ch0); }
        }
        if (pb == 0) {
        if (tid < 64) {
                const float* gtr = (const float*)(p.ws + WS_GATE) + (size_t)(t0 + tid) * 8; const float ga = gtr[h], gb = gtr[4 + h];
                float g = -__expf(p.in[12][l * 4 + h]) * softplus_f(ga + p.in[13][l * 4 + h]);
                GV[64 + tid] = sigmoid_f(gb);
#pragma unroll
                for (int off = 1; off < 64; off <<= 1) { const float o = __shfl_up(g, off); g += (tid >= off) ? o : 0.f; }
                GV[tid] = g;
            }
            __syncthreads();
        }
#pragma unroll
        for (int pi = 0; pi < 3; ++pi) {
            const int ps = pb * 3 + pi;
            const int kind = ps >> 1, t = (ps & 1) * 32 + wave * 4 + fq, cgp = fr;
            const int ch0 = kind * 512 + h * 128 + cgp * 8;
            float y[8];
#pragma unroll
            for (int e = 0; e < 8; ++e) y[e] = 0.f;
#pragma unroll
            for (int j = 0; j < 4; ++j) {
                const int tt = t - 3 + j;
                float x[8];
                if (tt >= 0 || !first) {
                    unpack8(rawc[pi][j], x);
                } else if (!prompt) {
                    const float* cs = conv_state + ((size_t)(l * 8 + sb) * 3 + (tt + 3)) * 1536 + ch0;
                    const f32x4 a = *(const f32x4*)cs, b = *(const f32x4*)(cs + 4);
                    x[0] = a.x; x[1] = a.y; x[2] = a.z; x[3] = a.w; x[4] = b.x; x[5] = b.y; x[6] = b.z; x[7] = b.w;
                } else {
#pragma unroll
                    for (int e = 0; e < 8; ++e) x[e] = 0.f;
                }
                const f32x4 w0 = *(const f32x4*)(convw + j * 1536 + ch0), w1 = *(const f32x4*)(convw + j * 1536 + ch0 + 4);
                y[0] += x[0] * w0.x; y[1] += x[1] * w0.y; y[2] += x[2] * w0.z; y[3] += x[3] * w0.w;
                y[4] += x[4] * w1.x; y[5] += x[5] * w1.y; y[6] += x[6] * w1.z; y[7] += x[7] * w1.w;
            }
            float ss = 0.f;
#pragma unroll
            for (int e = 0; e < 8; ++e) { y[e] = silu_f(y[e]); ss += y[e] * y[e]; }
            const float gt = GV[t], bt = GV[64 + t];
            if (kind == 0) {
                ss = red16(ss);
                const float rn = rsqrtf(ss + 1e-6f) * 0.08838834764831845f;
                float q[8], qd[8]; const float eg = __expf(gt);
#pragma unroll
                for (int e = 0; e < 8; ++e) { q[e] = y[e] * rn; qd[e] = q[e] * eg; }
                *(u32x4*)(QN + t * 136 + cgp * 8) = pack8(q);
                *(u32x4*)(P + PO_QD + t * 128 + cgp * 8) = pack8(qd);
            } else if (kind == 1) {
                ss = red16(ss);
                const float rn = rsqrtf(ss + 1e-6f);
                float k[8]; const float sc2 = bt * __expf(gt);
#pragma unroll
                for (int e = 0; e < 8; ++e) { k[e] = y[e] * rn; KBG[swz_el(cgp * 8 + e, t)] = f2bf(k[e] * sc2); }
                *(u32x4*)(KN + t * 136 + cgp * 8) = pack8(k);
            } else {
#pragma unroll
                for (int e = 0; e < 8; ++e) VB[swz_el(cgp * 8 + e, t)] = f2bf(y[e] * bt);
            }
        }
        }
        __syncthreads();
        const float g_last = GV[63];
        if (h == 0 && (!prompt || (c & 31) == 31)) {
            float* co = p.out + (prompt ? O_PCONV + (size_t)(l * 16 + (c >> 5)) * 4608 : O_SCONV + (size_t)(l * 8 + sb) * 4608);
            for (int i = tid; i < 4608; i += 512) { const int r = i / 1536, ch = i % 1536; co[i] = bf2f(PROJ[(size_t)(t0 + 61 + r) * PJ + ch]); }
        }
        {
            const int d = tid >> 2, tq = tid & 3;
            float v[16];
#pragma unroll
            for (int i = 0; i < 16; ++i) { const int t = tq * 16 + i; v[i] = bf2f(KN[t * 136 + d]) * __expf(g_last - GV[t]); }
            *(u32x4*)(P + PO_KDT + d * 64 + tq * 16) = pack8(v);
            *(u32x4*)(P + PO_KDT + d * 64 + tq * 16 + 8) = pack8(v + 8);
        }
#pragma unroll
        for (int q = 0; q < 2; ++q) {
            const int tile = wave * 2 + q, tm = tile >> 2, tn = tile & 3;
            f32x4 akk = {0.f, 0.f, 0.f, 0.f}, aqk = {0.f, 0.f, 0.f, 0.f};
#pragma unroll
            for (int kk = 0; kk < 4; ++kk) {
                const bf16x8 ka = *(const bf16x8*)(KN + (tm * 16 + fr) * 136 + kk * 32 + fq * 8);
                const bf16x8 kb = *(const bf16x8*)(KN + (tn * 16 + fr) * 136 + kk * 32 + fq * 8);
                const bf16x8 qb = *(const bf16x8*)(QN + (tn * 16 + fr) * 136 + kk * 32 + fq * 8);
                akk = __builtin_amdgcn_mfma_f32_16x16x32_bf16(ka, kb, akk, 0, 0, 0);
                aqk = __builtin_amdgcn_mfma_f32_16x16x32_bf16(ka, qb, aqk, 0, 0, 0);
            }
            {
                const int i = tn * 16 + fr; const float gi = GV[i];
#pragma unroll
                for (int j = 0; j < 4; ++j) { const int t = tm * 16 + fq * 4 + j; AM[t * 68 + i] = (t > i) ? GV[64 + t] * akk[j] * __expf(GV[t] - gi) : 0.f; }
            }
            {
                const int t = tn * 16 + fr; const float gtt = GV[t]; float o[4];
#pragma unroll
                for (int j = 0; j < 4; ++j) { const int i = tm * 16 + fq * 4 + j; o[j] = (t >= i) ? aqk[j] * __expf(gtt - GV[i]) : 0.f; }
                u32x2 w; w.x = cvt_pk_bf16(o[0], o[1]); w.y = cvt_pk_bf16(o[2], o[3]);
                *(u32x2*)(P + PO_QK + t * 64 + tm * 16 + fq * 4) = w;
            }
        }
        __syncthreads();
        tri_inv64(AM, TF, WSB, tid);
        __syncthreads();
        for (int e = tid; e < 4096; e += 512) {
            const int i = e >> 6, cc = e & 63;
            TM[i * 72 + cc] = ((cc >> 4) <= (i >> 4)) ? f2bf(TF[i * 68 + cc]) : (bf16_t)0;
        }
        if (tid == 64) DL[u] = __expf(g_last);
        __syncthreads();
        {
            const int tm = wave & 3, vh = wave >> 2;
            bf16x8 ta[2];
#pragma unroll
            for (int kk = 0; kk < 2; ++kk) ta[kk] = *(const bf16x8*)(TM + (tm * 16 + fr) * 72 + kk * 32 + fq * 8);
#pragma unroll
            for (int n = 0; n < 4; ++n) {
                const int v = (vh * 4 + n) * 16 + fr;
                f32x4 a = {0.f, 0.f, 0.f, 0.f};
#pragma unroll
                for (int kk = 0; kk < 2; ++kk) a = __builtin_amdgcn_mfma_f32_16x16x32_bf16(ta[kk], *(const bf16x8*)(VB + swz_ch(v, kk * 4 + fq)), a, 0, 0, 0);
                u32x2 w; w.x = cvt_pk_bf16(a[0], a[1]); w.y = cvt_pk_bf16(a[2], a[3]);
                *(u32x2*)(P + PO_U0T + v * 64 + tm * 16 + fq * 4) = w;
            }
            bf16x8 ka[2];
#pragma unroll
            for (int kk = 0; kk < 2; ++kk) ka[kk] = *(const bf16x8*)(KBG + swz_ch(wave * 16 + fr, kk * 4 + fq));
#pragma unroll
            for (int tn = 0; tn < 4; ++tn) {
                f32x4 a = {0.f, 0.f, 0.f, 0.f};
#pragma unroll
                for (int kk = 0; kk < 2; ++kk) a = __builtin_amdgcn_mfma_f32_16x16x32_bf16(ka[kk], *(const bf16x8*)(TM + (tn * 16 + fr) * 72 + kk * 32 + fq * 8), a, 0, 0, 0);
                u32x2 w; w.x = cvt_pk_bf16(-a[0], -a[1]); w.y = cvt_pk_bf16(-a[2], -a[3]);
                *(u32x2*)(P + PO_WKN + (tn * 16 + fr) * 128 + wave * 16 + fq * 4) = w;
            }
        }
        __syncthreads();
    }
}

__device__ __forceinline__ void gdn_scan_unit(const Ctx& cx, const Params& p, int l, int seq, int h) {
    const int tid = cx.tid, lane = tid & 63, wave = tid >> 6, fr = lane & 15, fq = lane >> 4;
    bf16_t* ST = (bf16_t*)(smem);
    bf16_t* UT = (bf16_t*)(smem + 34816);
    float* OB = (float*)(smem + 53248);
    const bf16_t* PROJ = (const bf16_t*)(p.ws + WS_R1);
    const bf16_t* PREP = (const bf16_t*)(p.ws + WS_PREP);
    const float* DL = (const float*)(p.ws + WS_DL);
    bf16_t* YIN = (bf16_t*)(p.ws + WS_H);
    const bool prompt = seq < 16;
    const int b = prompt ? seq : seq - 16;
    const int nch = prompt ? 32 : 1;
    const float* nw = p.in[14] + l * 128;
    f32x4 S[8];
    if (prompt) {
#pragma unroll
        for (int n = 0; n < 8; ++n) S[n] = (f32x4){0.f, 0.f, 0.f, 0.f};
    } else {
        const float* s0 = p.in[4] + ((size_t)(l * 8 + b) * 4 + h) * 16384;
#pragma unroll
        for (int n = 0; n < 8; ++n)
#pragma unroll
            for (int j = 0; j < 4; ++j) S[n][j] = s0[(wave * 16 + fq * 4 + j) * 128 + n * 16 + fr];
    }
#pragma unroll
    for (int n = 0; n < 8; ++n) { u32x2 w; w.x = cvt_pk_bf16(S[n][0], S[n][1]); w.y = cvt_pk_bf16(S[n][2], S[n][3]); *(u32x2*)(ST + (n * 16 + fr) * 136 + wave * 16 + fq * 4) = w; }
    __syncthreads();
    const int tm = wave & 3, vh = wave >> 2;
#pragma unroll 1
    for (int ci = 0; ci < nch; ++ci) {
        const int c = prompt ? seq * 32 + ci : 512 + b;
        const int u = c * 4 + h, t0 = c * 64;
        const bf16_t* P = PREP + (size_t)u * PREP_STRIDE;
        bf16x8 wkn[4], qd[4], qk[2], kdt[2];
#pragma unroll
        for (int kk = 0; kk < 4; ++kk) { wkn[kk] = *(const bf16x8*)(P + PO_WKN + (tm * 16 + fr) * 128 + kk * 32 + fq * 8); qd[kk] = *(const bf16x8*)(P + PO_QD + (tm * 16 + fr) * 128 + kk * 32 + fq * 8); }
#pragma unroll
        for (int kk = 0; kk < 2; ++kk) { qk[kk] = *(const bf16x8*)(P + PO_QK + (tm * 16 + fr) * 64 + kk * 32 + fq * 8); kdt[kk] = *(const bf16x8*)(P + PO_KDT + (wave * 16 + fr) * 64 + kk * 32 + fq * 8); }
        f32x4 U[4], O[4];
#pragma unroll
        for (int n = 0; n < 4; ++n) {
            const u32x2 w = *(const u32x2*)(P + PO_U0T + ((vh * 4 + n) * 16 + fr) * 64 + tm * 16 + fq * 4);
            U[n] = (f32x4){bflo(w.x), bfhi(w.x), bflo(w.y), bfhi(w.y)};
            O[n] = (f32x4){0.f, 0.f, 0.f, 0.f};
        }
        const float dl = DL[u];
#pragma unroll
        for (int kk = 0; kk < 4; ++kk)
#pragma unroll
            for (int n = 0; n < 4; ++n) {
                const bf16x8 sf = *(const bf16x8*)(ST + ((vh * 4 + n) * 16 + fr) * 136 + kk * 32 + fq * 8);
                U[n] = __builtin_amdgcn_mfma_f32_16x16x32_bf16(wkn[kk], sf, U[n], 0, 0, 0);
                O[n] = __builtin_amdgcn_mfma_f32_16x16x32_bf16(qd[kk], sf, O[n], 0, 0, 0);
            }
#pragma unroll
        for (int n = 0; n < 4; ++n) { u32x2 w; w.x = cvt_pk_bf16(U[n][0], U[n][1]); w.y = cvt_pk_bf16(U[n][2], U[n][3]); *(u32x2*)(UT + ((vh * 4 + n) * 16 + fr) * 72 + tm * 16 + fq * 4) = w; }
        __syncthreads();
#pragma unroll
        for (int kk = 0; kk < 2; ++kk)
#pragma unroll
            for (int n = 0; n < 4; ++n) O[n] = __builtin_amdgcn_mfma_f32_16x16x32_bf16(qk[kk], *(const bf16x8*)(UT + ((vh * 4 + n) * 16 + fr) * 72 + kk * 32 + fq * 8), O[n], 0, 0, 0);
#pragma unroll
        for (int n = 0; n < 8; ++n) {
            S[n] = S[n] * dl;
#pragma unroll
            for (int kk = 0; kk < 2; ++kk) S[n] = __builtin_amdgcn_mfma_f32_16x16x32_bf16(kdt[kk], *(const bf16x8*)(UT + (n * 16 + fr) * 72 + kk * 32 + fq * 8), S[n], 0, 0, 0);
        }
        __syncthreads();
#pragma unroll
        for (int n = 0; n < 8; ++n) { u32x2 w; w.x = cvt_pk_bf16(S[n][0], S[n][1]); w.y = cvt_pk_bf16(S[n][2], S[n][3]); *(u32x2*)(ST + (n * 16 + fr) * 136 + wave * 16 + fq * 4) = w; }
#pragma unroll
        for (int n = 0; n < 4; ++n)
#pragma unroll
            for (int j = 0; j < 4; ++j) OB[(tm * 16 + fq * 4 + j) * 132 + (vh * 4 + n) * 16 + fr] = O[n][j];
        __syncthreads();
        {
            const int t = tid >> 3, part = tid & 7;
            float o[16]; float ss = 0.f;
#pragma unroll
            for (int q = 0; q < 4; ++q) { const f32x4 v = *(const f32x4*)(OB + t * 132 + part * 16 + q * 4); o[4 * q] = v.x; o[4 * q + 1] = v.y; o[4 * q + 2] = v.z; o[4 * q + 3] = v.w; ss += v.x * v.x + v.y * v.y + v.z * v.z + v.w * v.w; }
            ss = red8(ss);
            const float rstd = rsqrtf(ss * (1.f / 128.f) + 1e-6f);
            const bf16_t* zp = PROJ + (size_t)(t0 + t) * PJ + C_Z + h * 128 + part * 16;
            float z[16]; unpack8(*(const u32x4*)zp, z); unpack8(*(const u32x4*)(zp + 8), z + 8);
#pragma unroll
            for (int e = 0; e < 16; ++e) o[e] = o[e] * rstd * nw[part * 16 + e] * silu_f(z[e]);
            bf16_t* yp = YIN + (size_t)(t0 + t) * 1024 + h * 128 + part * 16;
            *(u32x4*)yp = pack8(o); *(u32x4*)(yp + 8) = pack8(o + 8);
        }
    }
    {
        float* so = p.out + (prompt ? O_PGDN + ((size_t)(l * 16 + b) * 4 + h) * 16384 : O_SGDN + ((size_t)(l * 8 + b) * 4 + h) * 16384);
#pragma unroll
        for (int n = 0; n < 8; ++n)
#pragma unroll
            for (int j = 0; j < 4; ++j) so[(wave * 16 + fq * 4 + j) * 128 + n * 16 + fr] = S[n][j];
    }
    __syncthreads();
}

__device__ __forceinline__ void phase_rwkv_prep(const Ctx& cx, const Params& p, int l) {
    const int tid = cx.tid, lane = tid & 63, wave = tid >> 6, fr = lane & 15, fq = lane >> 4;
    bf16_t* XW = (bf16_t*)(smem);
    bf16_t* XA = (bf16_t*)(smem + 9216);
    bf16_t* XG = (bf16_t*)(smem + 18432);
    bf16_t* PROJ = (bf16_t*)(p.ws + WS_R1);
    const bf16_t* LW2 = (const bf16_t*)(p.ws + WS_LW2); const bf16_t* LA2 = (const bf16_t*)(p.ws + WS_LA2); const bf16_t* LG2 = (const bf16_t*)(p.ws + WS_LG2);
    const float* mu = p.in[15] + l * RWP;
#ifndef REP_RP
#define REP_RP 1
#endif
    for (int rep = 0; rep < REP_RP; ++rep)
    for (int c = cx.bid; c < 520; c += cx.nb) {
        const int t0 = c * 64;
        const bool prompt = c < 512;
        const bool first = prompt ? ((c & 31) == 0) : true;
        const float* shift_state = p.in[7] + (size_t)(l * 8 + (prompt ? 0 : c - 512)) * RWP;
        {
            const int t = tid >> 3, part = tid & 7;
#pragma unroll
            for (int q = 0; q < 4; ++q) {
                const int cl = part * 32 + q * 8;
                const int idx0 = 1536 + cl;
                float cur[8], prv[8], o[8];
                unpack8(*(const u32x4*)(PROJ + (size_t)(t0 + t) * PJ + C_RW + idx0), cur);
                if (t > 0 || !first) unpack8(*(const u32x4*)(PROJ + (size_t)(t0 + t - 1) * PJ + C_RW + idx0), prv);
                else if (!prompt) {
#pragma unroll
                    for (int e = 0; e < 8; ++e) prv[e] = shift_state[idx0 + e];
                } else {
#pragma unroll
                    for (int e = 0; e < 8; ++e) prv[e] = 0.f;
                }
#pragma unroll
                for (int e = 0; e < 8; ++e) {
                    const float x = cur[e] + (prv[e] - cur[e]) * mu[idx0 + e];
                    o[e] = cl < 64 ? tanh_f(x) : (cl < 128 ? x : sigmoid_f(x));
                }
                bf16_t* dst = cl < 64 ? XW + t * 72 + cl : (cl < 128 ? XA + t * 72 + (cl - 64) : XG + t * 136 + (cl - 128));
                *(u32x4*)dst = pack8(o);
            }
        }
        __syncthreads();
#pragma unroll 1
        for (int cp = 0; cp < 2; ++cp) {
            const int cb = wave * 64 + cp * 32;
            bf16x8 bw[2][2], ba[2][2], bg[2][4];
#pragma unroll
            for (int n = 0; n < 2; ++n) {
                const int nrow = cb + 8 * (fr >> 2) + 4 * n + (fr & 3);
#pragma unroll
                for (int kk = 0; kk < 2; ++kk) { bw[n][kk] = *(const bf16x8*)(LW2 + nrow * 64 + kk * 32 + fq * 8); ba[n][kk] = *(const bf16x8*)(LA2 + nrow * 64 + kk * 32 + fq * 8); }
#pragma unroll
                for (int kk = 0; kk < 4; ++kk) bg[n][kk] = *(const bf16x8*)(LG2 + nrow * 128 + kk * 32 + fq * 8);
            }
            const int ch = cb + 8 * fq;
            f32x4 w0[2], a0[2];
#pragma unroll
            for (int n = 0; n < 2; ++n) { w0[n] = *(const f32x4*)(p.in[16] + l * 512 + ch + 4 * n); a0[n] = *(const f32x4*)(p.in[18] + l * 512 + ch + 4 * n); }
#pragma unroll 1
            for (int tm = 0; tm < 4; ++tm) {
                f32x4 dw[2], da[2], dg[2];
#pragma unroll
                for (int n = 0; n < 2; ++n) { dw[n] = (f32x4){0.f, 0.f, 0.f, 0.f}; da[n] = dw[n]; dg[n] = dw[n]; }
#pragma unroll
                for (int kk = 0; kk < 2; ++kk) {
                    const bf16x8 xw = *(const bf16x8*)(XW + (tm * 16 + fr) * 72 + kk * 32 + fq * 8), xa = *(const bf16x8*)(XA + (tm * 16 + fr) * 72 + kk * 32 + fq * 8);
#pragma unroll
                    for (int n = 0; n < 2; ++n) { dw[n] = __builtin_amdgcn_mfma_f32_16x16x32_bf16(bw[n][kk], xw, dw[n], 0, 0, 0); da[n] = __builtin_amdgcn_mfma_f32_16x16x32_bf16(ba[n][kk], xa, da[n], 0, 0, 0); }
                }
#pragma unroll
                for (int kk = 0; kk < 4; ++kk) {
                    const bf16x8 xg = *(const bf16x8*)(XG + (tm * 16 + fr) * 136 + kk * 32 + fq * 8);
#pragma unroll
                    for (int n = 0; n < 2; ++n) dg[n] = __builtin_amdgcn_mfma_f32_16x16x32_bf16(bg[n][kk], xg, dg[n], 0, 0, 0);
                }
                float dv[8], av[8];
#pragma unroll
                for (int n = 0; n < 2; ++n)
#pragma unroll
                    for (int j = 0; j < 4; ++j) {
                        dv[4 * n + j] = __expf(-softplus_f(-(w0[n][j] + dw[n][j])) - 0.5f);
                        av[4 * n + j] = sigmoid_f(a0[n][j] + da[n][j]);
                    }
                bf16_t* orow = PROJ + (size_t)(t0 + tm * 16 + fr) * PJ + ch;
                *(u32x4*)(orow) = pack8(dv);
                *(u32x4*)(orow + 512) = pack8(av);
                u32x4 og; og.x = cvt_pk_bf16(dg[0][0], dg[0][1]); og.y = cvt_pk_bf16(dg[0][2], dg[0][3]); og.z = cvt_pk_bf16(dg[1][0], dg[1][1]); og.w = cvt_pk_bf16(dg[1][2], dg[1][3]);
                *(u32x4*)(orow + 1024) = og;
            }
        }
        __syncthreads();
    }
}

__device__ __forceinline__ void rwkv_scan_unit(const Ctx& cx, const Params& p, int l, int seq, int h) {
    const int tid = cx.tid, lane = tid & 63, wave = tid >> 6, fr = lane & 15, fq = lane >> 4;
    float* B0 = (float*)(smem);
    float* B1 = (float*)(smem + 16384);
    float* B2 = (float*)(smem + 32768);
    float* B3 = (float*)(smem + 49152);
    float* B4 = (float*)(smem + 65536);
    float* B5 = (float*)(smem + 81920);
    float* B6 = (float*)(smem + 98304);
    float* B7 = (float*)(smem + 114688);
    float* SCL = (float*)(smem + 131072);
    const bf16_t* PROJ = (const bf16_t*)(p.ws + WS_R1);
    bf16_t* YIN = (bf16_t*)(p.ws + WS_H);
    const bool prompt = seq < 16;
    const int b = prompt ? seq : seq - 16;
    const int nch = prompt ? 32 : 1;
    const float* mu = p.in[15] + l * RWP;
    const float* shift_state = p.in[7] + (size_t)(l * 8 + b) * RWP;
    const int row = tid >> 3, sub = tid & 7;
    const int r0 = tid >> 4, l16 = tid & 15;
    f32x2 S0[2], S1[2];
    if (prompt) {
#pragma unroll
        for (int q = 0; q < 2; ++q) { S0[q] = (f32x2){0.f, 0.f}; S1[q] = (f32x2){0.f, 0.f}; }
    } else {
        const float* s0 = p.in[6] + ((size_t)(l * 8 + b) * 8 + h) * 4096 + l16 * 4;
#pragma unroll
        for (int q = 0; q < 2; ++q) { S0[q] = *(const f32x2*)(s0 + r0 * 64 + 2 * q); S1[q] = *(const f32x2*)(s0 + (r0 + 32) * 64 + 2 * q); }
    }
#pragma unroll 1
    for (int ci = 0; ci < nch; ++ci) {
        const int t0 = prompt ? (seq * 32 + ci) * 64 : NTP + b * 64;
        const bool first = (ci == 0);
        {
            const int t = row, c0 = h * 64 + sub * 8, ch0 = l * 512 + c0;
            const bf16_t* prow = PROJ + (size_t)(t0 + t) * PJ;
            float r[8], k[8], v[8], dd[8], a[8], g[8];
            {
                float cur[8], prv[8];
#pragma unroll
                for (int kind = 0; kind < 3; ++kind) {
                    const int idx0 = kind * 512 + c0;
                    unpack8(*(const u32x4*)(prow + C_RW + idx0), cur);
                    if (t > 0 || !first) unpack8(*(const u32x4*)(prow - PJ + C_RW + idx0), prv);
                    else if (!prompt) {
#pragma unroll
                        for (int e = 0; e < 8; ++e) prv[e] = shift_state[idx0 + e];
                    } else {
#pragma unroll
                        for (int e = 0; e < 8; ++e) prv[e] = 0.f;
                    }
                    float* dst = kind == 0 ? r : (kind == 1 ? k : v);
#pragma unroll
                    for (int e = 0; e < 8; ++e) dst[e] = cur[e] + (prv[e] - cur[e]) * mu[idx0 + e];
                }
            }
            unpack8(*(const u32x4*)(prow + c0), dd); unpack8(*(const u32x4*)(prow + 512 + c0), a); unpack8(*(const u32x4*)(prow + 1024 + c0), g);
            float ss = 0.f, c1 = 0.f, c2 = 0.f, bn = 0.f;
            float kkv[8];
#pragma unroll
            for (int e = 0; e < 8; ++e) { kkv[e] = k[e] * p.in[21][ch0 + e]; ss += kkv[e] * kkv[e]; }
            ss = red8(ss);
            const float rn = rsqrtf(ss + 1e-6f);
#pragma unroll
            for (int e = 0; e < 8; ++e) {
                const float w = __expf(-dd[e]);
                const float kkn = kkv[e] * rn, ka = kkn * a[e];
                const float k2 = k[e] * (1.f + (a[e] - 1.f) * p.in[22][ch0 + e]);
                B6[t * 64 + sub * 8 + e] = kkn; B7[t * 64 + sub * 8 + e] = ka; B1[t * 64 + sub * 8 + e] = k2; B0[t * 64 + sub * 8 + e] = w * r[e];
                B3[t * 64 + sub * 8 + e] = w; B2[t * 64 + sub * 8 + e] = v[e]; B5[t * 64 + sub * 8 + e] = g[e];
                c1 += ka * r[e]; c2 += k2 * r[e]; bn += r[e] * k2 * p.in[23][ch0 + e];
            }
            c1 = red8(c1); c2 = red8(c2); bn = red8(bn);
            if (sub == 0) { SCL[t] = c1; SCL[64 + t] = c2; SCL[128 + t] = bn; }
        }
        __syncthreads();
        {
            const f32x4* KKp = (const f32x4*)(B6 + l16 * 4); const f32x4* WRp = (const f32x4*)(B0 + l16 * 4); const f32x4* Wp = (const f32x4*)(B3 + l16 * 4);
            const f32x4* KAp = (const f32x4*)(B7 + l16 * 4); const f32x4* K2p = (const f32x4*)(B1 + l16 * 4);
#pragma unroll 2
            for (int t = 0; t < 64; ++t) {
                const f32x4 kk4 = KKp[t * 16], wr4 = WRp[t * 16], w4 = Wp[t * 16], ka4 = KAp[t * 16], k24 = K2p[t * 16];
                const f32x2 kk[2] = {{kk4.x, kk4.y}, {kk4.z, kk4.w}}, wrr[2] = {{wr4.x, wr4.y}, {wr4.z, wr4.w}}, ww[2] = {{w4.x, w4.y}, {w4.z, w4.w}};
                const f32x2 ka[2] = {{ka4.x, ka4.y}, {ka4.z, ka4.w}}, k2[2] = {{k24.x, k24.y}, {k24.z, k24.w}};
                const float v0 = B2[t * 64 + r0], v1 = B2[t * 64 + r0 + 32], c1 = SCL[t], c2 = SCL[64 + t];
                f32x2 a0 = S0[0] * kk[0], b0 = S0[0] * wrr[0], a1 = S1[0] * kk[0], b1 = S1[0] * wrr[0];
                a0 = __builtin_elementwise_fma(S0[1], kk[1], a0); b0 = __builtin_elementwise_fma(S0[1], wrr[1], b0);
                a1 = __builtin_elementwise_fma(S1[1], kk[1], a1); b1 = __builtin_elementwise_fma(S1[1], wrr[1], b1);
                float d10 = a0.x + a0.y, d20 = b0.x + b0.y, d11 = a1.x + a1.y, d21 = b1.x + b1.y;
                d10 += dpp_x1(d10); d11 += dpp_x1(d11); d20 += dpp_x1(d20); d21 += dpp_x1(d21);
                d10 += dpp_x2(d10); d11 += dpp_x2(d11); d20 += dpp_x2(d20); d21 += dpp_x2(d21);
                d10 += dpp_hm(d10); d11 += dpp_hm(d11); d20 += dpp_hm(d20); d21 += dpp_hm(d21);
                d10 += dpp_rm(d10); d11 += dpp_rm(d11); d20 += dpp_rm(d20); d21 += dpp_rm(d21);
                const float sa0 = -d10, sa1 = -d11;
                const f32x2 sa02 = {sa0, sa0}, sa12 = {sa1, sa1}, v02 = {v0, v0}, v12 = {v1, v1};
#pragma unroll
                for (int q = 0; q < 2; ++q) {
                    S0[q] = __builtin_elementwise_fma(S0[q], ww[q], __builtin_elementwise_fma(sa02, ka[q], v02 * k2[q]));
                    S1[q] = __builtin_elementwise_fma(S1[q], ww[q], __builtin_elementwise_fma(sa12, ka[q], v12 * k2[q]));
                }
                if (l16 == 0) { B4[t * 64 + r0] = d20 + sa0 * c1 + v0 * c2; B4[t * 64 + r0 + 32] = d21 + sa1 * c1 + v1 * c2; }
            }
        }
        __syncthreads();
        {
            const int t = row, ch0 = l * 512 + h * 64 + sub * 8;
            float o[8]; float s = 0.f;
#pragma unroll
            for (int e = 0; e < 8; ++e) { o[e] = B4[t * 64 + sub * 8 + e]; s += o[e]; }
            const float mean = red8(s) * (1.f / 64.f); float s2 = 0.f;
#pragma unroll
            for (int e = 0; e < 8; ++e) { o[e] -= mean; s2 += o[e] * o[e]; }
            const float rstd = rsqrtf(red8(s2) * (1.f / 64.f) + 64e-5f);
            const float bn = SCL[128 + t];
#pragma unroll
            for (int e = 0; e < 8; ++e) o[e] = (o[e] * rstd * p.in[24][ch0 + e] + p.in[25][ch0 + e] + bn * B2[t * 64 + sub * 8 + e]) * B5[t * 64 + sub * 8 + e];
            *(u32x4*)(YIN + (size_t)(t0 + t) * 1024 + 512 + h * 64 + sub * 8) = pack8(o);
        }
        __syncthreads();
    }
    {
        float* so = p.out + (prompt ? O_PRW + ((size_t)(l * 16 + b) * 8 + h) * 4096 : O_SRW + ((size_t)(l * 8 + b) * 8 + h) * 4096) + l16 * 4;
#pragma unroll
        for (int q = 0; q < 2; ++q) { *(f32x2*)(so + r0 * 64 + 2 * q) = S0[q]; *(f32x2*)(so + (r0 + 32) * 64 + 2 * q) = S1[q]; }
        if (h == 0) {
            const int tlast = prompt ? (seq + 1) * 2048 - 1 : NTP + (b + 1) * 64 - 1;
            float* sh = p.out + (prompt ? O_PSHIFT + (size_t)(l * 16 + b) * RWP : O_SSHIFT + (size_t)(l * 8 + b) * RWP);
            for (int i = tid; i < RWP; i += 512) sh[i] = bf2f(PROJ[(size_t)tlast * PJ + C_RW + i]);
        }
    }
    __syncthreads();
}

__device__ __forceinline__ void rwkv_chunk_unit(const Ctx& cx, const Params& p, int l, int seq, int h) {
    const int tid = cx.tid, lane = tid & 63, wave = tid >> 6, fr = lane & 15, fq = lane >> 4;
    constexpr int MS = 72;
    bf16_t* R0 = (bf16_t*)(smem);
    bf16_t* R2 = (bf16_t*)(smem + 9216);
    bf16_t* R3 = (bf16_t*)(smem + 18432);
    bf16_t* R1 = (bf16_t*)(smem + 27648);
    bf16_t* R4 = (bf16_t*)(smem + 36864);
    bf16_t* R5 = (bf16_t*)(smem + 46080);
    bf16_t* R6 = (bf16_t*)(smem + 55296);
    bf16_t* R7 = (bf16_t*)(smem + 64512);
    bf16_t* R8 = (bf16_t*)(smem + 73728);
    bf16_t* R9 = (bf16_t*)(smem + 82944);
    bf16_t* R10 = (bf16_t*)(smem + 92160);
    bf16_t* PT = (bf16_t*)(smem + 101376);
    float* GA = (float*)(smem + 110592);
    float* OW = (float*)(smem + 128000);
    float* GC = (float*)(smem + 145408);
    float* PRM = (float*)(smem + 145664);
    float* TF = (float*)(smem);
    const bf16_t* PROJ = (const bf16_t*)(p.ws + WS_R1);
    bf16_t* YIN = (bf16_t*)(p.ws + WS_H);
    const bool prompt = seq < 16;
    const int b = prompt ? seq : seq - 16;
    const int nch = prompt ? 32 : 1;
    const float* mu = p.in[15] + l * RWP;
    const float* shift_state = p.in[7] + (size_t)(l * 8 + b) * RWP;
    const int row = tid >> 3, sub = tid & 7;
    const int tm = wave & 3, ih = (wave >> 2) * 2;
    f32x4 Pacc[2];
#pragma unroll
    for (int q = 0; q < 2; ++q) Pacc[q] = (f32x4){0.f, 0.f, 0.f, 0.f};
    if (!prompt) {
        const float* s0 = p.in[6] + ((size_t)(l * 8 + b) * 8 + h) * 4096;
#pragma unroll
        for (int q = 0; q < 2; ++q)
#pragma unroll
            for (int jj = 0; jj < 4; ++jj) Pacc[q][jj] = s0[((ih + q) * 16 + fr) * 64 + tm * 16 + fq * 4 + jj];
    }
#pragma unroll
    for (int q = 0; q < 2; ++q) { u32x2 w; w.x = cvt_pk_bf16(Pacc[q][0], Pacc[q][1]); w.y = cvt_pk_bf16(Pacc[q][2], Pacc[q][3]); *(u32x2*)(PT + ((ih + q) * 16 + fr) * MS + tm * 16 + fq * 4) = w; }
    {
        const int pk = tid >> 6, pc = tid & 63;
        const float* s21 = p.in[21]; const float* s22 = p.in[22]; const float* s23 = p.in[23]; const float* s24 = p.in[24]; const float* s25 = p.in[25];
        const float* src = pk < 3 ? mu + pk * 512 + h * 64 : (pk == 3 ? s21 : (pk == 4 ? s22 : (pk == 5 ? s23 : (pk == 6 ? s24 : s25)))) + l * 512 + h * 64;
        PRM[pk * 64 + pc] = src[pc];
    }
    __syncthreads();
    u32x4 nx[9];
    {
        const int t_ = cx.tid >> 3, c_ = (cx.tid & 7) * 8;
        const int t0_ = prompt ? (seq * 32) * 64 : NTP + b * 64;
        const bf16_t* pr = PROJ + (size_t)(t0_ + t_) * PJ + h * 64 + c_;
        const bf16_t* pp = t_ > 0 ? pr - PJ : pr;
#pragma unroll
        for (int q = 0; q < 3; ++q) { nx[q] = *(const u32x4*)(pr + C_RW + q * 512); nx[3 + q] = *(const u32x4*)(pp + C_RW + q * 512); nx[6 + q] = *(const u32x4*)(pr + q * 512); }
    }
#pragma unroll 1
    for (int ci = 0; ci < nch; ++ci) {
        const int t0 = prompt ? (seq * 32 + ci) * 64 : NTP + b * 64;
        const bool first = (ci == 0);
        int tq = cx.tid; asm volatile("" : "+v"(tq));
        const int tid = tq, lane = tid & 63, wave = tid >> 6, fr = lane & 15, fq = lane >> 4, row = tid >> 3, sub = tid & 7, tm = wave & 3, ih = (wave >> 2) * 2;
        const int t = row, c0 = sub * 8, ch0 = l * 512 + h * 64 + c0;
        float v[8], g[8], bn;
        {
            float r[8], k[8], dd[8], a[8], kkn[8], be[8], k2[8];
            u32x4 raw[9];
#pragma unroll
            for (int q = 0; q < 9; ++q) raw[q] = nx[q];
            if (ci + 1 < nch) {
                const bf16_t* pr = PROJ + (size_t)(t0 + 64 + t) * PJ + h * 64 + c0;
#pragma unroll
                for (int q = 0; q < 3; ++q) { nx[q] = *(const u32x4*)(pr + C_RW + q * 512); nx[3 + q] = *(const u32x4*)(pr - PJ + C_RW + q * 512); nx[6 + q] = *(const u32x4*)(pr + q * 512); }
            }
            {
                float cur[8], prv[8];
#pragma unroll
                for (int kind = 0; kind < 3; ++kind) {
                    const int idx0 = kind * 512 + h * 64 + c0;
                    unpack8(raw[kind], cur);
                    if (t > 0 || !first) unpack8(raw[3 + kind], prv);
                    else if (!prompt) {
#pragma unroll
                        for (int e = 0; e < 8; ++e) prv[e] = shift_state[idx0 + e];
                    } else {
#pragma unroll
                        for (int e = 0; e < 8; ++e) prv[e] = 0.f;
                    }
                    float* dst = kind == 0 ? r : (kind == 1 ? k : v);
#pragma unroll
                    for (int e = 0; e < 8; ++e) dst[e] = cur[e] + (prv[e] - cur[e]) * PRM[kind * 64 + c0 + e];
                }
            }
            unpack8(raw[6], dd); unpack8(raw[7], a); unpack8(raw[8], g);
            float ss = 0.f; bn = 0.f;
#pragma unroll
            for (int e = 0; e < 8; ++e) { kkn[e] = k[e] * PRM[192 + c0 + e]; ss += kkn[e] * kkn[e]; }
            ss = red8(ss);
            const float rn = rsqrtf(ss + 1e-6f);
#pragma unroll
            for (int e = 0; e < 8; ++e) {
                kkn[e] *= rn; be[e] = kkn[e] * a[e];
                k2[e] = k[e] * (1.f + (a[e] - 1.f) * PRM[256 + c0 + e]);
                bn += r[e] * k2[e] * PRM[320 + c0 + e];
                R8[swz_el(c0 + e, t)] = f2bf(dd[e]);
            }
            bn = red8(bn);
            __syncthreads();
#pragma unroll
            for (int q = 0; q < 2; ++q) {
                const int jt = ih + q;
                f32x4 gacc = {0.f, 0.f, 0.f, 0.f};
#pragma unroll
                for (int kk = 0; kk < 2; ++kk) {
                    bf16x8 lt;
#pragma unroll
                    for (int e = 0; e < 8; ++e) lt[e] = (kk * 32 + fq * 8 + e <= tm * 16 + fr) ? (short)0x3F80 : (short)0;
                    gacc = __builtin_amdgcn_mfma_f32_16x16x32_bf16(lt, *(const bf16x8*)(R8 + swz_ch(jt * 16 + fr, kk * 4 + fq)), gacc, 0, 0, 0);
                }
#pragma unroll
                for (int jj = 0; jj < 4; ++jj) GA[(tm * 16 + fq * 4 + jj) * 64 + jt * 16 + fr] = gacc[jj];
            }
            __syncthreads();
            {
                float at[8], bt[8], kt[8], rt[8];
#pragma unroll
                for (int e = 0; e < 8; ++e) {
                    const int j = c0 + e;
                    const float Gt = GA[t * 64 + j], Gp = t > 0 ? GA[(t - 1) * 64 + j] : 0.f, Gc = GA[63 * 64 + j];
                    const float em = __expf(-Gp), ep = __expf(Gt), en = __expf(-Gt), ec = __expf(Gt - Gc);
                    at[e] = -kkn[e] * em; bt[e] = be[e] * ep; kt[e] = k2[e] * ep; rt[e] = r[e] * en;
                    const int so = swz_el(j, t);
                    R5[so] = f2bf(be[e] * ec); R6[so] = f2bf(k2[e] * ec); R7[so] = f2bf(v[e]);
                    if (t == 63) GC[j] = __expf(-Gc);
                }
                *(u32x4*)(R0 + t * MS + c0) = pack8(at); *(u32x4*)(R2 + t * MS + c0) = pack8(bt); *(u32x4*)(R3 + t * MS + c0) = pack8(kt); *(u32x4*)(R4 + t * MS + c0) = pack8(rt);
            }
        }
        __syncthreads();
#pragma unroll
        for (int q = 0; q < 2; ++q) {
            const int tile = wave * 2 + q, sm = tile >> 2, tn = tile & 3;
            f32x4 lb = {0.f, 0.f, 0.f, 0.f}, lk = lb, mb = lb, mk = lb;
#pragma unroll
            for (int kk = 0; kk < 2; ++kk) {
                const bf16x8 yb = *(const bf16x8*)(R2 + (sm * 16 + fr) * MS + kk * 32 + fq * 8), yk = *(const bf16x8*)(R3 + (sm * 16 + fr) * MS + kk * 32 + fq * 8);
                const bf16x8 xa = *(const bf16x8*)(R0 + (tn * 16 + fr) * MS + kk * 32 + fq * 8), xr = *(const bf16x8*)(R4 + (tn * 16 + fr) * MS + kk * 32 + fq * 8);
                lb = __builtin_amdgcn_mfma_f32_16x16x32_bf16(yb, xa, lb, 0, 0, 0); lk = __builtin_amdgcn_mfma_f32_16x16x32_bf16(yk, xa, lk, 0, 0, 0);
                mb = __builtin_amdgcn_mfma_f32_16x16x32_bf16(yb, xr, mb, 0, 0, 0); mk = __builtin_amdgcn_mfma_f32_16x16x32_bf16(yk, xr, mk, 0, 0, 0);
            }
            const int tt = tn * 16 + fr, s0i = sm * 16 + fq * 4;
            float olk[4], omb[4], omk[4];
#pragma unroll
            for (int jj = 0; jj < 4; ++jj) {
                const int si = s0i + jj;
                olk[jj] = (si < tt) ? lk[jj] : 0.f; omb[jj] = (si <= tt) ? mb[jj] : 0.f; omk[jj] = (si <= tt) ? mk[jj] : 0.f;
            }
            u32x2 w;
            w.x = cvt_pk_bf16(olk[0], olk[1]); w.y = cvt_pk_bf16(olk[2], olk[3]); *(u32x2*)(R8 + tt * MS + s0i) = w;
            w.x = cvt_pk_bf16(omb[0], omb[1]); w.y = cvt_pk_bf16(omb[2], omb[3]); *(u32x2*)(R9 + tt * MS + s0i) = w;
            w.x = cvt_pk_bf16(omk[0], omk[1]); w.y = cvt_pk_bf16(omk[2], omk[3]); *(u32x2*)(R10 + tt * MS + s0i) = w;
#pragma unroll
            for (int jj = 0; jj < 4; ++jj) { const int si = s0i + jj; GA[tt * 68 + si] = (si < tt) ? -lb[jj] : 0.f; }
        }
        __syncthreads();
#pragma unroll
        for (int q = 0; q < 2; ++q) {
            f32x4 y = {0.f, 0.f, 0.f, 0.f};
#pragma unroll
            for (int kk = 0; kk < 2; ++kk) {
                y = __builtin_amdgcn_mfma_f32_16x16x32_bf16(*(const bf16x8*)(R8 + (tm * 16 + fr) * MS + kk * 32 + fq * 8), *(const bf16x8*)(R7 + swz_ch((ih + q) * 16 + fr, kk * 4 + fq)), y, 0, 0, 0);
                y = __builtin_amdgcn_mfma_f32_16x16x32_bf16(*(const bf16x8*)(R0 + (tm * 16 + fr) * MS + kk * 32 + fq * 8), *(const bf16x8*)(PT + ((ih + q) * 16 + fr) * MS + kk * 32 + fq * 8), y, 0, 0, 0);
            }
            u32x2 w; w.x = cvt_pk_bf16(y[0], y[1]); w.y = cvt_pk_bf16(y[2], y[3]); *(u32x2*)(R1 + ((ih + q) * 16 + fr) * MS + tm * 16 + fq * 4) = w;
        }
        __syncthreads();
        {
            bf16_t* TM = R3;
            tri_inv64(GA, TF, OW, tid);
            __syncthreads();
#pragma unroll
            for (int q = 0; q < 8; ++q) { const int e = tid + q * 512, i = e >> 6, cc = e & 63; TM[i * MS + cc] = ((cc >> 4) <= (i >> 4)) ? f2bf(TF[i * 68 + cc]) : (bf16_t)0; }
        }
        __syncthreads();
#pragma unroll
        for (int q = 0; q < 2; ++q) {
            f32x4 uacc = {0.f, 0.f, 0.f, 0.f};
#pragma unroll
            for (int kk = 0; kk < 2; ++kk)
                uacc = __builtin_amdgcn_mfma_f32_16x16x32_bf16(*(const bf16x8*)(R3 + (tm * 16 + fr) * MS + kk * 32 + fq * 8), *(const bf16x8*)(R1 + ((ih + q) * 16 + fr) * MS + kk * 32 + fq * 8), uacc, 0, 0, 0);
            u32x2 w; w.x = cvt_pk_bf16(uacc[0], uacc[1]); w.y = cvt_pk_bf16(uacc[2], uacc[3]); *(u32x2*)(R2 + ((ih + q) * 16 + fr) * MS + tm * 16 + fq * 4) = w;
        }
        __syncthreads();
#pragma unroll
        for (int q = 0; q < 2; ++q) {
            f32x4 o = {0.f, 0.f, 0.f, 0.f};
            const f32x4 gc = *(const f32x4*)(GC + tm * 16 + fq * 4);
            Pacc[q] = Pacc[q] * gc;
#pragma unroll
            for (int kk = 0; kk < 2; ++kk) {
                const bf16x8 vt = *(const bf16x8*)(R7 + swz_ch((ih + q) * 16 + fr, kk * 4 + fq)), ut = *(const bf16x8*)(R2 + ((ih + q) * 16 + fr) * MS + kk * 32 + fq * 8);
                const bf16x8 pt = *(const bf16x8*)(PT + ((ih + q) * 16 + fr) * MS + kk * 32 + fq * 8);
                o = __builtin_amdgcn_mfma_f32_16x16x32_bf16(*(const bf16x8*)(R10 + (tm * 16 + fr) * MS + kk * 32 + fq * 8), vt, o, 0, 0, 0);
                o = __builtin_amdgcn_mfma_f32_16x16x32_bf16(*(const bf16x8*)(R4 + (tm * 16 + fr) * MS + kk * 32 + fq * 8), pt, o, 0, 0, 0);
                o = __builtin_amdgcn_mfma_f32_16x16x32_bf16(*(const bf16x8*)(R9 + (tm * 16 + fr) * MS + kk * 32 + fq * 8), ut, o, 0, 0, 0);
                Pacc[q] = __builtin_amdgcn_mfma_f32_16x16x32_bf16(*(const bf16x8*)(R5 + swz_ch(tm * 16 + fr, kk * 4 + fq)), ut, Pacc[q], 0, 0, 0);
                Pacc[q] = __builtin_amdgcn_mfma_f32_16x16x32_bf16(*(const bf16x8*)(R6 + swz_ch(tm * 16 + fr, kk * 4 + fq)), vt, Pacc[q], 0, 0, 0);
            }
#pragma unroll
            for (int jj = 0; jj < 4; ++jj) OW[(tm * 16 + fq * 4 + jj) * 68 + (ih + q) * 16 + fr] = o[jj];
        }
        __syncthreads();
#pragma unroll
        for (int q = 0; q < 2; ++q) { u32x2 w; w.x = cvt_pk_bf16(Pacc[q][0], Pacc[q][1]); w.y = cvt_pk_bf16(Pacc[q][2], Pacc[q][3]); *(u32x2*)(PT + ((ih + q) * 16 + fr) * MS + tm * 16 + fq * 4) = w; }
        {
            float o[8]; float sm = 0.f;
#pragma unroll
            for (int e = 0; e < 8; ++e) { o[e] = OW[t * 68 + c0 + e]; sm += o[e]; }
            const float mean = red8(sm) * (1.f / 64.f); float s2 = 0.f;
#pragma unroll
            for (int e = 0; e < 8; ++e) { o[e] -= mean; s2 += o[e] * o[e]; }
            const float rstd = rsqrtf(red8(s2) * (1.f / 64.f) + 64e-5f);
#pragma unroll
            for (int e = 0; e < 8; ++e) o[e] = (o[e] * rstd * PRM[384 + c0 + e] + PRM[448 + c0 + e] + bn * v[e]) * g[e];
            *(u32x4*)(YIN + (size_t)(t0 + t) * 1024 + 512 + h * 64 + c0) = pack8(o);
        }
        __syncthreads();
    }
    {
        float* so = p.out + (prompt ? O_PRW + ((size_t)(l * 16 + b) * 8 + h) * 4096 : O_SRW + ((size_t)(l * 8 + b) * 8 + h) * 4096);
#pragma unroll
        for (int q = 0; q < 2; ++q)
#pragma unroll
            for (int jj = 0; jj < 4; ++jj) so[((ih + q) * 16 + fr) * 64 + tm * 16 + fq * 4 + jj] = Pacc[q][jj];
        if (h == 0) {
            const int tlast = prompt ? (seq + 1) * 2048 - 1 : NTP + (b + 1) * 64 - 1;
            float* sh = p.out + (prompt ? O_PSHIFT + (size_t)(l * 16 + b) * RWP : O_SSHIFT + (size_t)(l * 8 + b) * RWP);
            for (int i = tid; i < RWP; i += 512) sh[i] = bf2f(PROJ[(size_t)tlast * PJ + C_RW + i]);
        }
    }
    __syncthreads();
}

__device__ __forceinline__ void phase_scan(const Ctx& cx, const Params& p, int l) {
#ifndef REP_SCAN
#define REP_SCAN 1
#endif
    for (int rep = 0; rep < REP_SCAN; ++rep)
    for (int w = cx.bid; w < 288; w += cx.nb) {
        bool isr; int seq, h;
        if (w < 128) { isr = true; seq = w >> 3; h = w & 7; }
        else if (w < 192) { isr = false; seq = (w - 128) >> 2; h = (w - 128) & 3; }
        else if (w < 224) { isr = false; seq = 16 + ((w - 192) >> 2); h = (w - 192) & 3; }
        else { isr = true; seq = 16 + ((w - 224) >> 3); h = (w - 224) & 7; }
#ifndef SCANM
#define SCANM 3
#endif
#ifndef REP_R
#define REP_R 1
#endif
#ifndef REP_GD
#define REP_GD 1
#endif
        if (isr) { if (SCANM & 1) for (int rr = 0; rr < REP_R; ++rr) rwkv_chunk_unit(cx, p, l, seq, h); }
        else { if (SCANM & 2) for (int rr = 0; rr < REP_GD; ++rr) gdn_scan_unit(cx, p, l, seq, h); }
    }
}

#define XB_TMO      128
#define XB_XCNT(j)  (256  + 64 * (j))
#define XB_XSUB(j)  (1280 + 64 * (j))
#define XB_XGEN(j)  (2304 + 64 * (j))
#define XB_TOP      3328
#define XB_TOPGEN   3392
#define XCD_BAR_WORDS 3456
#define XB_SPIN_CAP (1u << 18)
#define XLAS __attribute__((address_space(3)))
__device__ __forceinline__ unsigned xb_ld(unsigned* p)              { return __hip_atomic_load(p, __ATOMIC_RELAXED, __HIP_MEMORY_SCOPE_AGENT); }
__device__ __forceinline__ unsigned xb_add(unsigned* p, unsigned v) { return __hip_atomic_fetch_add(p, v, __ATOMIC_RELAXED, __HIP_MEMORY_SCOPE_AGENT); }
__device__ __forceinline__ unsigned xb_xcc_id() { return (unsigned)__builtin_amdgcn_s_getreg((3 << 11) | 20) & 0xFu; }
#define XB_SPIN(cond, bar) do { unsigned _sp = 0; while (cond) { __builtin_amdgcn_s_sleep(1); \
    if ((++_sp & 255u) == 0u) { if (xb_ld(&(bar)[XB_TMO])) break; if (_sp > XB_SPIN_CAP) { atomicAdd(&(bar)[XB_TMO], 1u); break; } } } } while (0)
struct XcdBarrier { unsigned* bar; unsigned x; volatile XLAS unsigned* st; };
__device__ __forceinline__ XcdBarrier xcd_barrier_post(unsigned* bar, volatile XLAS unsigned* st) {
    XcdBarrier b; b.bar = bar; b.x = xb_xcc_id(); b.st = st;
    if (threadIdx.x == 0) (void)xb_add(&bar[XB_XCNT(b.x)], 1u);
    return b;
}
__device__ __forceinline__ void xcd_barrier_complete(unsigned* bar, unsigned x, unsigned& nloc, unsigned& nx) {
    const unsigned G = gridDim.x * gridDim.y * gridDim.z;
    unsigned sum, cnt, mine, sp = 0u;
    for (;;) {
        sum = 0u; cnt = 0u; mine = 0u;
#pragma unroll
        for (unsigned j = 0; j < 16; ++j) { const unsigned c = xb_ld(&bar[XB_XCNT(j)]); sum += c; cnt += (c > 0u) ? 1u : 0u; mine = (j == x) ? c : mine; }
        if (sum == G) break;
        __builtin_amdgcn_s_sleep(1);
        if ((++sp & 255u) == 0u) { if (xb_ld(&bar[XB_TMO])) break; if (sp > XB_SPIN_CAP) { atomicAdd(&bar[XB_TMO], 1u); break; } }
    }
    nloc = mine > 0u ? mine : 1u; nx = cnt > 0u ? cnt : 1u;
}
__device__ __forceinline__ void xcd_barrier(const XcdBarrier& b) {
    asm volatile("s_waitcnt vmcnt(0)" ::: "memory");
    __syncthreads();
    if (threadIdx.x == 0) {
        unsigned* bar = b.bar;
        __builtin_amdgcn_s_waitcnt(0);
        unsigned nloc = b.st[0], nx = b.st[1];
        if (nloc == 0u) { xcd_barrier_complete(bar, b.x, nloc, nx); b.st[0] = nloc; b.st[1] = nx; }
        const unsigned old = xb_add(&bar[XB_XSUB(b.x)], 1u);
        const unsigned gen = old / nloc;
        if (old + 1u == (gen + 1u) * nloc) {
            __builtin_amdgcn_fence(__ATOMIC_RELEASE, "agent");
            asm volatile("s_waitcnt vmcnt(0)" ::: "memory");
            const unsigned og = xb_add(&bar[XB_TOP], 1u);
            const unsigned tg = og / nx;
            if (og + 1u == (tg + 1u) * nx) xb_add(&bar[XB_TOPGEN], 1u);
            else XB_SPIN(xb_ld(&bar[XB_TOPGEN]) == tg, bar);
            __builtin_amdgcn_fence(__ATOMIC_ACQUIRE, "agent");
            xb_add(&bar[XB_XGEN(b.x)], 1u);
            asm volatile("s_waitcnt vmcnt(0)" ::: "memory");
        } else {
            XB_SPIN(xb_ld(&bar[XB_XGEN(b.x)]) == gen, bar);
            __builtin_amdgcn_fence(__ATOMIC_ACQUIRE, "agent");
            asm volatile("s_waitcnt vmcnt(0)" ::: "memory");
        }
    }
    __syncthreads();
}

__device__ __forceinline__ void run_phase(const Ctx& cx, const Params& p, int ph) {
    unsigned char* ws = p.ws;
    const float* MOD = (const float*)(ws + WS_MOD);
#ifndef PHM
#define PHM 0xFFFF
#endif
    if (ph == 0) { if (PHM & 1) phase_mod(cx, p); __syncthreads(); if (PHM & 2) phase_weights(cx, p, 0); return; }
    if (ph == 1) { if (PHM & 4) phase_mod0(cx, p); return; }
    const int l = (ph - 2) / 9, s = (ph - 2) % 9;
    const float* modl = MOD + (size_t)l * 24 * 6144;
    gm::Epi E{};
    const bf16_t* gA = (const bf16_t*)(ws + WS_H); const bf16_t* gB = nullptr; int gN = 0, gK = 1024;
    switch (s) {
    case 0: E.kind = 1; E.O = (bf16_t*)(ws + WS_R1); E.ldo = PJ; gB = (const bf16_t*)(ws + WS_WIN); gN = 3840; break;
    case 1: if (PHM & 16) phase_gdn_prep(cx, p, l); break;
    case 2: if (PHM & 128) phase_rwkv_prep(cx, p, l); break;
    case 3: if (PHM & 32) phase_scan(cx, p, l); break;
    case 4: E.kind = 2; E.X = p.out; E.O = (bf16_t*)(ws + WS_PREP); E.gate = modl + 2048; gB = (const bf16_t*)(ws + WS_WOUT); gN = 1024;
        if (l == 0) { E.xp = p.in[0]; E.xs = p.in[1] - (size_t)NTP * 1024; E.xb = nullptr; } else { E.xp = p.out; E.xs = p.out; E.xb = (const bf16_t*)p.out; }
        break;
    case 5: if (PHM & 64) phase_ln(cx, p, p.in[27] + l * 1024, p.in[28] + l * 1024, modl, 3072, 4096, false, nullptr); break;
    case 6: E.kind = 3; E.O = (bf16_t*)(ws + WS_R1); E.ldo = DFF; gB = (const bf16_t*)(ws + WS_W1); gN = DFF; break;
    case 7: E.kind = 2; E.X = p.out; E.O = (bf16_t*)(ws + WS_PREP); E.gate = modl + 5120; E.xp = p.out; E.xs = p.out; E.xb = (const bf16_t*)p.out;
        gA = (const bf16_t*)(ws + WS_R1); gB = (const bf16_t*)(ws + WS_W2); gN = 1024; gK = DFF; break;
    default:
        if (PHM & 64) phase_ln(cx, p, p.in[31] + l * 1024, p.in[32] + l * 1024, l < NLAYER - 1 ? modl + 24 * 6144 : nullptr, 0, 1024, l == NLAYER - 1, l < NLAYER - 1 ? p.in[10] + (size_t)(l + 1) * 1024 * PTOT : nullptr);
        if ((PHM & 2) && l < NLAYER - 1) { __syncthreads(); phase_weights(cx, p, l + 1); }
        break;
    }
#ifndef REP_G
#define REP_G 1
#endif
#ifndef REP_G2
#define REP_G2 0
#endif
    if ((PHM & 8) && gB) {
        const int reps = (E.kind == 2) ? 1 + REP_G2 : REP_G;
        for (int r = 0; r < reps; ++r) { gm::Epi E2 = E; if (E.kind == 2 && r + 1 < reps) E2.kind = 0; gemm_phase(cx, gA, gB, NTOK, gN, gK, E2); }
    }
}

#ifndef DBG_STOP
#define DBG_STOP 0
#endif
#ifndef DBG_OFF
#define DBG_OFF WS_PREP
#endif
#ifndef DBG_MOD
#define DBG_MOD 76677120
#endif
#ifndef DBG_SZ
#define DBG_SZ 20480
#define DBG_POFF 16384
#endif
#ifndef DBG_STRIDE
#define DBG_STRIDE 5
#endif
__global__ void __launch_bounds__(512) mk_fwd(Params p) {
    cg::grid_group grid = cg::this_grid();
    if (p.ph_lo == 1000) {
        const bf16_t* src = (const bf16_t*)(p.ws + DBG_OFF);
        for (size_t i = (size_t)blockIdx.x * 512 + threadIdx.x; i < 44130304; i += (size_t)gridDim.x * 512) p.out[i] = bf2f(src[((i / DBG_SZ) % 2080) * 36864 + DBG_POFF + (i % DBG_SZ)]);
        return;
    }
    volatile XLAS unsigned* xst = (volatile XLAS unsigned*)((XLAS unsigned char*)smem + (LDS_BYTES - 16));
    if (threadIdx.x == 0) { xst[0] = 0u; xst[1] = 0u; xst[2] = 0u; xst[3] = 0u; }
    __syncthreads();
    const XcdBarrier xb = xcd_barrier_post((unsigned*)(p.ws + WS_BAR), xst);
    for (int ph = p.ph_lo; ph < p.ph_hi; ++ph) {
        if (ph > p.ph_lo) { if (p.ph_hi == 0x7fffffff) grid.sync(); else xcd_barrier(xb); }
        Ctx cx; cx.tid = threadIdx.x; cx.bid = blockIdx.x; cx.nb = gridDim.x;
        asm volatile("" : "+v"(cx.tid)); asm volatile("" : "+s"(cx.bid)); asm volatile("" : "+s"(cx.nb));
        run_phase(cx, p, ph);
        __syncthreads();
    }
}

extern "C" void kernel_launch(void* const* d_in, const int* in_sizes, int n_in, void* d_out, int out_size, void* d_ws, size_t ws_size, hipStream_t stream) {
    static int grid = 0;
    if (grid == 0) {
        if (n_in != 33 || ws_size < WS_END) { fprintf(stderr, "kernel_launch: unexpected n_in %d / ws %zu (need %zu)\n", n_in, ws_size, (size_t)WS_END); grid = -1; return; }
        int dev = 0, cus = 0, per_cu = 0;
        hipGetDevice(&dev);
        hipDeviceGetAttribute(&cus, hipDeviceAttributeMultiprocessorCount, dev);
        if (hipFuncSetAttribute((const void*)mk_fwd, hipFuncAttributeMaxDynamicSharedMemorySize, LDS_BYTES) != hipSuccess) { fprintf(stderr, "kernel_launch: hipFuncSetAttribute failed\n"); grid = -1; return; }
        if (hipOccupancyMaxActiveBlocksPerMultiprocessor(&per_cu, (const void*)mk_fwd, 512, LDS_BYTES) != hipSuccess || per_cu < 1) { fprintf(stderr, "kernel_launch: occupancy query says %d\n", per_cu); per_cu = 1; }
        (void)hipGetLastError();
        grid = cus;
    }
    if (grid < 0) return;
    if (hipMemsetAsync((char*)d_ws + WS_BAR, 0, 16384, stream) != hipSuccess) { fprintf(stderr, "kernel_launch: memset of the barrier words failed\n"); return; }
    Params p{};
    for (int i = 0; i < 33; ++i) p.in[i] = (const float*)d_in[i];
    p.out = (float*)d_out; p.ws = (unsigned char*)d_ws;
#if MK_ONE_LAUNCH
    p.ph_lo = 0; p.ph_hi = NPHASE;
    void* args[] = {&p};
    hipError_t e = hipLaunchCooperativeKernel((const void*)mk_fwd, dim3(grid), dim3(512), args, LDS_BYTES, stream);
    if (e != hipSuccess) fprintf(stderr, "cooperative launch failed: %s (grid %d)\n", hipGetErrorString(e), grid);
#else
    for (int ph = 0; ph < (DBG_STOP ? DBG_STOP + 1 : NPHASE); ++ph) {
        p.ph_lo = ph; p.ph_hi = ph + 1;
        if (DBG_STOP && ph == DBG_STOP) { p.ph_lo = 1000; p.ph_hi = 1000; }
        void* args[] = {&p};
        hipError_t e = hipLaunchCooperativeKernel((const void*)mk_fwd, dim3(grid), dim3(512), args, LDS_BYTES, stream);
        if (e != hipSuccess) { fprintf(stderr, "launch %d failed: %s\n", ph, hipGetErrorString(e)); break; }
    }
#endif
}
```
